# Optimizing an MI355X kernel written in HIP

```python
import math
import jax, jax.numpy as jnp
from jax import lax
import numpy as np

D_MODEL = 1024
BATCH = 4
SEQ = 8192
DEPTH = 1

CONV_A_WIDTH = 512
CONV_A_K = 3
DN_HEADS = 8
DN_DK = 128
DN_DV = 128
DN_CONV_K = 5
CHUNK = 64
DN_QK = DN_HEADS * DN_DK
DN_VW = DN_HEADS * DN_DV
N_BRANCH = 2
D_FF = 2816
N_MOD = 9
EPS = 1e-6

SPLIT_SIZES = (
    CONV_A_WIDTH,
    CONV_A_WIDTH,
    CONV_A_WIDTH,
    2 * DN_QK + DN_VW,
    DN_VW,
    4 * DN_HEADS,
    N_BRANCH * D_MODEL,
)
IN_COLS = sum(SPLIT_SIZES)
SPLIT_OFFSETS = tuple(int(v) for v in np.cumsum(SPLIT_SIZES)[:-1])

kernel_name = "bidir_hybrid_conv_gdn_macaron_adaln"


def _rmsnorm(x, w):
    xf = x.astype(jnp.float32)
    y = xf * lax.rsqrt(jnp.mean(xf * xf, axis=-1, keepdims=True) + EPS)
    return (y * w.astype(jnp.float32)).astype(x.dtype)


def _l2norm(x):
    return x * lax.rsqrt(jnp.sum(x * x, axis=-1, keepdims=True) + EPS)


def _modulate(x, shift, scale):
    return x * (1.0 + scale) + shift


def _swiglu(x, w_up, w_down):
    a, b = jnp.split(x @ w_up, 2, axis=-1)
    return (jax.nn.silu(a) * b) @ w_down


def _dwconv(x, w):
    k_taps = w.shape[0]
    pad = k_taps // 2
    s = x.shape[1]
    xp = jnp.pad(x, ((0, 0), (pad, pad), (0, 0)))
    y = xp[:, 0:s] * w[0]
    for i in range(1, k_taps):
        y = y + xp[:, i:i + s] * w[i]
    return y


def _chunk_gated_delta(q, k, v, beta, g):
    bn, s, h, dk = q.shape
    dv = v.shape[-1]
    n = s // CHUNK

    def to_chunks(t):
        t = t.reshape((bn, n, CHUNK, h) + t.shape[3:])
        return jnp.moveaxis(t, 3, 1)

    q, k, v, beta, g = (to_chunks(t) for t in (q, k, v, beta, g))
    g = jnp.cumsum(g, axis=-1)
    idx = jnp.arange(CHUNK)
    incl = idx[:, None] >= idx[None, :]
    strict = idx[:, None] > idx[None, :]
    decay = jnp.exp(jnp.where(incl, g[..., :, None] - g[..., None, :], -jnp.inf))
    k_beta = k * beta[..., None]
    a_mat = jnp.where(strict, jnp.einsum('bhnid,bhnjd->bhnij', k_beta, k) * decay, 0.0)
    a_mat = a_mat + jnp.eye(CHUNK, dtype=q.dtype)
    rhs = jnp.concatenate([v * beta[..., None], k_beta * jnp.exp(g)[..., None]], axis=-1)
    sol = lax.linalg.triangular_solve(a_mat, rhs, left_side=True, lower=True)
    u, w = sol[..., :dv], sol[..., dv:]
    attn = jnp.einsum('bhnid,bhnjd->bhnij', q, k) * decay

    xs = tuple(jnp.moveaxis(t, 2, 0) for t in (q, k, u, w, g, attn))

    def step(state, inp):
        q_c, k_c, u_c, w_c, g_c, attn_c = inp
        v_new = u_c - jnp.einsum('bhcd,bhde->bhce', w_c, state)
        o_c = (jnp.einsum('bhcd,bhde->bhce', q_c * jnp.exp(g_c)[..., None], state)
               + jnp.einsum('bhij,bhje->bhie', attn_c, v_new))
        g_last = g_c[..., -1:]
        state = (state * jnp.exp(g_last)[..., None]
                 + jnp.einsum('bhcd,bhce->bhde', k_c * jnp.exp(g_last - g_c)[..., None], v_new))
        return state, o_c

    state0 = jnp.zeros((bn, h, dk, dv), q.dtype)
    _, o = lax.scan(step, state0, xs)
    return o.transpose(1, 0, 3, 2, 4).reshape(bn, s, h, dv)


def _hybrid_mixer(u, w_in, conv_a, conv_dn, a_log_fwd, dt_bias_fwd, a_log_bwd, dt_bias_bwd,
                  dn_norm, w_a_out, w_b_out, w_out):
    bn, s, _ = u.shape
    f32 = jnp.float32
    proj = u @ w_in
    ca_b, ca_c, ca_v, dn_qkv, dn_z, dn_ba, gate_logits = jnp.split(proj, SPLIT_OFFSETS, axis=-1)

    y_a = ca_b * _dwconv(ca_c * ca_v, conv_a)

    qkv = jax.nn.silu(_dwconv(dn_qkv, conv_dn))
    q, k, v = jnp.split(qkv, [DN_QK, 2 * DN_QK], axis=-1)
    q = (_l2norm(q.reshape(bn, s, DN_HEADS, DN_DK).astype(f32)) * (DN_DK ** -0.5))
    k = _l2norm(k.reshape(bn, s, DN_HEADS, DN_DK).astype(f32))
    v = v.reshape(bn, s, DN_HEADS, DN_DV).astype(f32)
    b_f, b_b, al_f, al_b = jnp.split(dn_ba.astype(f32), 4, axis=-1)
    beta_f, beta_b = jax.nn.sigmoid(b_f), jax.nn.sigmoid(b_b)
    g_f = -jnp.exp(a_log_fwd.astype(f32)) * jax.nn.softplus(al_f + dt_bias_fwd.astype(f32))
    g_b = -jnp.exp(a_log_bwd.astype(f32)) * jax.nn.softplus(al_b + dt_bias_bwd.astype(f32))
    o_fwd = _chunk_gated_delta(q, k, v, beta_f, g_f)
    rev = lambda t: t[:, ::-1]
    o_bwd = rev(_chunk_gated_delta(rev(q), rev(k), rev(v), rev(beta_b), rev(g_b)))
    o = _rmsnorm(o_fwd + o_bwd, dn_norm) * jax.nn.silu(dn_z.reshape(bn, s, DN_HEADS, DN_DV).astype(f32))
    y_b = o.reshape(bn, s, DN_VW).astype(u.dtype)

    gate_a, gate_b = jnp.split(gate_logits, N_BRANCH, axis=-1)
    merged = jax.nn.sigmoid(gate_a) * (y_a @ w_a_out) + jax.nn.sigmoid(gate_b) * (y_b @ w_b_out)
    return merged @ w_out


def setup_inputs(seed: int = 0) -> dict:
    key = jax.random.key(seed)
    ks = jax.random.split(key, 24)
    L = DEPTH
    f32 = jnp.float32

    def nrm(k, shape, fan_in):
        return jax.random.normal(k, shape, f32) * (fan_in ** -0.5)

    def gain(k, shape):
        return 1.0 + 0.02 * jax.random.normal(k, shape, f32)

    def a_log(k):
        return jnp.log(jax.random.uniform(k, (L, DN_HEADS), f32, minval=1.0, maxval=16.0))

    def dt_bias(k):
        dt = jnp.exp(jax.random.uniform(k, (L, DN_HEADS), f32,
                                        minval=math.log(1e-3), maxval=math.log(1e-1)))
        return dt + jnp.log(-jnp.expm1(-dt))

    return {
        "x": jax.random.normal(ks[0], (BATCH, SEQ, D_MODEL), f32),
        "c": jax.random.normal(ks[1], (BATCH, D_MODEL), f32),
        "w_ada": nrm(ks[2], (L, D_MODEL, N_MOD * D_MODEL), D_MODEL),
        "b_ada": 0.02 * jax.random.normal(ks[3], (L, N_MOD * D_MODEL), f32),
        "norm_ffn1": gain(ks[4], (L, D_MODEL)),
        "w_ffn1_up": nrm(ks[5], (L, D_MODEL, 2 * D_FF), D_MODEL),
        "w_ffn1_down": nrm(ks[6], (L, D_FF, D_MODEL), D_FF),
        "norm_mix": gain(ks[7], (L, D_MODEL)),
        "w_in": nrm(ks[8], (L, D_MODEL, IN_COLS), D_MODEL),
        "conv_a": nrm(ks[9], (L, CONV_A_K, CONV_A_WIDTH), CONV_A_K),
        "conv_dn": nrm(ks[10], (L, DN_CONV_K, 2 * DN_QK + DN_VW), DN_CONV_K),
        "a_log_fwd": a_log(ks[11]),
        "dt_bias_fwd": dt_bias(ks[12]),
        "a_log_bwd": a_log(ks[13]),
        "dt_bias_bwd": dt_bias(ks[14]),
        "dn_norm": gain(ks[15], (L, DN_DV)),
        "w_a_out": nrm(ks[16], (L, CONV_A_WIDTH, D_MODEL), CONV_A_WIDTH),
        "w_b_out": nrm(ks[17], (L, DN_VW, D_MODEL), DN_VW),
        "w_out": nrm(ks[18], (L, D_MODEL, D_MODEL), D_MODEL),
        "norm_ffn2": gain(ks[19], (L, D_MODEL)),
        "w_ffn2_up": nrm(ks[20], (L, D_MODEL, 2 * D_FF), D_MODEL),
        "w_ffn2_down": nrm(ks[21], (L, D_FF, D_MODEL), D_FF),
        "norm_final": gain(ks[22], (D_MODEL,)),
    }


def reference(x, c, w_ada, b_ada, norm_ffn1, w_ffn1_up, w_ffn1_down, norm_mix, w_in, conv_a,
              conv_dn, a_log_fwd, dt_bias_fwd, a_log_bwd, dt_bias_bwd, dn_norm, w_a_out, w_b_out,
              w_out, norm_ffn2, w_ffn2_up, w_ffn2_down, norm_final):
    h = x
    c_act = jax.nn.silu(c)
    for l in range(DEPTH):
        mod = c_act @ w_ada[l] + b_ada[l]
        sh1, sc1, g1, sh2, sc2, g2, sh3, sc3, g3 = [m[:, None, :] for m in jnp.split(mod, N_MOD, axis=-1)]
        u = _modulate(_rmsnorm(h, norm_ffn1[l]), sh1, sc1)
        h = h + 0.5 * g1 * _swiglu(u, w_ffn1_up[l], w_ffn1_down[l])
        u = _modulate(_rmsnorm(h, norm_mix[l]), sh2, sc2)
        h = h + g2 * _hybrid_mixer(u, w_in[l], conv_a[l], conv_dn[l], a_log_fwd[l], dt_bias_fwd[l],
                                   a_log_bwd[l], dt_bias_bwd[l], dn_norm[l], w_a_out[l],
                                   w_b_out[l], w_out[l])
        u = _modulate(_rmsnorm(h, norm_ffn2[l]), sh3, sc3)
        h = h + 0.5 * g3 * _swiglu(u, w_ffn2_up[l], w_ffn2_down[l])
    return _rmsnorm(h, norm_final)
```

```cpp
#include <hip/hip_runtime.h>
#include <cstdio>
#include <cstdint>
namespace pg8 {
#define PG8_LAS __attribute__((address_space(3)))
typedef unsigned short bf16_t;
typedef short bf16x8 __attribute__((ext_vector_type(8)));
typedef float f32x4 __attribute__((ext_vector_type(4)));
typedef unsigned u32x4 __attribute__((ext_vector_type(4)));
constexpr int BM = 256, BK = 64, HALF = 128, HTB = HALF * BK * 2  , STAGE_BYTES = 8 * HTB, NXCD = 8, WGM = 8;

__host__ __device__ __forceinline__ int lds_byte(int r, int c) { const int st = (r >> 4) * 2 + (c >> 5), rr = r & 15, cc = c & 31, ob = rr * 64 + cc * 2; return st * 1024 + (ob ^ (((ob >> 9) & 1) << 5)); }
__host__ __device__ __forceinline__ void stage_rc(int b, int& R, int& C) { const int st = b / 1024, sb = b % 1024, swz = sb ^ (((sb >> 9) & 1) << 5); R = (st >> 1) * 16 + swz / 64; C = (st & 1) * 32 + (swz % 64) / 2; }
__host__ __device__ __forceinline__ int perm32(int rho) { const int n = rho >> 4, i = rho & 15; return 8 * (i >> 2) + 4 * n + (i & 3); }

struct Unit { int pm, pn; };
struct Gemm { const bf16_t* A; const bf16_t* Bt; int M, N, K; };

struct StaticOrder {
    int nM, nN, nwg, G, c;
    __host__ __device__ void init(int M, int N, int G_, int c_) { nM = M / BM; nN = N / BM; nwg = nM * nN; G = G_; c = c_; }
    __host__ __device__ bool next(int i, Unit& u) const {
        const long L = (long)i * G + c; if (L >= nwg) return false;
        int wgid = (int)L; { const int q = nwg / NXCD, r = nwg % NXCD, xcd = wgid % NXCD, off = wgid / NXCD; wgid = (xcd < r ? xcd * (q + 1) : r * (q + 1) + (xcd - r) * q) + off; }
        const int nig = WGM * nN, gid = wgid / nig, fm = gid * WGM, gsz = (nM - fm) < WGM ? (nM - fm) : WGM;
        u.pm = fm + ((wgid % nig) % gsz); u.pn = (wgid % nig) / gsz; return true;
    }
    __device__ __forceinline__ void a_ready(const Unit&) const {}
    __device__ __forceinline__ void done(const Unit&) const {}
};
__device__ __forceinline__ unsigned cvt_pk_bf16(float lo, float hi) { unsigned r; asm volatile("v_cvt_pk_bf16_f32 %0, %1, %2" : "=v"(r) : "v"(lo), "v"(hi)); return r; }
__device__ __forceinline__ float fast_sigmoid(float x) { return __builtin_amdgcn_rcpf(1.0f + __builtin_amdgcn_exp2f(-1.4426950408889634f * x)); }
__device__ __forceinline__ float fast_silu(float x) { return x * fast_sigmoid(x); }
__device__ __forceinline__ f32x4 silu4(f32x4 v) { return (f32x4){fast_silu(v[0]), fast_silu(v[1]), fast_silu(v[2]), fast_silu(v[3])}; }
__device__ __forceinline__ f32x4 sigm4(f32x4 v) { return (f32x4){fast_sigmoid(v[0]), fast_sigmoid(v[1]), fast_sigmoid(v[2]), fast_sigmoid(v[3])}; }
__device__ __forceinline__ u32x4 pack8(f32x4 v0, f32x4 v1) { u32x4 w; w.x = cvt_pk_bf16(v0[0], v0[1]); w.y = cvt_pk_bf16(v0[2], v0[3]); w.z = cvt_pk_bf16(v1[0], v1[1]); w.w = cvt_pk_bf16(v1[2], v1[3]); return w; }
__device__ __forceinline__ void unpack8(u32x4 w, f32x4& v0, f32x4& v1) {
    v0 = (f32x4){__uint_as_float(w.x << 16), __uint_as_float(w.x & 0xffff0000u), __uint_as_float(w.y << 16), __uint_as_float(w.y & 0xffff0000u)};
    v1 = (f32x4){__uint_as_float(w.z << 16), __uint_as_float(w.z & 0xffff0000u), __uint_as_float(w.w << 16), __uint_as_float(w.w & 0xffff0000u)}; }

struct EpiGlu {
    static constexpr bool PERM = true, AFTER_DRAIN = false;
    bf16_t* O; int ldo;
    __device__ __forceinline__ void operator()(const f32x4 (&acc)[2][2][4][2], const Unit& u, int wr, int wc, int fr, int fq) const {
        const int row0 = u.pm * BM + wr * 64 + fr, col0 = u.pn * HALF + wc * 32 + 8 * fq;
#pragma unroll
        for (int ai = 0; ai < 2; ++ai)
#pragma unroll
            for (int m = 0; m < 4; ++m) { bf16_t* rowp = O + (size_t)(row0 + ai * HALF + m * 16) * ldo + col0;
                const f32x4 h0 = silu4(acc[ai][0][m][0]) * acc[ai][1][m][0], h1 = silu4(acc[ai][0][m][1]) * acc[ai][1][m][1];
                *(u32x4*)rowp = pack8(h0, h1); }
    }
};
struct EpiRes {
    static constexpr bool PERM = false, AFTER_DRAIN = false;
    const float* base; float* out; const float* gate; int gate_bstride; float scale; int rows_per_batch_shift;
    __device__ __forceinline__ void operator()(const f32x4 (&acc)[2][2][4][2], const Unit& u, int wr, int wc, int fr, int fq) const {
        const int row0 = u.pm * BM + wr * 64 + fr, col0 = u.pn * BM + wc * 32 + 4 * fq;
        const float* g = gate + (size_t)((u.pm * BM) >> rows_per_batch_shift) * gate_bstride + col0;
        f32x4 gv[2][2];
#pragma unroll
        for (int bj = 0; bj < 2; ++bj)
#pragma unroll
            for (int n = 0; n < 2; ++n) gv[bj][n] = *(const f32x4*)(g + bj * HALF + n * 16) * scale;
#pragma unroll
        for (int ai = 0; ai < 2; ++ai)
#pragma unroll
            for (int m = 0; m < 4; ++m) { const size_t off = (size_t)(row0 + ai * HALF + m * 16) * 1024 + col0;
#pragma unroll
                for (int bj = 0; bj < 2; ++bj)
#pragma unroll
                    for (int n = 0; n < 2; ++n) { const f32x4 bs = *(const f32x4*)(base + off + bj * HALF + n * 16);
                        *(f32x4*)(out + off + bj * HALF + n * 16) = bs + gv[bj][n] * acc[ai][bj][m][n]; } }
    }
};
struct EpiIn1 {
    static constexpr bool PERM = true, AFTER_DRAIN = false;
    bf16_t* CV; bf16_t* CAB; bf16_t* QKV; size_t qkv_stride; float* BA;
    __device__ __forceinline__ void operator()(const f32x4 (&acc)[2][2][4][2], const Unit& u, int wr, int wc, int fr, int fq) const {
        const int row0 = u.pm * BM + wr * 64 + fr, cl = wc * 32 + 8 * fq; const int pn = u.pn;
        if (pn < 4) {
#pragma unroll
            for (int ai = 0; ai < 2; ++ai)
#pragma unroll
                for (int m = 0; m < 4; ++m) { bf16_t* rowp = CV + (size_t)(row0 + ai * HALF + m * 16) * 512 + pn * HALF + cl;
                    *(u32x4*)rowp = pack8(acc[ai][0][m][0] * acc[ai][1][m][0], acc[ai][0][m][1] * acc[ai][1][m][1]); }
        } else if (pn < 18) {
            bf16_t* base; int ld, colt;
            if (pn < 6) { base = CAB; ld = 512; colt = (pn - 4) * BM; } else { const int t = pn - 6; base = QKV + (size_t)(t >> 2) * qkv_stride; ld = 1024; colt = (t & 3) * BM; }
#pragma unroll
            for (int ai = 0; ai < 2; ++ai)
#pragma unroll
                for (int m = 0; m < 4; ++m) { bf16_t* rowp = base + (size_t)(row0 + ai * HALF + m * 16) * ld + colt + cl;
#pragma unroll
                    for (int bj = 0; bj < 2; ++bj) *(u32x4*)(rowp + bj * HALF) = pack8(acc[ai][bj][m][0], acc[ai][bj][m][1]); }
        } else {
            if (wc == 0) {
#pragma unroll
                for (int ai = 0; ai < 2; ++ai)
#pragma unroll
                    for (int m = 0; m < 4; ++m) { float* rowp = BA + (size_t)(row0 + ai * HALF + m * 16) * 32 + 8 * fq;
                        *(f32x4*)rowp = acc[ai][0][m][0]; *(f32x4*)(rowp + 4) = acc[ai][0][m][1]; }
            }
        }
    }
};
struct EpiIn2 {
    static constexpr bool PERM = true, AFTER_DRAIN = false;
    bf16_t* YB; bf16_t* SGA; bf16_t* SGB;
    __device__ __forceinline__ void operator()(const f32x4 (&acc)[2][2][4][2], const Unit& u, int wr, int wc, int fr, int fq) const {
        const int row0 = u.pm * BM + wr * 64 + fr, cl = wc * 32 + 8 * fq; const int pn = u.pn;
        long doff = (long)(SGA - YB); if (pn >= 8) doff = (long)(SGB - YB); if (pn < 4) doff = 0; bf16_t* base = YB + doff; const int colt = (pn & 3) * BM;
#pragma unroll
        for (int ai = 0; ai < 2; ++ai)
#pragma unroll
            for (int m = 0; m < 4; ++m) { bf16_t* rowp = base + (size_t)(row0 + ai * HALF + m * 16) * 1024 + colt + cl;
#pragma unroll
                for (int bj = 0; bj < 2; ++bj) {
                    if (pn < 4) { f32x4 o0, o1; unpack8(*(const u32x4*)(rowp + bj * HALF), o0, o1);
                        *(u32x4*)(rowp + bj * HALF) = pack8(o0 * silu4(acc[ai][bj][m][0]), o1 * silu4(acc[ai][bj][m][1])); }
                    else *(u32x4*)(rowp + bj * HALF) = pack8(sigm4(acc[ai][bj][m][0]), sigm4(acc[ai][bj][m][1])); } }
    }
};
struct EpiMul {
    static constexpr bool PERM = true, AFTER_DRAIN = false;
    bf16_t* T;
    __device__ __forceinline__ void operator()(const f32x4 (&acc)[2][2][4][2], const Unit& u, int wr, int wc, int fr, int fq) const {
        const int row0 = u.pm * BM + wr * 64 + fr, col0 = u.pn * BM + wc * 32 + 8 * fq;
#pragma unroll
        for (int ai = 0; ai < 2; ++ai)
#pragma unroll
            for (int m = 0; m < 4; ++m) { bf16_t* rowp = T + (size_t)(row0 + ai * HALF + m * 16) * 1024 + col0;
#pragma unroll
                for (int bj = 0; bj < 2; ++bj) { f32x4 o0, o1; unpack8(*(const u32x4*)(rowp + bj * HALF), o0, o1);
                    *(u32x4*)(rowp + bj * HALF) = pack8(o0 * acc[ai][bj][m][0], o1 * acc[ai][bj][m][1]); } }
    }
};
struct EpiMerge {
    static constexpr bool PERM = true, AFTER_DRAIN = false;
    const bf16_t* T; bf16_t* G;
    __device__ __forceinline__ void operator()(const f32x4 (&acc)[2][2][4][2], const Unit& u, int wr, int wc, int fr, int fq) const {
        const int row0 = u.pm * BM + wr * 64 + fr, col0 = u.pn * BM + wc * 32 + 8 * fq;
#pragma unroll
        for (int ai = 0; ai < 2; ++ai)
#pragma unroll
            for (int m = 0; m < 4; ++m) { const size_t off = (size_t)(row0 + ai * HALF + m * 16) * 1024 + col0;
#pragma unroll
                for (int bj = 0; bj < 2; ++bj) { f32x4 t0, t1, g0, g1; unpack8(*(const u32x4*)(T + off + bj * HALF), t0, t1); unpack8(*(const u32x4*)(G + off + bj * HALF), g0, g1);
                    *(u32x4*)(G + off + bj * HALF) = pack8(t0 + g0 * acc[ai][bj][m][0], t1 + g1 * acc[ai][bj][m][1]); } }
    }
};
template <class Epi, class Sched, bool ALIGN_EPI = false, bool SP2 = false>
__device__ __forceinline__ void gemm_phase(PG8_LAS unsigned char* lds, const Gemm g, const Sched& S, const Epi& E) {
    const int tid = threadIdx.x, wid = __builtin_amdgcn_readfirstlane(tid >> 6), lane = tid & 63, wr = wid >> 2, wc = wid & 3, fr = lane & 15, fq = lane >> 4;
    const int K = g.K, nt = K / BK;
    unsigned voffA[2], voffB[2];
#pragma unroll
    for (int i = 0; i < 2; ++i) { int R, C; stage_rc(tid * 16 + i * 8192, R, C); const int Rb = Epi::PERM ? ((R & ~31) + perm32(R & 31)) : R;
        voffA[i] = (unsigned)(R * K + C) * 2u; voffB[i] = (unsigned)(Rb * K + C) * 2u; }
    const size_t kstep = (size_t)(BK * 2);
    const size_t hstep = (size_t)HALF * K * 2;
    const size_t tstep = 2 * hstep;
    const unsigned ldsw = (unsigned)wid * 1024u;
    const int aoff = lds_byte(wr * 64 + fr, fq * 8), boff = lds_byte(wc * 32 + fr, fq * 8);
#define PG8_SA(b, h) (((b) * 2 + (h)) * HTB)
#define PG8_SB(b, h) ((4 + (b) * 2 + (h)) * HTB)
#define PG8_STAGE(bufoff, gbase, voff) do { _Pragma("unroll") for (int _i = 0; _i < 2; ++_i) \
        __builtin_amdgcn_global_load_lds((const unsigned*)((const char*)(gbase) + (voff)[_i]), (PG8_LAS unsigned*)(lds + (bufoff) + ldsw + _i * 8192), 16, 0, 0); } while (0)
#define PG8_LDA(dst, b, h) do { _Pragma("unroll") for (int m = 0; m < 4; ++m) _Pragma("unroll") for (int k = 0; k < 2; ++k) dst[m][k] = *(const PG8_LAS bf16x8*)(lds + PG8_SA(b, h) + aoff + m * 2048 + k * 1024); } while (0)
#define PG8_LDB(dst, b, h) do { _Pragma("unroll") for (int n = 0; n < 2; ++n) _Pragma("unroll") for (int k = 0; k < 2; ++k) dst[n][k] = *(const PG8_LAS bf16x8*)(lds + PG8_SB(b, h) + boff + n * 2048 + k * 1024); } while (0)
#define PG8_MMA(ai, bj, At, Bt) do { __builtin_amdgcn_s_setprio(1); _Pragma("unroll") for (int m = 0; m < 4; ++m) _Pragma("unroll") for (int n = 0; n < 2; ++n) _Pragma("unroll") for (int k = 0; k < 2; ++k) \
        acc[ai][bj][m][n] = __builtin_amdgcn_mfma_f32_16x16x32_bf16(Bt[n][k], At[m][k], acc[ai][bj][m][n], 0, 0, 0); __builtin_amdgcn_s_setprio(0); } while (0)
#define PG8_WAIT_V(n) asm volatile("s_waitcnt vmcnt(" #n ")" ::: "memory")
#define PG8_WAIT_L(n) asm volatile("s_waitcnt lgkmcnt(" #n ")" ::: "memory")
#define PG8_BAR __builtin_amdgcn_s_barrier()
#define PG8_SCHED __builtin_amdgcn_sched_barrier(0)
    Unit cur, nxt; int ui = 0;
    if (!S.next(0, cur)) return;
    f32x4 acc[2][2][4][2];
#pragma unroll
    for (int a = 0; a < 2; ++a)
#pragma unroll
        for (int b = 0; b < 2; ++b)
#pragma unroll
            for (int m = 0; m < 4; ++m)
#pragma unroll
                for (int n = 0; n < 2; ++n) acc[a][b][m][n] = (f32x4){0.f, 0.f, 0.f, 0.f};
    bf16x8 At[4][2], B0[2][2], B1[2][2];
    const char* cA = (const char*)g.A + (size_t)cur.pm * tstep; const char* cB = (const char*)g.Bt + (size_t)cur.pn * tstep;
    S.a_ready(cur);
    if constexpr (SP2) {
        PG8_STAGE(PG8_SB(0, 0), cB, voffB); PG8_STAGE(PG8_SB(0, 1), cB + hstep, voffB); PG8_STAGE(PG8_SA(0, 0), cA, voffA); PG8_STAGE(PG8_SA(0, 1), cA + hstep, voffA);
        if (wr == 1) PG8_BAR;
        PG8_WAIT_V(2); PG8_BAR;
        PG8_STAGE(PG8_SB(1, 0), cB + kstep, voffB); PG8_STAGE(PG8_SA(1, 0), cA + kstep, voffA); PG8_STAGE(PG8_SB(1, 1), cB + hstep + kstep, voffB);
        PG8_WAIT_V(6); PG8_BAR;
    } else {
        PG8_STAGE(PG8_SB(0, 0), cB, voffB); PG8_STAGE(PG8_SA(0, 0), cA, voffA); PG8_STAGE(PG8_SB(0, 1), cB + hstep, voffB); PG8_STAGE(PG8_SA(0, 1), cA + hstep, voffA);
        if (wr == 1) PG8_BAR;
        PG8_WAIT_V(4); PG8_BAR;
        PG8_STAGE(PG8_SB(1, 0), cB + kstep, voffB); PG8_STAGE(PG8_SA(1, 0), cA + kstep, voffA); PG8_STAGE(PG8_SB(1, 1), cB + hstep + kstep, voffB);
        PG8_WAIT_V(6); PG8_BAR;
    }
    for (;;) {
        const bool has_next = S.next(ui + 1, nxt);
        const char* nA = has_next ? (const char*)g.A + (size_t)nxt.pm * tstep : cA; const char* nB = has_next ? (const char*)g.Bt + (size_t)nxt.pn * tstep : cB;
        for (int t = 0; t < nt; t += 2) {
            const bool last = (t == nt - 2);
            const char* a1 = cA + (size_t)(t + 1) * kstep;
            const char* a2 = last ? nA : cA + (size_t)(t + 2) * kstep; const char* b2 = last ? nB : cB + (size_t)(t + 2) * kstep;
            const char* a3 = a2 + kstep; const char* b3 = b2 + kstep;
            if (last && has_next) S.a_ready(nxt);
            if constexpr (SP2) {
            PG8_LDB(B0, 0, 0); PG8_LDB(B1, 0, 1); PG8_SCHED; PG8_LDA(At, 0, 0); PG8_STAGE(PG8_SA(1, 1), a1 + hstep, voffA);
            PG8_WAIT_V(8); PG8_WAIT_L(0); PG8_BAR; PG8_MMA(0, 0, At, B0); PG8_MMA(0, 1, At, B1); PG8_BAR; PG8_SCHED;
            PG8_LDA(At, 0, 1); PG8_STAGE(PG8_SB(0, 0), b2, voffB); PG8_STAGE(PG8_SB(0, 1), b2 + hstep, voffB); PG8_STAGE(PG8_SA(0, 0), a2, voffA);
            PG8_WAIT_V(8); PG8_WAIT_L(0); PG8_BAR; PG8_MMA(1, 0, At, B0); PG8_MMA(1, 1, At, B1); PG8_BAR; PG8_SCHED;
            PG8_LDB(B0, 1, 0); PG8_LDB(B1, 1, 1); PG8_SCHED; PG8_LDA(At, 1, 0); PG8_STAGE(PG8_SA(0, 1), a2 + hstep, voffA);
            PG8_WAIT_V(8); PG8_WAIT_L(0); PG8_BAR; PG8_MMA(0, 0, At, B0); PG8_MMA(0, 1, At, B1); PG8_BAR; PG8_SCHED;
            PG8_LDA(At, 1, 1); PG8_STAGE(PG8_SB(1, 0), b3, voffB); PG8_STAGE(PG8_SB(1, 1), b3 + hstep, voffB); PG8_STAGE(PG8_SA(1, 0), a3, voffA);
            PG8_WAIT_V(8); PG8_WAIT_L(0); PG8_BAR; PG8_MMA(1, 0, At, B0); PG8_MMA(1, 1, At, B1); PG8_BAR; PG8_SCHED;
            } else {
            PG8_LDB(B0, 0, 0); PG8_SCHED; PG8_LDA(At, 0, 0); PG8_STAGE(PG8_SA(1, 1), a1 + hstep, voffA);
            PG8_WAIT_L(8); PG8_BAR; PG8_WAIT_L(0); PG8_MMA(0, 0, At, B0); PG8_BAR; PG8_SCHED;
            PG8_LDB(B1, 0, 1); PG8_STAGE(PG8_SB(0, 0), b2, voffB);
            PG8_BAR; PG8_WAIT_L(0); PG8_MMA(0, 1, At, B1); PG8_BAR;
            PG8_LDA(At, 0, 1); PG8_STAGE(PG8_SA(0, 0), a2, voffA);
            PG8_BAR; PG8_WAIT_L(0); PG8_MMA(1, 0, At, B0); PG8_BAR; PG8_SCHED;
            PG8_STAGE(PG8_SB(0, 1), b2 + hstep, voffB);
            PG8_WAIT_V(6); PG8_BAR; PG8_MMA(1, 1, At, B1); PG8_BAR;
            PG8_LDB(B0, 1, 0); PG8_SCHED; PG8_LDA(At, 1, 0); PG8_STAGE(PG8_SA(0, 1), a2 + hstep, voffA);
            PG8_WAIT_L(8); PG8_BAR; PG8_WAIT_L(0); PG8_MMA(0, 0, At, B0); PG8_BAR; PG8_SCHED;
            PG8_LDB(B1, 1, 1); PG8_STAGE(PG8_SB(1, 0), b3, voffB);
            PG8_BAR; PG8_WAIT_L(0); PG8_MMA(0, 1, At, B1); PG8_BAR;
            PG8_LDA(At, 1, 1); PG8_STAGE(PG8_SA(1, 0), a3, voffA);
            PG8_BAR; PG8_WAIT_L(0); PG8_MMA(1, 0, At, B0); PG8_BAR; PG8_SCHED;
            PG8_STAGE(PG8_SB(1, 1), b3 + hstep, voffB);
            PG8_WAIT_V(6); PG8_BAR; PG8_MMA(1, 1, At, B1); PG8_BAR;
            }
        }
        if constexpr (ALIGN_EPI) { if (wr == 0) PG8_BAR; }
        if constexpr (!Epi::AFTER_DRAIN) { E(acc, cur, wr, wc, fr, fq); S.done(cur); }
        if (!has_next) break;
#pragma unroll
        for (int a = 0; a < 2; ++a)
#pragma unroll
            for (int b = 0; b < 2; ++b)
#pragma unroll
                for (int m = 0; m < 4; ++m)
#pragma unroll
                    for (int n = 0; n < 2; ++n) acc[a][b][m][n] = (f32x4){0.f, 0.f, 0.f, 0.f};
        cur = nxt; cA = nA; cB = nB; ++ui;
        if constexpr (ALIGN_EPI) { if (wr == 1) PG8_BAR; }
    }
    PG8_WAIT_V(0);
    if constexpr (!ALIGN_EPI) { if (wr == 0) PG8_BAR; }
    PG8_BAR;
    if constexpr (Epi::AFTER_DRAIN) { E.fused(acc, cur, wr, wc, fr, fq, lds, wid, lane); S.done(cur); }
#undef PG8_SA
#undef PG8_SB
#undef PG8_STAGE
#undef PG8_LDA
#undef PG8_LDB
#undef PG8_MMA
#undef PG8_WAIT_V
#undef PG8_WAIT_L
#undef PG8_BAR
#undef PG8_SCHED
}
}
#define PG8_SP2 true
#define PG8_ALIGN true
#define GAS __attribute__((address_space(1)))
#define LAS __attribute__((address_space(3)))
typedef unsigned short bf16;
typedef unsigned v4u __attribute__((ext_vector_type(4)));
typedef float f32x4 __attribute__((ext_vector_type(4)));
typedef short bf16x8 __attribute__((ext_vector_type(8)));
typedef GAS unsigned gu32;
typedef GAS unsigned long long gu64;
#define RLX_AGENT __ATOMIC_RELAXED, __HIP_MEMORY_SCOPE_AGENT
#define LDS_WAIT() asm volatile("s_waitcnt lgkmcnt(0)" ::: "memory")
#define VM_WAIT() asm volatile("s_waitcnt vmcnt(0)" ::: "memory")
__device__ __forceinline__ unsigned long long rt() { return __builtin_amdgcn_s_memrealtime(); }
__device__ __forceinline__ unsigned f2bf(float f) { unsigned u = __builtin_bit_cast(unsigned, f); return (u + 0x7fffu + ((u >> 16) & 1u)) >> 16; }
__device__ __forceinline__ unsigned pk2(float lo, float hi) { return f2bf(lo) | (f2bf(hi) << 16); }
#define XB_TMO      128
#define XB_XCNT(j)  (256  + 64 * (j))
#define XB_XSUB(j)  (1280 + 64 * (j))
#define XB_XGEN(j)  (2304 + 64 * (j))
#define XB_TOP      3328
#define XB_TOPGEN   3392
#define XCD_BAR_WORDS 3456
#define XB_SPIN_CAP (1u << 18)

__device__ __forceinline__ unsigned xb_ld(unsigned* p)              { return __hip_atomic_load(p, __ATOMIC_RELAXED, __HIP_MEMORY_SCOPE_AGENT); }
__device__ __forceinline__ unsigned xb_add(unsigned* p, unsigned v) { return __hip_atomic_fetch_add(p, v, __ATOMIC_RELAXED, __HIP_MEMORY_SCOPE_AGENT); }
__device__ __forceinline__ unsigned xb_xcc_id() { return (unsigned)__builtin_amdgcn_s_getreg((3 << 11) | 20) & 0xFu; }
#define XB_SPIN(cond, bar) do { unsigned _sp = 0; while (cond) { __builtin_amdgcn_s_sleep(1); \
    if ((++_sp & 255u) == 0u) { if (xb_ld(&(bar)[XB_TMO])) break; if (_sp > XB_SPIN_CAP) { atomicAdd(&(bar)[XB_TMO], 1u); break; } } } } while (0)

struct XcdBarrier {
    unsigned* bar; unsigned x;
    volatile LAS unsigned* st;
};

__device__ __forceinline__ XcdBarrier xcd_barrier_post(unsigned* bar, volatile LAS unsigned* st) {
    XcdBarrier b; b.bar = bar; b.x = xb_xcc_id(); b.st = st;
    if (threadIdx.x == 0) (void)xb_add(&bar[XB_XCNT(b.x)], 1u);
    return b;
}
__device__ __forceinline__ void xcd_barrier_complete(unsigned* bar, unsigned x, unsigned& nloc, unsigned& nx) {
    const unsigned G = gridDim.x * gridDim.y * gridDim.z;
    unsigned sum, cnt, mine, sp = 0u;
    for (;;) {
        sum = 0u; cnt = 0u; mine = 0u;
#pragma unroll
        for (unsigned j = 0; j < 16; ++j) { const unsigned c = xb_ld(&bar[XB_XCNT(j)]); sum += c; cnt += (c > 0u) ? 1u : 0u; mine = (j == x) ? c : mine; }
        if (sum == G) break;
        __builtin_amdgcn_s_sleep(1);
        if ((++sp & 255u) == 0u) { if (xb_ld(&bar[XB_TMO])) break; if (sp > XB_SPIN_CAP) { atomicAdd(&bar[XB_TMO], 1u); break; } }
    }
    nloc = mine > 0u ? mine : 1u; nx = cnt > 0u ? cnt : 1u;
}

__device__ __forceinline__ void xcd_barrier(const XcdBarrier& b) {
    asm volatile("s_waitcnt vmcnt(0)" ::: "memory");
    __syncthreads();
    if (threadIdx.x == 0) {
        unsigned* bar = b.bar;
        __builtin_amdgcn_s_waitcnt(0);
        unsigned nloc = b.st[0], nx = b.st[1];
        if (nloc == 0u) { xcd_barrier_complete(bar, b.x, nloc, nx); b.st[0] = nloc; b.st[1] = nx; }
        const unsigned old = xb_add(&bar[XB_XSUB(b.x)], 1u);
        const unsigned gen = old / nloc;
        if (old + 1u == (gen + 1u) * nloc) {
            __builtin_amdgcn_fence(__ATOMIC_RELEASE, "agent");
            asm volatile("s_waitcnt vmcnt(0)" ::: "memory");
            const unsigned og = xb_add(&bar[XB_TOP], 1u);
            const unsigned tg = og / nx;
            if (og + 1u == (tg + 1u) * nx) xb_add(&bar[XB_TOPGEN], 1u);
            else XB_SPIN(xb_ld(&bar[XB_TOPGEN]) == tg, bar);
            __builtin_amdgcn_fence(__ATOMIC_ACQUIRE, "agent");
            xb_add(&bar[XB_XGEN(b.x)], 1u);
            asm volatile("s_waitcnt vmcnt(0)" ::: "memory");
        } else {
            XB_SPIN(xb_ld(&bar[XB_XGEN(b.x)]) == gen, bar);
            __builtin_amdgcn_fence(__ATOMIC_ACQUIRE, "agent");
            asm volatile("s_waitcnt vmcnt(0)" ::: "memory");
        }
    }
    __syncthreads();
}

constexpr int NWAVES = 8;
constexpr int BATCH = 4, SEQ = 8192, D = 1024, M = BATCH * SEQ, FF = 2816, NH = 8, DK = 128, DV = 128;
constexpr int IN_COLS = 7712, NMOD = 9;
constexpr int N_IN1 = 19 * 256, N_IN2 = 12 * 256;
constexpr float EPS = 1e-6f;
#ifndef MK_SPLIT
#define MK_SPLIT 1
#endif
constexpr int NPHASE = 19;

constexpr size_t MiB = 1u << 20;
constexpr size_t WS_CTL = 0, CTL_ZERO_BYTES = 64 * 1024;
constexpr size_t WS_MOD = 256 * 1024;
constexpr size_t WS_WUP1 = 1 * MiB, WS_WDN1 = 12 * MiB, WS_WUP2 = 18 * MiB, WS_WDN2 = 29 * MiB, WS_WIN1 = 35 * MiB, WS_WIN2 = 45 * MiB, WS_WA = 51 * MiB, WS_WB = 52 * MiB, WS_WO = 54 * MiB;
constexpr size_t WS_XN = 56 * MiB;
constexpr size_t WS_HID = 120 * MiB;
constexpr size_t WS_QRAW = 120 * MiB, WS_KRAW = 184 * MiB, WS_VRAW = 248 * MiB;
constexpr size_t WS_CAB = 312 * MiB, WS_CV = 344 * MiB;
constexpr size_t WS_QF = 376 * MiB;
constexpr size_t WS_YA = 440 * MiB;
constexpr size_t WS_BA = 472 * MiB;
constexpr size_t WS_GB = 476 * MiB;
constexpr size_t WS_END = 480 * MiB;
constexpr size_t WS_KF = WS_QRAW, WS_VF = WS_KRAW;
constexpr size_t WS_OF = WS_VRAW, WS_OB = WS_CAB;
constexpr size_t WS_SGA = WS_QF, WS_SGB = WS_QRAW;
static_assert(WS_WUP1 + (size_t)2 * FF * D * 2 <= WS_WDN1 && WS_WDN1 + (size_t)D * FF * 2 <= WS_WUP2 && WS_WIN1 + (size_t)N_IN1 * D * 2 <= WS_WIN2 && WS_WIN2 + (size_t)N_IN2 * D * 2 <= WS_WA && WS_WO + 2 * MiB <= WS_XN, "weights map");
static_assert(WS_HID + (size_t)M * FF * 2 <= WS_CAB + 64 * MiB && WS_GB + (size_t)4 * M * 8 * 4 <= WS_END, "activation map");

constexpr int RING_OFF = 0, RING_BYTES = 131072;
constexpr int LDSCTL_OFF = RING_BYTES, MISC_OFF = LDSCTL_OFF + 320;
constexpr int LDS_BYTES = 147456;

struct Args { const float* in[23]; float* out; unsigned char* ws; int ph_lo, ph_hi; };
enum { I_X = 0, I_C, I_WADA, I_BADA, I_NF1, I_WUP1, I_WDN1, I_NMIX, I_WIN, I_CONVA, I_CONVDN, I_ALF, I_DTF, I_ALB, I_DTB, I_DNNORM, I_WAO, I_WBO, I_WOUT, I_NF2, I_WUP2, I_WDN2, I_NFIN };

__device__ __forceinline__ float wave_sum(float v) {
#pragma unroll
    for (int o = 1; o < 64; o <<= 1) v += __shfl_xor(v, o);
    return v;
}
__device__ __forceinline__ float sum16(float v) {
#pragma unroll
    for (int o = 1; o < 16; o <<= 1) v += __shfl_xor(v, o);
    return v;
}
__device__ __forceinline__ float bf2f(unsigned short b) { return __uint_as_float((unsigned)b << 16); }
__device__ __forceinline__ void unpack8f(v4u w, float* f) {
    f[0] = __uint_as_float(w.x << 16); f[1] = __uint_as_float(w.x & 0xffff0000u); f[2] = __uint_as_float(w.y << 16); f[3] = __uint_as_float(w.y & 0xffff0000u);
    f[4] = __uint_as_float(w.z << 16); f[5] = __uint_as_float(w.z & 0xffff0000u); f[6] = __uint_as_float(w.w << 16); f[7] = __uint_as_float(w.w & 0xffff0000u); }
__device__ __forceinline__ v4u pack8f(const float* f) { v4u w; w.x = pk2(f[0], f[1]); w.y = pk2(f[2], f[3]); w.z = pk2(f[4], f[5]); w.w = pk2(f[6], f[7]); return w; }
__device__ __forceinline__ float sigmoidf_(float x) { return 1.0f / (1.0f + __expf(-x)); }
__device__ __forceinline__ float siluf_(float x) { return x / (1.0f + __expf(-x)); }

__device__ __forceinline__ void transpose_item(const float* W, int N, int K, bf16* dst0  , int k0, int n0, LAS float* scr, int lane) {
#pragma unroll 8
    for (int i = 0; i < 32; ++i) { const int kk = 2 * i + (lane >> 5); scr[kk * 33 + (lane & 31)] = W[(size_t)(k0 + kk) * N + n0 + (lane & 31)]; }
    LDS_WAIT(); asm volatile("" ::: "memory");
    const int c = lane & 7;
#pragma unroll
    for (int j = 0; j < 4; ++j) { const int n = (lane >> 3) + 8 * j; const LAS float* s = scr + (8 * c) * 33 + n;
        v4u o; o.x = pk2(s[0 * 33], s[1 * 33]); o.y = pk2(s[2 * 33], s[3 * 33]); o.z = pk2(s[4 * 33], s[5 * 33]); o.w = pk2(s[6 * 33], s[7 * 33]);
        *(GAS v4u*)(dst0 + (size_t)n * K + k0 + 8 * c) = o; }
    LDS_WAIT(); asm volatile("" ::: "memory");
}
__device__ __forceinline__ int up_row(int n0) { const int part = n0 / FF, j = n0 % FF; return 256 * (j / 128) + 128 * part + (j % 128); }

__device__ __forceinline__ void phase_prologue(const Args& a, LAS unsigned char* lds, int tid, int lane, int wave) {
    unsigned char* ws = a.ws;
    LAS float* cact = (LAS float*)lds;
    LAS float* red = (LAS float*)(lds + 16384);
    for (int i = tid; i < 4096; i += 512) cact[i] = siluf_(a.in[I_C][i]);
    __syncthreads();
    float* mod = (float*)(ws + WS_MOD);
    for (int it = blockIdx.x; it < (NMOD * D) / 32; it += gridDim.x) {
        const int n0 = it * 32, col = tid & 31, kg = tid >> 5;
        float a0 = 0.f, a1 = 0.f, a2 = 0.f, a3 = 0.f;
        const float* wp = a.in[I_WADA] + (size_t)(kg * 64) * (NMOD * D) + n0 + col;
#pragma unroll 8
        for (int kk = 0; kk < 64; ++kk) { const float w = wp[(size_t)kk * (NMOD * D)]; const int k = kg * 64 + kk;
            a0 += cact[k] * w; a1 += cact[1024 + k] * w; a2 += cact[2048 + k] * w; a3 += cact[3072 + k] * w; }
        red[(kg * 4 + 0) * 32 + col] = a0; red[(kg * 4 + 1) * 32 + col] = a1; red[(kg * 4 + 2) * 32 + col] = a2; red[(kg * 4 + 3) * 32 + col] = a3;
        __syncthreads();
        if (tid < 128) { const int b = tid >> 5, c2 = tid & 31; float s = 0.f;
#pragma unroll
            for (int g = 0; g < 16; ++g) s += red[(g * 4 + b) * 32 + c2];
            mod[b * (NMOD * D) + n0 + c2] = s + a.in[I_BADA][n0 + c2]; }
        __syncthreads();
    }
    __syncthreads();
    LAS float* scr = (LAS float*)(lds + wave * 16384);
    const int gw = blockIdx.x * NWAVES + wave, NGW = gridDim.x * NWAVES;
    constexpr int I_UP = (D / 64) * (2 * FF / 32), I_DN = (FF / 64) * (D / 32), I_IN = (D / 64) * (IN_COLS / 32), I_A = (512 / 64) * (D / 32), I_B = (D / 64) * (D / 32);
    constexpr int NITEMS = 2 * I_UP + 2 * I_DN + I_IN + I_A + 2 * I_B;
    for (int it = gw; it < NITEMS; it += NGW) {
        int r = it;
        if (r < 2 * I_UP) { const int wsel = r / I_UP; r %= I_UP; const int nblk = 2 * FF / 32, kb = r / nblk, nb = r % nblk;
            const float* W = a.in[wsel ? I_WUP2 : I_WUP1]; bf16* dst = (bf16*)(ws + (wsel ? WS_WUP2 : WS_WUP1));
            transpose_item(W, 2 * FF, D, dst + (size_t)up_row(32 * nb) * D, 64 * kb, 32 * nb, scr, lane); continue; }
        r -= 2 * I_UP;
        if (r < 2 * I_DN) { const int wsel = r / I_DN; r %= I_DN; const int nblk = D / 32, kb = r / nblk, nb = r % nblk;
            const float* W = a.in[wsel ? I_WDN2 : I_WDN1]; bf16* dst = (bf16*)(ws + (wsel ? WS_WDN2 : WS_WDN1));
            transpose_item(W, D, FF, dst + (size_t)(32 * nb) * FF, 64 * kb, 32 * nb, scr, lane); continue; }
        r -= 2 * I_DN;
        if (r < I_IN) { const int nblk = IN_COLS / 32, kb = r / nblk, nb = r % nblk, n0 = 32 * nb;
            bf16* dst;
            if (n0 < 512) dst = (bf16*)(ws + WS_WIN1) + (size_t)(1024 + n0) * D;
            else if (n0 < 1024) { const int j = n0 - 512; dst = (bf16*)(ws + WS_WIN1) + (size_t)(256 * (j / 128) + (j % 128)) * D; }
            else if (n0 < 1536) { const int j = n0 - 1024; dst = (bf16*)(ws + WS_WIN1) + (size_t)(256 * (j / 128) + 128 + (j % 128)) * D; }
            else if (n0 < 4608) dst = (bf16*)(ws + WS_WIN1) + (size_t)n0 * D;
            else if (n0 < 5632) dst = (bf16*)(ws + WS_WIN2) + (size_t)(n0 - 4608) * D;
            else if (n0 < 5664) dst = (bf16*)(ws + WS_WIN1) + (size_t)(4608 + n0 - 5632) * D;
            else dst = (bf16*)(ws + WS_WIN2) + (size_t)(1024 + n0 - 5664) * D;
            transpose_item(a.in[I_WIN], IN_COLS, D, dst, 64 * kb, n0, scr, lane); continue; }
        r -= I_IN;
        if (r < I_A) { const int nblk = D / 32, kb = r / nblk, nb = r % nblk; transpose_item(a.in[I_WAO], D, 512, (bf16*)(ws + WS_WA) + (size_t)(32 * nb) * 512, 64 * kb, 32 * nb, scr, lane); continue; }
        r -= I_A;
        { const int wsel = r / I_B; r %= I_B; const int nblk = D / 32, kb = r / nblk, nb = r % nblk;
          transpose_item(a.in[wsel ? I_WOUT : I_WBO], D, D, (bf16*)(ws + (wsel ? WS_WO : WS_WB)) + (size_t)(32 * nb) * D, 64 * kb, 32 * nb, scr, lane); }
    }
    { GAS v4u* z = (GAS v4u*)((bf16*)(ws + WS_WIN1) + (size_t)4640 * D); const int nz = (4864 - 4640) * D * 2 / 16;
      for (int i = blockIdx.x * 512 + tid; i < nz; i += gridDim.x * 512) z[i] = (v4u){0u, 0u, 0u, 0u}; }
}

__device__ __forceinline__ void phase_norm_mod(const float* src, const float* nw, const float* mod, int mi, bf16* dst, int lane, int wave) {
    const int gw = blockIdx.x * NWAVES + wave, NGW = gridDim.x * NWAVES;
    for (int m = gw; m < M; m += NGW) {
        const int b = m / SEQ; const float* sh = mod + b * (NMOD * D) + mi * D; const float* sc = sh + D;
        const GAS f32x4* xr = (const GAS f32x4*)(src + (size_t)m * D) + lane;
        f32x4 v[4]; float s = 0.f;
#pragma unroll
        for (int j = 0; j < 4; ++j) { v[j] = xr[64 * j]; s += (v[j].x * v[j].x + v[j].y * v[j].y) + (v[j].z * v[j].z + v[j].w * v[j].w); }
        const float rstd = 1.0f / sqrtf(wave_sum(s) * (1.f / D) + EPS);
        GAS unsigned long long* o8 = (GAS unsigned long long*)(dst + (size_t)m * D) + lane;
#pragma unroll
        for (int j = 0; j < 4; ++j) { const int c = 4 * lane + 256 * j; const f32x4 w = *(const f32x4*)(nw + c), s1 = *(const f32x4*)(sc + c), s0 = *(const f32x4*)(sh + c);
            const f32x4 y = v[j] * rstd * w * (s1 + 1.0f) + s0;
            o8[64 * j] = (unsigned long long)pk2(y.x, y.y) | ((unsigned long long)pk2(y.z, y.w) << 32); }
    }
}
__device__ __forceinline__ void phase_final_norm(float* io, const float* nw, int lane, int wave) {
    const int gw = blockIdx.x * NWAVES + wave, NGW = gridDim.x * NWAVES;
    for (int m = gw; m < M; m += NGW) {
        GAS f32x4* xr = (GAS f32x4*)(io + (size_t)m * D) + lane;
        f32x4 v[4]; float s = 0.f;
#pragma unroll
        for (int j = 0; j < 4; ++j) { v[j] = xr[64 * j]; s += (v[j].x * v[j].x + v[j].y * v[j].y) + (v[j].z * v[j].z + v[j].w * v[j].w); }
        const float rstd = 1.0f / sqrtf(wave_sum(s) * (1.f / D) + EPS);
#pragma unroll
        for (int j = 0; j < 4; ++j) { const f32x4 w = *(const f32x4*)(nw + 4 * lane + 256 * j); xr[64 * j] = v[j] * rstd * w; }
    }
}
__device__ __forceinline__ void phase_conv_qkv(const bf16* src, bf16* dst, const float* cw  , bool do_norm, float scale, int lane, int wave) {
    const int gw = blockIdx.x * NWAVES + wave, NGW = gridDim.x * NWAVES;
    const int h = gw & 7, rs = lane >> 4, cp = lane & 15, c0 = h * 128 + 8 * cp;
    float w[5][8];
#pragma unroll
    for (int i = 0; i < 5; ++i)
#pragma unroll
        for (int e = 0; e < 8; ++e) w[i][e] = cw[i * 3072 + c0 + e];
    for (int it = gw; it < (M / 4) * 8; it += NGW) {
        const int rg = it >> 3, row = 4 * rg + rs, s = row & (SEQ - 1);
        float acc[8];
#pragma unroll
        for (int e = 0; e < 8; ++e) acc[e] = 0.f;
#pragma unroll
        for (int i = 0; i < 5; ++i) { const int ss = s + i - 2;
            if (ss >= 0 && ss < SEQ) { float x[8]; unpack8f(*(const GAS v4u*)(src + (size_t)(row + i - 2) * D + c0), x);
#pragma unroll
                for (int e = 0; e < 8; ++e) acc[e] += x[e] * w[i][e]; } }
        float ssq = 0.f;
#pragma unroll
        for (int e = 0; e < 8; ++e) { acc[e] = siluf_(acc[e]); ssq += acc[e] * acc[e]; }
        if (do_norm) { const float r = scale / sqrtf(sum16(ssq) + EPS);
#pragma unroll
            for (int e = 0; e < 8; ++e) acc[e] *= r; }
        *(GAS v4u*)(dst + (size_t)row * D + c0) = pack8f(acc);
    }
}
__device__ __forceinline__ void phase_ya(const bf16* cab, const bf16* cv, const float* cw  , bf16* ya, int lane, int wave) {
    const int gw = blockIdx.x * NWAVES + wave, NGW = gridDim.x * NWAVES, c0 = 8 * lane;
    float w[3][8];
#pragma unroll
    for (int i = 0; i < 3; ++i)
#pragma unroll
        for (int e = 0; e < 8; ++e) w[i][e] = cw[i * 512 + c0 + e];
    for (int row = gw; row < M; row += NGW) {
        const int s = row & (SEQ - 1); float acc[8];
#pragma unroll
        for (int e = 0; e < 8; ++e) acc[e] = 0.f;
#pragma unroll
        for (int i = 0; i < 3; ++i) { const int ss = s + i - 1;
            if (ss >= 0 && ss < SEQ) { float x[8]; unpack8f(*(const GAS v4u*)(cv + (size_t)(row + i - 1) * 512 + c0), x);
#pragma unroll
                for (int e = 0; e < 8; ++e) acc[e] += x[e] * w[i][e]; } }
        float g[8]; unpack8f(*(const GAS v4u*)(cab + (size_t)row * 512 + c0), g);
#pragma unroll
        for (int e = 0; e < 8; ++e) acc[e] *= g[e];
        *(GAS v4u*)(ya + (size_t)row * 512 + c0) = pack8f(acc);
    }
}
__device__ __forceinline__ void phase_gb(const Args& a, const float* ba, float* gb, int tid) {
    for (int i = blockIdx.x * 512 + tid; i < M * 32; i += gridDim.x * 512) {
        const int row = i >> 5, j = i & 31, part = j >> 3, h = j & 7; const float x = ba[i]; float r;
        if (part < 2) r = sigmoidf_(x);
        else { const float al = a.in[part == 2 ? I_ALF : I_ALB][h], dt = a.in[part == 2 ? I_DTF : I_DTB][h]; const float y = x + dt;
            const float sp = y > 20.f ? y : log1pf(__expf(y)); r = -__expf(al) * sp; }
        gb[(size_t)part * M * 8 + (size_t)row * 8 + h] = r;
    }
}
__device__ __forceinline__ void phase_scan_ref(const bf16* Q, const bf16* K, const bf16* V, const float* gbuf, bf16* OF, bf16* OB, LAS unsigned char* lds, int tid, int lane, int wave) {
    constexpr int TB = 16;
    LAS float* Kt = (LAS float*)lds;
    LAS float* Qt = Kt + TB * 128;
    LAS float* Vt = Qt + TB * 128;
    LAS float* sc = Vt + TB * 128;
    typedef float f2 __attribute__((ext_vector_type(2)));
    LAS f2* red = (LAS f2*)(sc + 64);
    const int e = tid & 127, dp = tid >> 7;
    for (int ci = blockIdx.x; ci < BATCH * NH * 2; ci += gridDim.x) {
        const int b = ci >> 4, h = (ci >> 1) & 7, dir = ci & 1;
        const float* beta = gbuf + (size_t)dir * M * 8; const float* gl = gbuf + (size_t)(2 + dir) * M * 8; bf16* O = dir ? OB : OF;
        float S[32];
#pragma unroll
        for (int d = 0; d < 32; ++d) S[d] = 0.f;
        int par = 0;
        for (int p0 = 0; p0 < SEQ; p0 += TB) {
            __syncthreads();
#pragma unroll
            for (int r = 0; r < 4; ++r) { const int i = tid + 512 * r, tt = i >> 7, col = i & 127; const int s = dir ? (SEQ - 1 - (p0 + tt)) : (p0 + tt);
                const size_t off = (size_t)(b * SEQ + s) * D + h * 128 + col;
                Kt[i] = bf2f(K[off]); Qt[i] = bf2f(Q[off]); Vt[i] = bf2f(V[off]); }
            if (tid < TB) { const int s = dir ? (SEQ - 1 - (p0 + tid)) : (p0 + tid); const size_t off = (size_t)(b * SEQ + s) * 8 + h; sc[tid] = __expf(gl[off]); sc[16 + tid] = beta[off]; }
            __syncthreads();
            { const int t0 = 2 * wave;
#pragma unroll
              for (int q = 0; q < 2; ++q) { const int tt = t0 + q; float s = Kt[tt * 128 + lane] * Qt[tt * 128 + lane] + Kt[tt * 128 + 64 + lane] * Qt[tt * 128 + 64 + lane]; s = wave_sum(s); if (lane == 0) sc[32 + tt] = s; } }
            __syncthreads();
            for (int tt = 0; tt < TB; ++tt) {
                float r = 0.f, oq = 0.f; float kd[32];
#pragma unroll
                for (int d = 0; d < 32; ++d) { kd[d] = Kt[tt * 128 + 32 * dp + d]; r += kd[d] * S[d]; oq += Qt[tt * 128 + 32 * dp + d] * S[d]; }
                red[(par * 4 + dp) * 128 + e] = (f2){r, oq};
                __syncthreads();
                const f2 r0 = red[(par * 4 + 0) * 128 + e], r1 = red[(par * 4 + 1) * 128 + e], r2 = red[(par * 4 + 2) * 128 + e], r3 = red[(par * 4 + 3) * 128 + e];
                const float R = (r0.x + r1.x) + (r2.x + r3.x), OQ = (r0.y + r1.y) + (r2.y + r3.y);
                const float eg = sc[tt], vn = sc[16 + tt] * (Vt[tt * 128 + e] - eg * R);
#pragma unroll
                for (int d = 0; d < 32; ++d) S[d] = eg * S[d] + kd[d] * vn;
                if (dp == 0) { const int s = dir ? (SEQ - 1 - (p0 + tt)) : (p0 + tt); const float o = eg * OQ + sc[32 + tt] * vn;
                    O[(size_t)(b * SEQ + s) * D + h * 128 + e] = (bf16)f2bf(o); }
                par ^= 1;
            }
        }
        __syncthreads();
    }
}
__device__ __forceinline__ void phase_onorm(bf16* of, const bf16* ob, const float* dnw, int lane, int wave) {
    const int gw = blockIdx.x * NWAVES + wave, NGW = gridDim.x * NWAVES, hh = lane >> 4, cp = lane & 15;
    float w[8];
#pragma unroll
    for (int e = 0; e < 8; ++e) w[e] = dnw[8 * cp + e];
    for (int it = gw; it < M * 2; it += NGW) {
        const int row = it >> 1, half = it & 1; const size_t off = (size_t)row * D + (4 * half + hh) * 128 + 8 * cp;
        float x[8], y[8]; unpack8f(*(const GAS v4u*)(of + off), x); unpack8f(*(const GAS v4u*)(ob + off), y);
        float ssq = 0.f;
#pragma unroll
        for (int e = 0; e < 8; ++e) { x[e] += y[e]; ssq += x[e] * x[e]; }
        const float r = 1.0f / sqrtf(sum16(ssq) * (1.f / 128.f) + EPS);
#pragma unroll
        for (int e = 0; e < 8; ++e) x[e] = x[e] * r * w[e];
        *(GAS v4u*)(of + off) = pack8f(x);
    }
}

template <class Epi> __device__ __forceinline__ void run_gemm(LAS unsigned char* lds, const bf16* A, const bf16* Bt, int N, int K, const Epi& E) {
    pg8::Gemm g{A, Bt, M, N, K}; pg8::StaticOrder S; S.init(M, N, (int)gridDim.x, (int)blockIdx.x);
    pg8::gemm_phase<Epi, pg8::StaticOrder, true, true>(lds, g, S, E);
}

__global__ void __launch_bounds__(NWAVES * 64, 2) mk_fwd(Args args) {
    extern __shared__ __attribute__((aligned(16))) unsigned char lds_raw[];
    LAS unsigned char* lds = (LAS unsigned char*)lds_raw;
    volatile LAS unsigned* MISC = (volatile LAS unsigned*)(lds + MISC_OFF);
    const int tid = threadIdx.x, lane = tid & 63, wave = __builtin_amdgcn_readfirstlane(tid >> 6);
    unsigned char* ws = args.ws;
    for (int u = tid; u < (LDS_BYTES - LDSCTL_OFF) / 4; u += NWAVES * 64) ((LAS unsigned*)(lds + LDSCTL_OFF))[u] = 0u;
    __syncthreads();
    XcdBarrier bar; bar.bar = (unsigned*)(ws + WS_CTL); bar.x = 0; bar.st = nullptr;
    const int lo = args.ph_lo, hi = args.ph_hi;
    if (hi - lo > 1) bar = xcd_barrier_post((unsigned*)(ws + WS_CTL), MISC + 8);
    float* mod = (float*)(ws + WS_MOD);
    float* hbuf = args.out;
    bf16* XN = (bf16*)(ws + WS_XN); bf16* HID = (bf16*)(ws + WS_HID);


#define IN(k) (lo <= (k) && (k) < hi)
#define SEAM(k) do { if (IN(k) && IN((k) + 1)) xcd_barrier(bar); } while (0)
    if (IN(0)) { phase_prologue(args, lds, tid, lane, wave); } SEAM(0);
    if (IN(1)) { phase_norm_mod(args.in[I_X], args.in[I_NF1], mod, 0, XN, lane, wave); } SEAM(1);
    if (IN(2)) { pg8::EpiGlu E{HID, FF}; run_gemm(lds, XN, (const bf16*)(ws + WS_WUP1), 2 * FF, D, E); } SEAM(2);
    if (IN(3)) { pg8::EpiRes E{args.in[I_X], hbuf, mod + 2 * D, NMOD * D, 0.5f, 13}; run_gemm(lds, HID, (const bf16*)(ws + WS_WDN1), D, FF, E); } SEAM(3);
    if (IN(4)) { phase_norm_mod(hbuf, args.in[I_NMIX], mod, 3, XN, lane, wave); } SEAM(4);
    if (IN(5)) { pg8::EpiIn1 E{(bf16*)(ws + WS_CV), (bf16*)(ws + WS_CAB), (bf16*)(ws + WS_QRAW), (size_t)M * D, (float*)(ws + WS_BA)};
        run_gemm(lds, XN, (const bf16*)(ws + WS_WIN1), N_IN1, D, E); } SEAM(5);
    if (IN(6)) { phase_conv_qkv((const bf16*)(ws + WS_QRAW), (bf16*)(ws + WS_QF), args.in[I_CONVDN], true, 0.08838834764831845f, lane, wave);
        phase_ya((const bf16*)(ws + WS_CAB), (const bf16*)(ws + WS_CV), args.in[I_CONVA], (bf16*)(ws + WS_YA), lane, wave);
        phase_gb(args, (const float*)(ws + WS_BA), (float*)(ws + WS_GB), tid); } SEAM(6);
    if (IN(7)) { phase_conv_qkv((const bf16*)(ws + WS_KRAW), (bf16*)(ws + WS_KF), args.in[I_CONVDN] + 1024, true, 1.0f, lane, wave); } SEAM(7);
    if (IN(8)) { phase_conv_qkv((const bf16*)(ws + WS_VRAW), (bf16*)(ws + WS_VF), args.in[I_CONVDN] + 2048, false, 1.0f, lane, wave); } SEAM(8);
    if (IN(9)) { phase_scan_ref((const bf16*)(ws + WS_QF), (const bf16*)(ws + WS_KF), (const bf16*)(ws + WS_VF), (const float*)(ws + WS_GB), (bf16*)(ws + WS_OF), (bf16*)(ws + WS_OB), lds, tid, lane, wave); } SEAM(9);
    if (IN(10)) { phase_onorm((bf16*)(ws + WS_OF), (const bf16*)(ws + WS_OB), args.in[I_DNNORM], lane, wave); } SEAM(10);
    if (IN(11)) { pg8::EpiIn2 E{(bf16*)(ws + WS_OF), (bf16*)(ws + WS_SGA), (bf16*)(ws + WS_SGB)}; run_gemm(lds, XN, (const bf16*)(ws + WS_WIN2), N_IN2, D, E); } SEAM(11);
    if (IN(12)) { pg8::EpiMul E{(bf16*)(ws + WS_SGA)}; run_gemm(lds, (const bf16*)(ws + WS_YA), (const bf16*)(ws + WS_WA), D, 512, E); } SEAM(12);
    if (IN(13)) { pg8::EpiMerge E{(const bf16*)(ws + WS_SGA), (bf16*)(ws + WS_SGB)}; run_gemm(lds, (const bf16*)(ws + WS_OF), (const bf16*)(ws + WS_WB), D, D, E); } SEAM(13);
    if (IN(14)) { pg8::EpiRes E{hbuf, hbuf, mod + 5 * D, NMOD * D, 1.0f, 13}; run_gemm(lds, (const bf16*)(ws + WS_SGB), (const bf16*)(ws + WS_WO), D, D, E); } SEAM(14);
    if (IN(15)) { phase_norm_mod(hbuf, args.in[I_NF2], mod, 6, XN, lane, wave); } SEAM(15);
    if (IN(16)) { pg8::EpiGlu E{HID, FF}; run_gemm(lds, XN, (const bf16*)(ws + WS_WUP2), 2 * FF, D, E); } SEAM(16);
    if (IN(17)) { pg8::EpiRes E{hbuf, hbuf, mod + 8 * D, NMOD * D, 0.5f, 13}; run_gemm(lds, HID, (const bf16*)(ws + WS_WDN2), D, FF, E); } SEAM(17);
    if (IN(18)) { phase_final_norm(hbuf, args.in[I_NFIN], lane, wave); }
#undef IN
#undef SEAM
}

extern "C" void kernel_launch(void* const* d_in, const int* in_sizes, int n_in, void* d_out, int out_size, void* d_ws, size_t ws_size, hipStream_t stream) {
    static int grid = 0;
    if (grid == 0) {
        if (n_in != 23 || in_sizes[0] != M * D || out_size != M * D || ws_size < WS_END) { fprintf(stderr, "kernel_launch: unexpected problem: n_in %d in0 %d out %d ws %zu (need %zu)\n", n_in, n_in > 0 ? in_sizes[0] : -1, out_size, ws_size, (size_t)WS_END); grid = -1; return; }
        int dev = 0, cus = 0, per_cu = 0;
        if (hipGetDevice(&dev) != hipSuccess || hipDeviceGetAttribute(&cus, hipDeviceAttributeMultiprocessorCount, dev) != hipSuccess) { grid = -1; return; }
        if (hipFuncSetAttribute((const void*)mk_fwd, hipFuncAttributeMaxDynamicSharedMemorySize, LDS_BYTES) != hipSuccess) { fprintf(stderr, "kernel_launch: hipFuncSetAttribute failed\n"); grid = -1; return; }
        if (hipOccupancyMaxActiveBlocksPerMultiprocessor(&per_cu, (const void*)mk_fwd, NWAVES * 64, LDS_BYTES) != hipSuccess || per_cu < 1)
            fprintf(stderr, "kernel_launch: note: occupancy query reports %d workgroups per CU\n", per_cu);
        (void)hipGetLastError();
        grid = cus;
    }
    if (grid < 0) return;
    (void)hipMemsetAsync((char*)d_ws + WS_CTL, 0, CTL_ZERO_BYTES, stream);
    Args a{};
    for (int i = 0; i < 23; ++i) a.in[i] = (const float*)d_in[i];
    a.out = (float*)d_out; a.ws = (unsigned char*)d_ws;
#if MK_SPLIT
    for (int ph = 0; ph < NPHASE; ++ph) { a.ph_lo = ph; a.ph_hi = ph + 1; hipLaunchKernelGGL(mk_fwd, dim3(grid), dim3(NWAVES * 64), LDS_BYTES, stream, a); }
#else
    a.ph_lo = 0; a.ph_hi = NPHASE; hipLaunchKernelGGL(mk_fwd, dim3(grid), dim3(NWAVES * 64), LDS_BYTES, stream, a);
#endif
    const hipError_t le = hipPeekAtLastError();
    if (le != hipSuccess) fprintf(stderr, "kernel_launch: launch failed: %s\n", hipGetErrorName(le));
}
```

```cpp
#include <hip/hip_runtime.h>
#include <cstdio>
#include <cstdint>
namespace pg8 {
#define PG8_LAS __attribute__((address_space(3)))
typedef unsigned short bf16_t;
typedef short bf16x8 __attribute__((ext_vector_type(8)));
typedef float f32x4 __attribute__((ext_vector_type(4)));
typedef unsigned u32x4 __attribute__((ext_vector_type(4)));
constexpr int BM = 256, BK = 64, HALF = 128, HTB = HALF * BK * 2  , STAGE_BYTES = 8 * HTB, NXCD = 8, WGM = 8;

__host__ __device__ __forceinline__ int lds_byte(int r, int c) { const int st = (r >> 4) * 2 + (c >> 5), rr = r & 15, cc = c & 31, ob = rr * 64 + cc * 2; return st * 1024 + (ob ^ (((ob >> 9) & 1) << 5)); }
__host__ __device__ __forceinline__ void stage_rc(int b, int& R, int& C) { const int st = b / 1024, sb = b % 1024, swz = sb ^ (((sb >> 9) & 1) << 5); R = (st >> 1) * 16 + swz / 64; C = (st & 1) * 32 + (swz % 64) / 2; }
__host__ __device__ __forceinline__ int perm32(int rho) { const int n = rho >> 4, i = rho & 15; return 8 * (i >> 2) + 4 * n + (i & 3); }

struct Unit { int pm, pn; };
struct Gemm { const bf16_t* A; const bf16_t* Bt; int M, N, K; };

struct StaticOrder {
    int nM, nN, nwg, G, c;
    __host__ __device__ void init(int M, int N, int G_, int c_) { nM = M / BM; nN = N / BM; nwg = nM * nN; G = G_; c = c_; }
    __host__ __device__ bool next(int i, Unit& u) const {
        const long L = (long)i * G + c; if (L >= nwg) return false;
        int wgid = (int)L; { const int q = nwg / NXCD, r = nwg % NXCD, xcd = wgid % NXCD, off = wgid / NXCD; wgid = (xcd < r ? xcd * (q + 1) : r * (q + 1) + (xcd - r) * q) + off; }
        const int nig = WGM * nN, gid = wgid / nig, fm = gid * WGM, gsz = (nM - fm) < WGM ? (nM - fm) : WGM;
        u.pm = fm + ((wgid % nig) % gsz); u.pn = (wgid % nig) / gsz; return true;
    }
    __device__ __forceinline__ void a_ready(const Unit&) const {}
    __device__ __forceinline__ void done(const Unit&) const {}
};
__device__ __forceinline__ unsigned cvt_pk_bf16(float lo, float hi) { typedef float f32x2_ __attribute__((ext_vector_type(2))); typedef __bf16 bf16x2_ __attribute__((ext_vector_type(2)));
    const f32x2_ v = {lo, hi}; return __builtin_bit_cast(unsigned, __builtin_convertvector(v, bf16x2_)); }
__device__ __forceinline__ float fast_sigmoid(float x) { return __builtin_amdgcn_rcpf(1.0f + __builtin_amdgcn_exp2f(-1.4426950408889634f * x)); }
__device__ __forceinline__ float fast_silu(float x) { return x * fast_sigmoid(x); }
__device__ __forceinline__ f32x4 silu4(f32x4 v) { return (f32x4){fast_silu(v[0]), fast_silu(v[1]), fast_silu(v[2]), fast_silu(v[3])}; }
__device__ __forceinline__ f32x4 sigm4(f32x4 v) { return (f32x4){fast_sigmoid(v[0]), fast_sigmoid(v[1]), fast_sigmoid(v[2]), fast_sigmoid(v[3])}; }
__device__ __forceinline__ u32x4 pack8(f32x4 v0, f32x4 v1) { u32x4 w; w.x = cvt_pk_bf16(v0[0], v0[1]); w.y = cvt_pk_bf16(v0[2], v0[3]); w.z = cvt_pk_bf16(v1[0], v1[1]); w.w = cvt_pk_bf16(v1[2], v1[3]); return w; }
__device__ __forceinline__ void unpack8(u32x4 w, f32x4& v0, f32x4& v1) {
    v0 = (f32x4){__uint_as_float(w.x << 16), __uint_as_float(w.x & 0xffff0000u), __uint_as_float(w.y << 16), __uint_as_float(w.y & 0xffff0000u)};
    v1 = (f32x4){__uint_as_float(w.z << 16), __uint_as_float(w.z & 0xffff0000u), __uint_as_float(w.w << 16), __uint_as_float(w.w & 0xffff0000u)}; }

__device__ __forceinline__ float row_rstd(const float* ssq, int row) {
    const f32x4 a = *(const f32x4*)(ssq + (size_t)row * 16), b = *(const f32x4*)(ssq + (size_t)row * 16 + 4), c = *(const f32x4*)(ssq + (size_t)row * 16 + 8), d = *(const f32x4*)(ssq + (size_t)row * 16 + 12);
    const float s = ((a[0] + a[1]) + (a[2] + a[3])) + ((b[0] + b[1]) + (b[2] + b[3])) + (((c[0] + c[1]) + (c[2] + c[3])) + ((d[0] + d[1]) + (d[2] + d[3])));
    return __builtin_amdgcn_rsqf(s * (1.0f / 1024.0f) + 1e-6f); }
__device__ __forceinline__ unsigned f8x4(float a, float b, float c, float d) {
    a = __builtin_fminf(__builtin_fmaxf(a, -448.f), 448.f); b = __builtin_fminf(__builtin_fmaxf(b, -448.f), 448.f); c = __builtin_fminf(__builtin_fmaxf(c, -448.f), 448.f); d = __builtin_fminf(__builtin_fmaxf(d, -448.f), 448.f);
    unsigned w = 0u; w = __builtin_amdgcn_cvt_pk_fp8_f32(a, b, w, false); w = __builtin_amdgcn_cvt_pk_fp8_f32(c, d, w, true); return w; }
constexpr float W8_SCALE = 64.f;
constexpr float H8_SCALE = 8.f;
template <bool OUT8, bool CS = false> struct EpiGlu {
    static constexpr bool PERM = true, AFTER_DRAIN = false, PREFETCH = true;
    bf16_t* O; int ldo; const float* rstd; const float* bw; int bw_bstride; PG8_LAS float* tbl; const float* cf;
    __device__ __forceinline__ void prefetch(const Unit& u, int par, int wid, int lane) const {
        if (wid < 4) {
            const float* rp = rstd + (size_t)u.pm * BM + 64 * wid + lane;
            const float* bp = bw + (size_t)((u.pm * BM) >> 13) * bw_bstride + u.pn * BM + 64 * wid + lane;
            __builtin_amdgcn_global_load_lds((const unsigned*)rp, (PG8_LAS unsigned*)(tbl + par * 768 + 64 * wid), 4, 0, 0);
            __builtin_amdgcn_global_load_lds((const unsigned*)bp, (PG8_LAS unsigned*)(tbl + par * 768 + 256 + 64 * wid), 4, 0, 0);
            if constexpr (CS) __builtin_amdgcn_global_load_lds((const unsigned*)(cf + (size_t)u.pn * BM + 64 * wid + lane), (PG8_LAS unsigned*)(tbl + par * 768 + 512 + 64 * wid), 4, 0, 0);
        }
    }
    __device__ __forceinline__ void run(const f32x4 (&acc)[2][2][4][2], const Unit& u, int par, int wr, int wc, int fr, int fq) const {
        const int row0 = u.pm * BM + wr * 64 + fr, cl = wc * 32 + 8 * fq, col0 = u.pn * HALF + cl;
        const PG8_LAS float* tr = tbl + par * 768 + wr * 64 + fr; const PG8_LAS float* tb = tbl + par * 768 + 256 + cl;
        const f32x4 ba0 = *(const PG8_LAS f32x4*)tb, ba1 = *(const PG8_LAS f32x4*)(tb + 4), bb0 = *(const PG8_LAS f32x4*)(tb + HALF), bb1 = *(const PG8_LAS f32x4*)(tb + HALF + 4);
        f32x4 ca0 = {1.f, 1.f, 1.f, 1.f}, ca1 = ca0, cb0 = ca0, cb1 = ca0;
        if constexpr (CS) { ca0 = *(const PG8_LAS f32x4*)(tb + 256); ca1 = *(const PG8_LAS f32x4*)(tb + 256 + 4); cb0 = *(const PG8_LAS f32x4*)(tb + 256 + HALF); cb1 = *(const PG8_LAS f32x4*)(tb + 256 + HALF + 4); }
#pragma unroll
        for (int ai = 0; ai < 2; ++ai)
#pragma unroll
            for (int m = 0; m < 4; ++m) { const int row = row0 + ai * HALF + m * 16; const float rr = tr[ai * HALF + m * 16]; bf16_t* rowp = O + (size_t)row * ldo + col0;
                f32x4 h0, h1;
                if constexpr (CS) { h0 = silu4(acc[ai][0][m][0] * (ca0 * rr) + ba0) * (acc[ai][1][m][0] * (cb0 * rr) + bb0); h1 = silu4(acc[ai][0][m][1] * (ca1 * rr) + ba1) * (acc[ai][1][m][1] * (cb1 * rr) + bb1); }
                else { h0 = silu4(acc[ai][0][m][0] * rr + ba0) * (acc[ai][1][m][0] * rr + bb0); h1 = silu4(acc[ai][0][m][1] * rr + ba1) * (acc[ai][1][m][1] * rr + bb1); }
                if constexpr (OUT8) { typedef unsigned u32x2_ __attribute__((ext_vector_type(2))); const f32x4 g0 = h0 * H8_SCALE, g1 = h1 * H8_SCALE;
                    *(u32x2_*)((unsigned char*)O + (size_t)row * ldo + col0) = (u32x2_){f8x4(g0[0], g0[1], g0[2], g0[3]), f8x4(g1[0], g1[1], g1[2], g1[3])}; }
                else *(u32x4*)rowp = pack8(h0, h1); }
    }
};
template <bool BASE_F32> struct EpiRes {
    static constexpr bool PERM = true, AFTER_DRAIN = false, PREFETCH = false;
    const void* base; bf16_t* hout; bf16_t* aout; const float* gate; int gate_bstride; float scale; const float* cw; float* ssq;
    __device__ __forceinline__ void operator()(const f32x4 (&acc)[2][2][4][2], const Unit& u, int wr, int wc, int fr, int fq) const {
        const int row0 = u.pm * BM + wr * 64 + fr, col0 = u.pn * BM + wc * 32 + 8 * fq, b = (u.pm * BM) >> 13;
        f32x4 gv[2][2], cv[2][2];
#pragma unroll
        for (int bj = 0; bj < 2; ++bj)
#pragma unroll
            for (int n = 0; n < 2; ++n) { gv[bj][n] = *(const f32x4*)(gate + (size_t)b * gate_bstride + col0 + bj * HALF + 4 * n);
                cv[bj][n] = aout ? *(const f32x4*)(cw + b * 1024 + col0 + bj * HALF + 4 * n) : (f32x4){0.f, 0.f, 0.f, 0.f}; }
        asm volatile("" ::: "memory");
        constexpr int AHEAD = BASE_F32 ? 3 : 4;
        f32x4 pf[BASE_F32 ? AHEAD : 1][2][2]; u32x4 pb[BASE_F32 ? 1 : AHEAD][2];
#define EPIRES_LOAD(slot, grp) do { const size_t off_ = (size_t)(row0 + ((grp) >> 2) * HALF + ((grp) & 3) * 16) * 1024 + col0; \
            if (BASE_F32) { _Pragma("unroll") for (int bj = 0; bj < 2; ++bj) _Pragma("unroll") for (int n = 0; n < 2; ++n) pf[BASE_F32 ? (slot) : 0][bj][n] = *(const f32x4*)((const float*)base + off_ + bj * HALF + 4 * n); } \
            else { _Pragma("unroll") for (int bj = 0; bj < 2; ++bj) pb[BASE_F32 ? 0 : (slot)][bj] = *(const u32x4*)((const bf16_t*)base + off_ + bj * HALF); } } while (0)
#pragma unroll
        for (int grp = 0; grp < AHEAD; ++grp) EPIRES_LOAD(grp, grp);
#pragma unroll
        for (int grp = 0; grp < 8; ++grp) { const int ai = grp >> 2, m = grp & 3, slot = grp % AHEAD, row = row0 + ai * HALF + m * 16; const size_t off = (size_t)row * 1024 + col0;
            float ss = 0.f;
#pragma unroll
            for (int bj = 0; bj < 2; ++bj) { f32x4 b0, b1;
                if (BASE_F32) { b0 = pf[BASE_F32 ? slot : 0][bj][0]; b1 = pf[BASE_F32 ? slot : 0][bj][1]; } else unpack8(pb[BASE_F32 ? 0 : slot][bj], b0, b1);
                const f32x4 h0 = b0 + (gv[bj][0] * scale) * acc[ai][bj][m][0], h1 = b1 + (gv[bj][1] * scale) * acc[ai][bj][m][1];
                ss += (h0[0] * h0[0] + h0[1] * h0[1]) + (h0[2] * h0[2] + h0[3] * h0[3]) + (h1[0] * h1[0] + h1[1] * h1[1]) + (h1[2] * h1[2] + h1[3] * h1[3]);
                *(u32x4*)(hout + off + bj * HALF) = pack8(h0, h1);
                if (aout) *(u32x4*)(aout + off + bj * HALF) = pack8(h0 * cv[bj][0], h1 * cv[bj][1]); }
            ss += __shfl_xor(ss, 16); ss += __shfl_xor(ss, 32);
            if (fq == 0) ssq[(size_t)row * 16 + u.pn * 4 + wc] = ss;
            if (grp + AHEAD < 8) { asm volatile("" ::: "memory"); EPIRES_LOAD(slot, grp + AHEAD); } }
#undef EPIRES_LOAD
    }
};
struct EpiIn1 {
    static constexpr bool PERM = true, AFTER_DRAIN = false, PREFETCH = false;
    bf16_t* CV; bf16_t* CAB; bf16_t* QKV; size_t qkv_stride; float* BA;
    __device__ __forceinline__ void operator()(const f32x4 (&acc)[2][2][4][2], const Unit& u, int wr, int wc, int fr, int fq) const {
        const int row0 = u.pm * BM + wr * 64 + fr, cl = wc * 32 + 8 * fq; const int pn = u.pn;
        if (pn < 4) {
#pragma unroll
            for (int ai = 0; ai < 2; ++ai)
#pragma unroll
                for (int m = 0; m < 4; ++m) { bf16_t* rowp = CV + (size_t)(row0 + ai * HALF + m * 16) * 512 + pn * HALF + cl;
                    *(u32x4*)rowp = pack8(acc[ai][0][m][0] * acc[ai][1][m][0], acc[ai][0][m][1] * acc[ai][1][m][1]); }
        } else {
            bf16_t* base; int ld, colt;
            if (pn < 6) { base = CAB; ld = 512; colt = (pn - 4) * BM; } else { const int t = pn - 6; base = QKV + (size_t)(t >> 2) * qkv_stride; ld = 1024; colt = (t & 3) * BM; }
#pragma unroll
            for (int ai = 0; ai < 2; ++ai)
#pragma unroll
                for (int m = 0; m < 4; ++m) { bf16_t* rowp = base + (size_t)(row0 + ai * HALF + m * 16) * ld + colt + cl;
#pragma unroll
                    for (int bj = 0; bj < 2; ++bj) *(u32x4*)(rowp + bj * HALF) = pack8(acc[ai][bj][m][0], acc[ai][bj][m][1]); }
        }
    }
};
struct EpiIn2 {
    static constexpr bool PERM = true, AFTER_DRAIN = false, PREFETCH = false;
    bf16_t* YB; bf16_t* SGA; bf16_t* SGB;
    __device__ __forceinline__ void operator()(const f32x4 (&acc)[2][2][4][2], const Unit& u, int wr, int wc, int fr, int fq) const {
        const int row0 = u.pm * BM + wr * 64 + fr, cl = wc * 32 + 8 * fq; const int pn = u.pn;
        long doff = (long)(SGA - YB); if (pn >= 8) doff = (long)(SGB - YB); if (pn < 4) doff = 0; bf16_t* base = YB + doff; const int colt = (pn & 3) * BM;
#pragma unroll
        for (int ai = 0; ai < 2; ++ai)
#pragma unroll
            for (int m = 0; m < 4; ++m) { bf16_t* rowp = base + (size_t)(row0 + ai * HALF + m * 16) * 1024 + colt + cl;
#pragma unroll
                for (int bj = 0; bj < 2; ++bj) {
                    if (pn < 4) { f32x4 o0, o1; unpack8(*(const u32x4*)(rowp + bj * HALF), o0, o1);
                        *(u32x4*)(rowp + bj * HALF) = pack8(o0 * silu4(acc[ai][bj][m][0]), o1 * silu4(acc[ai][bj][m][1])); }
                    else *(u32x4*)(rowp + bj * HALF) = pack8(sigm4(acc[ai][bj][m][0]), sigm4(acc[ai][bj][m][1])); } }
    }
};
struct EpiIn2Q {
    static constexpr bool PERM = true, AFTER_DRAIN = false, PREFETCH = true;
    bf16_t* YB; bf16_t* SGA; bf16_t* SGB; const float* rs; const float* cf; PG8_LAS float* tbl;
    __device__ __forceinline__ void prefetch(const Unit& u, int par, int wid, int lane) const {
        if (wid < 4) {
            __builtin_amdgcn_global_load_lds((const unsigned*)(rs + (size_t)u.pm * BM + 64 * wid + lane), (PG8_LAS unsigned*)(tbl + par * 768 + 64 * wid), 4, 0, 0);
            __builtin_amdgcn_global_load_lds((const unsigned*)(cf + (size_t)u.pn * BM + 64 * wid + lane), (PG8_LAS unsigned*)(tbl + par * 768 + 512 + 64 * wid), 4, 0, 0);
        }
    }
    __device__ __forceinline__ void run(const f32x4 (&acc)[2][2][4][2], const Unit& u, int par, int wr, int wc, int fr, int fq) const {
        const int row0 = u.pm * BM + wr * 64 + fr, cl = wc * 32 + 8 * fq; const int pn = u.pn;
        long doff = (long)(SGA - YB); if (pn >= 8) doff = (long)(SGB - YB); if (pn < 4) doff = 0; bf16_t* base = YB + doff; const int colt = (pn & 3) * BM;
        const PG8_LAS float* tr = tbl + par * 768 + wr * 64 + fr; const PG8_LAS float* tc = tbl + par * 768 + 512 + cl;
        f32x4 cs[2][2]; cs[0][0] = *(const PG8_LAS f32x4*)tc; cs[0][1] = *(const PG8_LAS f32x4*)(tc + 4); cs[1][0] = *(const PG8_LAS f32x4*)(tc + HALF); cs[1][1] = *(const PG8_LAS f32x4*)(tc + HALF + 4);
#pragma unroll
        for (int ai = 0; ai < 2; ++ai)
#pragma unroll
            for (int m = 0; m < 4; ++m) { const float rr = tr[ai * HALF + m * 16]; bf16_t* rowp = base + (size_t)(row0 + ai * HALF + m * 16) * 1024 + colt + cl;
#pragma unroll
                for (int bj = 0; bj < 2; ++bj) { const f32x4 z0 = acc[ai][bj][m][0] * (cs[bj][0] * rr), z1 = acc[ai][bj][m][1] * (cs[bj][1] * rr);
                    if (pn < 4) { f32x4 o0, o1; unpack8(*(const u32x4*)(rowp + bj * HALF), o0, o1);
                        *(u32x4*)(rowp + bj * HALF) = pack8(o0 * silu4(z0), o1 * silu4(z1)); }
                    else *(u32x4*)(rowp + bj * HALF) = pack8(sigm4(z0), sigm4(z1)); } }
    }
};
struct EpiMul {
    static constexpr bool PERM = true, AFTER_DRAIN = false, PREFETCH = false;
    bf16_t* T;
    __device__ __forceinline__ void operator()(const f32x4 (&acc)[2][2][4][2], const Unit& u, int wr, int wc, int fr, int fq) const {
        const int row0 = u.pm * BM + wr * 64 + fr, col0 = u.pn * BM + wc * 32 + 8 * fq;
        u32x4 tv[4][2];
#define EPIMUL_LOAD(slot, grp) do { _Pragma("unroll") for (int bj = 0; bj < 2; ++bj) tv[slot][bj] = *(const u32x4*)(T + (size_t)(row0 + ((grp) >> 2) * HALF + ((grp) & 3) * 16) * 1024 + col0 + bj * HALF); } while (0)
#pragma unroll
        for (int grp = 0; grp < 4; ++grp) EPIMUL_LOAD(grp, grp);
#pragma unroll
        for (int grp = 0; grp < 8; ++grp) { const int ai = grp >> 2, m = grp & 3, slot = grp & 3; bf16_t* rowp = T + (size_t)(row0 + ai * HALF + m * 16) * 1024 + col0;
#pragma unroll
            for (int bj = 0; bj < 2; ++bj) { f32x4 o0, o1; unpack8(tv[slot][bj], o0, o1);
                *(u32x4*)(rowp + bj * HALF) = pack8(o0 * acc[ai][bj][m][0], o1 * acc[ai][bj][m][1]); }
            if (grp + 4 < 8) { asm volatile("" ::: "memory"); EPIMUL_LOAD(slot, grp + 4); } }
#undef EPIMUL_LOAD
    }
};
struct EpiMerge {
    static constexpr bool PERM = true, AFTER_DRAIN = false, PREFETCH = false;
    const bf16_t* T; bf16_t* G;
    __device__ __forceinline__ void operator()(const f32x4 (&acc)[2][2][4][2], const Unit& u, int wr, int wc, int fr, int fq) const {
        const int row0 = u.pm * BM + wr * 64 + fr, col0 = u.pn * BM + wc * 32 + 8 * fq;
        u32x4 tv[4][2], gvv[4][2];
#define EPIMERGE_LOAD(slot, grp) do { const size_t off_ = (size_t)(row0 + ((grp) >> 2) * HALF + ((grp) & 3) * 16) * 1024 + col0; \
            _Pragma("unroll") for (int bj = 0; bj < 2; ++bj) { tv[slot][bj] = *(const u32x4*)(T + off_ + bj * HALF); gvv[slot][bj] = *(const u32x4*)(G + off_ + bj * HALF); } } while (0)
#pragma unroll
        for (int grp = 0; grp < 4; ++grp) EPIMERGE_LOAD(grp, grp);
#pragma unroll
        for (int grp = 0; grp < 8; ++grp) { const int ai = grp >> 2, m = grp & 3, slot = grp & 3; const size_t off = (size_t)(row0 + ai * HALF + m * 16) * 1024 + col0;
#pragma unroll
            for (int bj = 0; bj < 2; ++bj) { f32x4 t0, t1, g0, g1; unpack8(tv[slot][bj], t0, t1); unpack8(gvv[slot][bj], g0, g1);
                *(u32x4*)(G + off + bj * HALF) = pack8(t0 + g0 * acc[ai][bj][m][0], t1 + g1 * acc[ai][bj][m][1]); }
            if (grp + 4 < 8) { asm volatile("" ::: "memory"); EPIMERGE_LOAD(slot, grp + 4); } }
#undef EPIMERGE_LOAD
    }
};
typedef int i32x8 __attribute__((ext_vector_type(8)));
typedef int i32x4 __attribute__((ext_vector_type(4)));
template <class Epi, class Sched, bool ALIGN_EPI = false, bool SP2 = false, int QMODE = 0>
__device__ __forceinline__ void gemm_phase(PG8_LAS unsigned char* lds, const Gemm g, const Sched& S, const Epi& E) {
    const int tid = threadIdx.x, wid = __builtin_amdgcn_readfirstlane(tid >> 6), lane = tid & 63, wr = wid >> 2, wc = wid & 3, fr = lane & 15, fq = lane >> 4;
    const int K = g.K, nt = K / BK;
    constexpr bool FP8 = (QMODE == 1), I8 = (QMODE == 2);
    int f8sc = 0x7f7f7f7f; asm volatile("" : "+v"(f8sc)); (void)f8sc;
    unsigned voffA[2], voffB[2];
#pragma unroll
    for (int i = 0; i < 2; ++i) { int R, C; stage_rc(tid * 16 + i * 8192, R, C); const int Rb = Epi::PERM ? ((R & ~31) + perm32(R & 31)) : R;
        voffA[i] = (unsigned)(R * K + C) * 2u; voffB[i] = (unsigned)(Rb * K + C) * 2u; }
    const size_t kstep = (size_t)(BK * 2);
    const size_t hstep = (size_t)HALF * K * 2;
    const size_t tstep = 2 * hstep;
    const unsigned ldsw = (unsigned)wid * 1024u;
    const int aoff = lds_byte(wr * 64 + fr, fq * 8), boff = lds_byte(wc * 32 + fr, fq * 8);
#define PG8_SA(b, h) (((b) * 2 + (h)) * HTB)
#define PG8_SB(b, h) ((4 + (b) * 2 + (h)) * HTB)
#define PG8_STAGE(bufoff, gbase, voff) do { _Pragma("unroll") for (int _i = 0; _i < 2; ++_i) \
        __builtin_amdgcn_global_load_lds((const unsigned*)((const char*)(gbase) + (voff)[_i]), (PG8_LAS unsigned*)(lds + (bufoff) + ldsw + _i * 8192), 16, 0, 0); } while (0)
#define PG8_LDA(dst, b, h) do { _Pragma("unroll") for (int m = 0; m < 4; ++m) { dst[m].lo = *(const PG8_LAS i32x4*)(lds + PG8_SA(b, h) + aoff + m * 2048); dst[m].hi = *(const PG8_LAS i32x4*)(lds + PG8_SA(b, h) + aoff + m * 2048 + 1024); } } while (0)
#define PG8_LDB(dst, b, h) do { _Pragma("unroll") for (int n = 0; n < 2; ++n) { dst[n].lo = *(const PG8_LAS i32x4*)(lds + PG8_SB(b, h) + boff + n * 2048); dst[n].hi = *(const PG8_LAS i32x4*)(lds + PG8_SB(b, h) + boff + n * 2048 + 1024); } } while (0)
#define PG8_MMA(ai, bj, At, Bt) do { __builtin_amdgcn_s_setprio(1); _Pragma("unroll") for (int m = 0; m < 4; ++m) _Pragma("unroll") for (int n = 0; n < 2; ++n) { \
        if constexpr (FP8) asm volatile("v_mfma_scale_f32_16x16x128_f8f6f4 %0, %1, %2, %0, %3, %3 op_sel_hi:[0,0,0]" : "+v"(acc[ai][bj][m][n]) : "v"(Bt[n]), "v"(At[m]), "v"(f8sc));   \
        else if constexpr (I8) { const i32x4 bl_ = Bt[n].lo, bh_ = Bt[n].hi, al_ = At[m].lo, ah_ = At[m].hi; i32x4 c_ = __builtin_bit_cast(i32x4, acc[ai][bj][m][n]); \
               c_ = __builtin_amdgcn_mfma_i32_16x16x64_i8(bl_, al_, c_, 0, 0, 0); c_ = __builtin_amdgcn_mfma_i32_16x16x64_i8(bh_, ah_, c_, 0, 0, 0); acc[ai][bj][m][n] = __builtin_bit_cast(f32x4, c_); } \
        else { const i32x4 bl_ = Bt[n].lo, bh_ = Bt[n].hi, al_ = At[m].lo, ah_ = At[m].hi;        \
               acc[ai][bj][m][n] = __builtin_amdgcn_mfma_f32_16x16x32_bf16(__builtin_bit_cast(bf16x8, bl_), __builtin_bit_cast(bf16x8, al_), acc[ai][bj][m][n], 0, 0, 0); \
               acc[ai][bj][m][n] = __builtin_amdgcn_mfma_f32_16x16x32_bf16(__builtin_bit_cast(bf16x8, bh_), __builtin_bit_cast(bf16x8, ah_), acc[ai][bj][m][n], 0, 0, 0); } } \
        __builtin_amdgcn_s_setprio(0); } while (0)
#define PG8_WAIT_V(n) asm volatile("s_waitcnt vmcnt(" #n ")" ::: "memory")
#define PG8_WAIT_L(n) asm volatile("s_waitcnt lgkmcnt(" #n ")" ::: "memory")
#define PG8_BAR __builtin_amdgcn_s_barrier()
#define PG8_SCHED __builtin_amdgcn_sched_barrier(0)
    Unit cur, nxt; int ui = 0;
    if (!S.next(0, cur)) return;
    if constexpr (Epi::PREFETCH) E.prefetch(cur, 0, wid, lane);
    f32x4 acc[2][2][4][2];
#pragma unroll
    for (int a = 0; a < 2; ++a)
#pragma unroll
        for (int b = 0; b < 2; ++b)
#pragma unroll
            for (int m = 0; m < 4; ++m)
#pragma unroll
                for (int n = 0; n < 2; ++n) acc[a][b][m][n] = (f32x4){0.f, 0.f, 0.f, 0.f};
    i32x8 At[4], B0[2], B1[2];
    const char* cA = (const char*)g.A + (size_t)cur.pm * tstep; const char* cB = (const char*)g.Bt + (size_t)cur.pn * tstep;
    S.a_ready(cur);
    if constexpr (SP2) {
        PG8_STAGE(PG8_SB(0, 0), cB, voffB); PG8_STAGE(PG8_SB(0, 1), cB + hstep, voffB); PG8_STAGE(PG8_SA(0, 0), cA, voffA); PG8_STAGE(PG8_SA(0, 1), cA + hstep, voffA);
        if (wr == 1) PG8_BAR;
        PG8_WAIT_V(2); PG8_BAR;
        PG8_STAGE(PG8_SB(1, 0), cB + kstep, voffB); PG8_STAGE(PG8_SA(1, 0), cA + kstep, voffA); PG8_STAGE(PG8_SB(1, 1), cB + hstep + kstep, voffB);
        PG8_WAIT_V(6); PG8_BAR;
    } else {
        PG8_STAGE(PG8_SB(0, 0), cB, voffB); PG8_STAGE(PG8_SA(0, 0), cA, voffA); PG8_STAGE(PG8_SB(0, 1), cB + hstep, voffB); PG8_STAGE(PG8_SA(0, 1), cA + hstep, voffA);
        if (wr == 1) PG8_BAR;
        PG8_WAIT_V(4); PG8_BAR;
        PG8_STAGE(PG8_SB(1, 0), cB + kstep, voffB); PG8_STAGE(PG8_SA(1, 0), cA + kstep, voffA); PG8_STAGE(PG8_SB(1, 1), cB + hstep + kstep, voffB);
        PG8_WAIT_V(6); PG8_BAR;
    }
    for (;;) {
        const bool has_next = S.next(ui + 1, nxt);
        const char* nA = has_next ? (const char*)g.A + (size_t)nxt.pm * tstep : cA; const char* nB = has_next ? (const char*)g.Bt + (size_t)nxt.pn * tstep : cB;
#pragma unroll 1
        for (int t = 0; t < nt; t += 2) {
            const bool last = (t == nt - 2);
            const char* a1 = cA + (size_t)(t + 1) * kstep;
            const char* a2 = last ? nA : cA + (size_t)(t + 2) * kstep; const char* b2 = last ? nB : cB + (size_t)(t + 2) * kstep;
            const char* a3 = a2 + kstep; const char* b3 = b2 + kstep;
            if (last && has_next) S.a_ready(nxt);
            if constexpr (SP2) {
            PG8_LDB(B0, 0, 0); PG8_LDB(B1, 0, 1); PG8_SCHED; PG8_LDA(At, 0, 0); PG8_STAGE(PG8_SA(1, 1), a1 + hstep, voffA);
            PG8_WAIT_V(8); PG8_WAIT_L(0); PG8_BAR; PG8_MMA(0, 0, At, B0); PG8_MMA(0, 1, At, B1); PG8_BAR; PG8_SCHED;
            PG8_LDA(At, 0, 1); PG8_STAGE(PG8_SB(0, 0), b2, voffB); PG8_STAGE(PG8_SB(0, 1), b2 + hstep, voffB); PG8_STAGE(PG8_SA(0, 0), a2, voffA);
            PG8_WAIT_V(8); PG8_WAIT_L(0); PG8_BAR; PG8_MMA(1, 0, At, B0); PG8_MMA(1, 1, At, B1); PG8_BAR; PG8_SCHED;
            PG8_LDB(B0, 1, 0); PG8_LDB(B1, 1, 1); PG8_SCHED; PG8_LDA(At, 1, 0); PG8_STAGE(PG8_SA(0, 1), a2 + hstep, voffA);
            PG8_WAIT_V(8); PG8_WAIT_L(0); PG8_BAR; PG8_MMA(0, 0, At, B0); PG8_MMA(0, 1, At, B1); PG8_BAR; PG8_SCHED;
            PG8_LDA(At, 1, 1); PG8_STAGE(PG8_SB(1, 0), b3, voffB); PG8_STAGE(PG8_SB(1, 1), b3 + hstep, voffB); PG8_STAGE(PG8_SA(1, 0), a3, voffA);
            PG8_WAIT_V(8); PG8_WAIT_L(0); PG8_BAR; PG8_MMA(1, 0, At, B0); PG8_MMA(1, 1, At, B1); PG8_BAR; PG8_SCHED;
            } else {
            PG8_LDB(B0, 0, 0); PG8_SCHED; PG8_LDA(At, 0, 0); PG8_STAGE(PG8_SA(1, 1), a1 + hstep, voffA);
            PG8_WAIT_L(8); PG8_BAR; PG8_WAIT_L(0); PG8_MMA(0, 0, At, B0); PG8_BAR; PG8_SCHED;
            PG8_LDB(B1, 0, 1); PG8_STAGE(PG8_SB(0, 0), b2, voffB);
            PG8_BAR; PG8_WAIT_L(0); PG8_MMA(0, 1, At, B1); PG8_BAR;
            PG8_LDA(At, 0, 1); PG8_STAGE(PG8_SA(0, 0), a2, voffA);
            PG8_BAR; PG8_WAIT_L(0); PG8_MMA(1, 0, At, B0); PG8_BAR; PG8_SCHED;
            PG8_STAGE(PG8_SB(0, 1), b2 + hstep, voffB);
            PG8_WAIT_V(6); PG8_BAR; PG8_MMA(1, 1, At, B1); PG8_BAR;
            PG8_LDB(B0, 1, 0); PG8_SCHED; PG8_LDA(At, 1, 0); PG8_STAGE(PG8_SA(0, 1), a2 + hstep, voffA);
            PG8_WAIT_L(8); PG8_BAR; PG8_WAIT_L(0); PG8_MMA(0, 0, At, B0); PG8_BAR; PG8_SCHED;
            PG8_LDB(B1, 1, 1); PG8_STAGE(PG8_SB(1, 0), b3, voffB);
            PG8_BAR; PG8_WAIT_L(0); PG8_MMA(0, 1, At, B1); PG8_BAR;
            PG8_LDA(At, 1, 1); PG8_STAGE(PG8_SA(1, 0), a3, voffA);
            PG8_BAR; PG8_WAIT_L(0); PG8_MMA(1, 0, At, B0); PG8_BAR; PG8_SCHED;
            PG8_STAGE(PG8_SB(1, 1), b3 + hstep, voffB);
            PG8_WAIT_V(6); PG8_BAR; PG8_MMA(1, 1, At, B1); PG8_BAR;
            }
        }
        if constexpr (ALIGN_EPI) { if (wr == 0) PG8_BAR; }
        if constexpr (I8) {
_Pragma("unroll") for (int a_ = 0; a_ < 2; ++a_) _Pragma("unroll") for (int b_ = 0; b_ < 2; ++b_) _Pragma("unroll") for (int m_ = 0; m_ < 4; ++m_) _Pragma("unroll") for (int n_ = 0; n_ < 2; ++n_)
                acc[a_][b_][m_][n_] = __builtin_convertvector(__builtin_bit_cast(i32x4, acc[a_][b_][m_][n_]), f32x4); }
        if constexpr (FP8) asm volatile("s_nop 15\n\ts_nop 15" ::: "memory");
        if constexpr (Epi::PREFETCH) { int le = (int)threadIdx.x; asm volatile("" : "+v"(le)); le &= 63;
            E.run(acc, cur, ui & 1, wr, wc, le & 15, le >> 4); S.done(cur); }
        else if constexpr (!Epi::AFTER_DRAIN) { E(acc, cur, wr, wc, fr, fq); S.done(cur); }
        if (!has_next) break;
#pragma unroll
        for (int a = 0; a < 2; ++a)
#pragma unroll
            for (int b = 0; b < 2; ++b)
#pragma unroll
                for (int m = 0; m < 4; ++m)
#pragma unroll
                    for (int n = 0; n < 2; ++n) acc[a][b][m][n] = (f32x4){0.f, 0.f, 0.f, 0.f};
        cur = nxt; cA = nA; cB = nB; ++ui;
        if constexpr (Epi::PREFETCH) { int lp = (int)threadIdx.x; asm volatile("" : "+v"(lp)); E.prefetch(cur, ui & 1, wid, lp & 63); }
        if constexpr (ALIGN_EPI) { if (wr == 1) PG8_BAR; }
    }
    PG8_WAIT_V(0);
    if constexpr (!ALIGN_EPI) { if (wr == 0) PG8_BAR; }
    PG8_BAR;
    if constexpr (Epi::AFTER_DRAIN) { E.fused(acc, cur, wr, wc, fr, fq, lds, wid, lane); S.done(cur); }
#undef PG8_SA
#undef PG8_SB
#undef PG8_STAGE
#undef PG8_LDA
#undef PG8_LDB
#undef PG8_MMA
#undef PG8_WAIT_V
#undef PG8_WAIT_L
#undef PG8_BAR
#undef PG8_SCHED
}
}
#define PG8_SP2 true
#define PG8_ALIGN true
#define GAS __attribute__((address_space(1)))
#define LAS __attribute__((address_space(3)))
typedef unsigned short bf16;
typedef unsigned v4u __attribute__((ext_vector_type(4)));
typedef float f32x4 __attribute__((ext_vector_type(4)));
typedef short bf16x8 __attribute__((ext_vector_type(8)));
typedef GAS unsigned gu32;
typedef GAS unsigned long long gu64;
#define RLX_AGENT __ATOMIC_RELAXED, __HIP_MEMORY_SCOPE_AGENT
#define LDS_WAIT() asm volatile("s_waitcnt lgkmcnt(0)" ::: "memory")
#define VM_WAIT() asm volatile("s_waitcnt vmcnt(0)" ::: "memory")
__device__ __forceinline__ unsigned long long rt() { return __builtin_amdgcn_s_memrealtime(); }
__device__ __forceinline__ unsigned pk2(float lo, float hi) { typedef float f32x2_ __attribute__((ext_vector_type(2))); typedef __bf16 bf16x2_ __attribute__((ext_vector_type(2)));
    const f32x2_ v = {lo, hi}; return __builtin_bit_cast(unsigned, __builtin_convertvector(v, bf16x2_)); }
__device__ __forceinline__ unsigned f2bf(float f) { return pk2(f, 0.f) & 0xffffu; }
#define XB_TMO      128
#define XB_XCNT(j)  (256  + 64 * (j))
#define XB_XSUB(j)  (1280 + 64 * (j))
#define XB_XGEN(j)  (2304 + 64 * (j))
#define XB_TOP      3328
#define XB_TOPGEN   3392
#define XCD_BAR_WORDS 3456
#define XB_SPIN_CAP (1u << 18)

__device__ __forceinline__ unsigned xb_ld(unsigned* p)              { return __hip_atomic_load(p, __ATOMIC_RELAXED, __HIP_MEMORY_SCOPE_AGENT); }
__device__ __forceinline__ unsigned xb_add(unsigned* p, unsigned v) { return __hip_atomic_fetch_add(p, v, __ATOMIC_RELAXED, __HIP_MEMORY_SCOPE_AGENT); }
__device__ __forceinline__ unsigned xb_xcc_id() { return (unsigned)__builtin_amdgcn_s_getreg((3 << 11) | 20) & 0xFu; }
#define XB_SPIN(cond, bar) do { unsigned _sp = 0; while (cond) { __builtin_amdgcn_s_sleep(1); \
    if ((++_sp & 255u) == 0u) { if (xb_ld(&(bar)[XB_TMO])) break; if (_sp > XB_SPIN_CAP) { atomicAdd(&(bar)[XB_TMO], 1u); break; } } } } while (0)

struct XcdBarrier {
    unsigned* bar; unsigned x;
    volatile LAS unsigned* st;
};

__device__ __forceinline__ XcdBarrier xcd_barrier_post(unsigned* bar, volatile LAS unsigned* st) {
    XcdBarrier b; b.bar = bar; b.x = xb_xcc_id(); b.st = st;
    if (threadIdx.x == 0) (void)xb_add(&bar[XB_XCNT(b.x)], 1u);
    return b;
}
__device__ __forceinline__ void xcd_barrier_complete(unsigned* bar, unsigned x, unsigned& nloc, unsigned& nx) {
    const unsigned G = gridDim.x * gridDim.y * gridDim.z;
    unsigned sum, cnt, mine, sp = 0u;
    for (;;) {
        sum = 0u; cnt = 0u; mine = 0u;
#pragma unroll
        for (unsigned j = 0; j < 16; ++j) { const unsigned c = xb_ld(&bar[XB_XCNT(j)]); sum += c; cnt += (c > 0u) ? 1u : 0u; mine = (j == x) ? c : mine; }
        if (sum == G) break;
        __builtin_amdgcn_s_sleep(1);
        if ((++sp & 255u) == 0u) { if (xb_ld(&bar[XB_TMO])) break; if (sp > XB_SPIN_CAP) { atomicAdd(&bar[XB_TMO], 1u); break; } }
    }
    nloc = mine > 0u ? mine : 1u; nx = cnt > 0u ? cnt : 1u;
}

__device__ __forceinline__ void xcd_barrier(const XcdBarrier& b) {
    asm volatile("s_waitcnt vmcnt(0)" ::: "memory");
    __syncthreads();
    if (threadIdx.x == 0) {
        unsigned* bar = b.bar;
        __builtin_amdgcn_s_waitcnt(0);
        unsigned nloc = b.st[0], nx = b.st[1];
        if (nloc == 0u) { xcd_barrier_complete(bar, b.x, nloc, nx); b.st[0] = nloc; b.st[1] = nx; }
        const unsigned old = xb_add(&bar[XB_XSUB(b.x)], 1u);
        const unsigned gen = old / nloc;
        if (old + 1u == (gen + 1u) * nloc) {
            __builtin_amdgcn_fence(__ATOMIC_RELEASE, "agent");
            asm volatile("s_waitcnt vmcnt(0)" ::: "memory");
            const unsigned og = xb_add(&bar[XB_TOP], 1u);
            const unsigned tg = og / nx;
            if (og + 1u == (tg + 1u) * nx) xb_add(&bar[XB_TOPGEN], 1u);
            else XB_SPIN(xb_ld(&bar[XB_TOPGEN]) == tg, bar);
            __builtin_amdgcn_fence(__ATOMIC_ACQUIRE, "agent");
            xb_add(&bar[XB_XGEN(b.x)], 1u);
            asm volatile("s_waitcnt vmcnt(0)" ::: "memory");
        } else {
            XB_SPIN(xb_ld(&bar[XB_XGEN(b.x)]) == gen, bar);
            __builtin_amdgcn_fence(__ATOMIC_ACQUIRE, "agent");
            asm volatile("s_waitcnt vmcnt(0)" ::: "memory");
        }
    }
    __syncthreads();
}

constexpr int NWAVES = 8;
constexpr int BATCH = 4, SEQ = 8192, D = 1024, M = BATCH * SEQ, FF = 2816, NH = 8, DK = 128, DV = 128;
constexpr int IN_COLS = 7712, NMOD = 9;
constexpr int N_IN1 = 18 * 256, N_IN2 = 12 * 256;
constexpr float EPS = 1e-6f;
#ifndef MK_SPLIT
#define MK_SPLIT 0
#endif
constexpr int NPHASE = 19;

constexpr size_t MiB = 1u << 20;
constexpr size_t WS_CTL = 0, CTL_ZERO_BYTES = 64 * 1024;
constexpr size_t WS_MOD = 256 * 1024;
constexpr size_t WS_WUP1 = 1 * MiB, WS_WDN1 = 12 * MiB, WS_WUP2 = 18 * MiB, WS_WDN2 = 29 * MiB, WS_WIN1 = 35 * MiB, WS_WIN2 = 45 * MiB, WS_WA = 51 * MiB, WS_WB = 52 * MiB, WS_WO = 54 * MiB;
constexpr size_t WS_XN = 64 * MiB;
constexpr size_t WS_HID = 128 * MiB;
constexpr size_t WS_QRAW = 128 * MiB, WS_KRAW = 192 * MiB, WS_VRAW = 256 * MiB;
constexpr size_t WS_CAB = 320 * MiB, WS_CV = 352 * MiB;
constexpr size_t WS_QF = 384 * MiB;
constexpr size_t WS_YA = 448 * MiB;
constexpr size_t WS_BA = 480 * MiB;
constexpr size_t WS_GB = 484 * MiB;
constexpr size_t WS_SSQ = 56 * MiB;
constexpr size_t WS_BW = 17 * MiB + 512 * 1024;
constexpr size_t BW_UP1 = 0, BW_IN1 = 96 * 1024, BW_IN2 = 176 * 1024, BW_UP2 = 224 * 1024;
constexpr size_t WS_CW = 34 * MiB + 512 * 1024;
constexpr size_t WS_HB2 = 304 * MiB, WS_HB3 = 384 * MiB;
constexpr size_t WS_WDN1F8 = 488 * MiB;
constexpr size_t WS_WUP1I8 = 491 * MiB, WS_WUP2I8 = 497 * MiB;
constexpr size_t WS_CF = 503 * MiB;
constexpr size_t WS_WIN2I8 = 504 * MiB;
constexpr size_t WS_CF3 = 507 * MiB, WS_RSX = 507 * MiB + 512 * 1024;
constexpr size_t WS_END = 508 * MiB;
constexpr size_t WS_KF = WS_QRAW, WS_VF = WS_KRAW;
constexpr size_t WS_OF = WS_VRAW, WS_OB = WS_CAB;
constexpr size_t WS_SGA = WS_QF, WS_SGB = WS_QRAW;
static_assert(WS_WUP1 + (size_t)2 * FF * D * 2 <= WS_WDN1 && WS_WDN1 + (size_t)D * FF * 2 <= WS_WUP2 && WS_WIN1 + (size_t)N_IN1 * D * 2 <= WS_WIN2 && WS_WIN2 + (size_t)N_IN2 * D * 2 <= WS_WA && WS_WO + 2 * MiB <= WS_XN, "weights map");
static_assert(WS_HID + (size_t)M * FF * 2 <= WS_CAB + 64 * MiB && WS_GB + (size_t)4 * M * 8 * 4 <= WS_END, "activation map");

constexpr int RING_OFF = 0, RING_BYTES = 131072;
constexpr int LDS_BYTES = 163840;
constexpr int LDSCTL_OFF = LDS_BYTES - 512, MISC_OFF = LDSCTL_OFF + 320;

struct Args { const float* in[23]; float* out; unsigned char* ws; int ph_lo, ph_hi; };
enum { I_X = 0, I_C, I_WADA, I_BADA, I_NF1, I_WUP1, I_WDN1, I_NMIX, I_WIN, I_CONVA, I_CONVDN, I_ALF, I_DTF, I_ALB, I_DTB, I_DNNORM, I_WAO, I_WBO, I_WOUT, I_NF2, I_WUP2, I_WDN2, I_NFIN };

template <int CTRL, int ROW_MASK = 0xf> __device__ __forceinline__ float dpp_add(float v) {
    return v + __builtin_bit_cast(float, __builtin_amdgcn_update_dpp(0, __builtin_bit_cast(int, v), CTRL, ROW_MASK, 0xf, false)); }
__device__ __forceinline__ float sum16(float v) {
    v = dpp_add<0x128>(v); v = dpp_add<0x124>(v); v = dpp_add<0x122>(v); v = dpp_add<0x121>(v);
    return v;
}
__device__ __forceinline__ float wave_sum(float v) {
    v = sum16(v);
    return (__builtin_bit_cast(float, __builtin_amdgcn_readlane(__builtin_bit_cast(int, v), 0)) + __builtin_bit_cast(float, __builtin_amdgcn_readlane(__builtin_bit_cast(int, v), 16)))
      + (__builtin_bit_cast(float, __builtin_amdgcn_readlane(__builtin_bit_cast(int, v), 32)) + __builtin_bit_cast(float, __builtin_amdgcn_readlane(__builtin_bit_cast(int, v), 48)));
}
template <int CTRL> __device__ __forceinline__ float dpp_max(float v) { return __builtin_fmaxf(v, __builtin_bit_cast(float, __builtin_amdgcn_update_dpp(__builtin_bit_cast(int, v), __builtin_bit_cast(int, v), CTRL, 0xf, 0xf, false))); }
__device__ __forceinline__ float wave_max(float v) {
    v = dpp_max<0x128>(v); v = dpp_max<0x124>(v); v = dpp_max<0x122>(v); v = dpp_max<0x121>(v);
    return __builtin_fmaxf(__builtin_fmaxf(__builtin_bit_cast(float, __builtin_amdgcn_readlane(__builtin_bit_cast(int, v), 0)), __builtin_bit_cast(float, __builtin_amdgcn_readlane(__builtin_bit_cast(int, v), 16))),
                           __builtin_fmaxf(__builtin_bit_cast(float, __builtin_amdgcn_readlane(__builtin_bit_cast(int, v), 32)), __builtin_bit_cast(float, __builtin_amdgcn_readlane(__builtin_bit_cast(int, v), 48))));
}
__device__ __forceinline__ unsigned i8x4(float a, float b, float c, float d) {
    const int qa = (int)__builtin_rintf(a), qb = (int)__builtin_rintf(b), qc = (int)__builtin_rintf(c), qd = (int)__builtin_rintf(d);
    return ((unsigned)qa & 0xffu) | (((unsigned)qb & 0xffu) << 8) | (((unsigned)qc & 0xffu) << 16) | ((unsigned)qd << 24); }
__device__ __forceinline__ float bf2f(unsigned short b) { return __uint_as_float((unsigned)b << 16); }
__device__ __forceinline__ void unpack8f(v4u w, float* f) {
    f[0] = __uint_as_float(w.x << 16); f[1] = __uint_as_float(w.x & 0xffff0000u); f[2] = __uint_as_float(w.y << 16); f[3] = __uint_as_float(w.y & 0xffff0000u);
    f[4] = __uint_as_float(w.z << 16); f[5] = __uint_as_float(w.z & 0xffff0000u); f[6] = __uint_as_float(w.w << 16); f[7] = __uint_as_float(w.w & 0xffff0000u); }
__device__ __forceinline__ v4u pack8f(const float* f) { v4u w; w.x = pk2(f[0], f[1]); w.y = pk2(f[2], f[3]); w.z = pk2(f[4], f[5]); w.w = pk2(f[6], f[7]); return w; }
__device__ __forceinline__ float sigmoidf_(float x) { return __builtin_amdgcn_rcpf(1.0f + __expf(-x)); }
__device__ __forceinline__ float siluf_(float x) { return x * __builtin_amdgcn_rcpf(1.0f + __expf(-x)); }

using pg8::f8x4; using pg8::W8_SCALE; using pg8::H8_SCALE;
__device__ __forceinline__ void transpose_item(const float* W, int N, int K, bf16* dst0  , int k0, int n0, LAS float* scr, int lane, unsigned char* dst8 = nullptr  ) {
#pragma unroll 8
    for (int i = 0; i < 32; ++i) { const int kk = 2 * i + (lane >> 5); scr[kk * 33 + (lane & 31)] = W[(size_t)(k0 + kk) * N + n0 + (lane & 31)]; }
    LDS_WAIT(); asm volatile("" ::: "memory");
    const int c = lane & 7;
#pragma unroll
    for (int j = 0; j < 4; ++j) { const int n = (lane >> 3) + 8 * j; const LAS float* s = scr + (8 * c) * 33 + n;
        v4u o; o.x = pk2(s[0 * 33], s[1 * 33]); o.y = pk2(s[2 * 33], s[3 * 33]); o.z = pk2(s[4 * 33], s[5 * 33]); o.w = pk2(s[6 * 33], s[7 * 33]);
        *(GAS v4u*)(dst0 + (size_t)n * K + k0 + 8 * c) = o;
        if (dst8) { typedef unsigned u32x2_ __attribute__((ext_vector_type(2)));
            *(GAS u32x2_*)(dst8 + (size_t)n * K + k0 + 8 * c) = (u32x2_){f8x4(W8_SCALE * s[0 * 33], W8_SCALE * s[1 * 33], W8_SCALE * s[2 * 33], W8_SCALE * s[3 * 33]), f8x4(W8_SCALE * s[4 * 33], W8_SCALE * s[5 * 33], W8_SCALE * s[6 * 33], W8_SCALE * s[7 * 33])}; } }
    LDS_WAIT(); asm volatile("" ::: "memory");
}
__device__ __forceinline__ int up_row(int n0) { const int part = n0 / FF, j = n0 % FF; return 256 * (j / 128) + 128 * part + (j % 128); }

__device__ __forceinline__ void phase_prologue(const Args& a, LAS unsigned char* lds, int tid, int lane, int wave) {
    unsigned char* ws = a.ws;
    LAS float* cact = (LAS float*)lds;
    LAS float* red = (LAS float*)(lds + 16384);
    for (int i = tid; i < 4096; i += 512) cact[i] = siluf_(a.in[I_C][i]);
    __syncthreads();
    float* mod = (float*)(ws + WS_MOD);
    for (int it = blockIdx.x; it < (NMOD * D) / 32; it += gridDim.x) {
        const int n0 = it * 32, col = tid & 31, kg = tid >> 5;
        float a0 = 0.f, a1 = 0.f, a2 = 0.f, a3 = 0.f;
        const float* wp = a.in[I_WADA] + (size_t)(kg * 64) * (NMOD * D) + n0 + col;
#pragma unroll 8
        for (int kk = 0; kk < 64; ++kk) { const float w = wp[(size_t)kk * (NMOD * D)]; const int k = kg * 64 + kk;
            a0 += cact[k] * w; a1 += cact[1024 + k] * w; a2 += cact[2048 + k] * w; a3 += cact[3072 + k] * w; }
        red[(kg * 4 + 0) * 32 + col] = a0; red[(kg * 4 + 1) * 32 + col] = a1; red[(kg * 4 + 2) * 32 + col] = a2; red[(kg * 4 + 3) * 32 + col] = a3;
        __syncthreads();
        if (tid < 128) { const int b = tid >> 5, c2 = tid & 31; float s = 0.f;
#pragma unroll
            for (int g = 0; g < 16; ++g) s += red[(g * 4 + b) * 32 + c2];
            mod[b * (NMOD * D) + n0 + c2] = s + a.in[I_BADA][n0 + c2]; }
        __syncthreads();
    }
    __syncthreads();
    LAS float* scr = (LAS float*)(lds + wave * 16384);
    const int gw = blockIdx.x * NWAVES + wave, NGW = gridDim.x * NWAVES;
    constexpr int I_UP = (D / 64) * (2 * FF / 32), I_DN = (FF / 64) * (D / 32), I_IN = (D / 64) * (IN_COLS / 32), I_A = (512 / 64) * (D / 32), I_B = (D / 64) * (D / 32);
    constexpr int NITEMS = 2 * I_UP + 2 * I_DN + I_IN + I_A + 2 * I_B;
    for (int it = gw; it < NITEMS; it += NGW) {
        int r = it;
        if (r < 2 * I_UP) { const int wsel = r / I_UP; r %= I_UP; const int nblk = 2 * FF / 32, kb = r / nblk, nb = r % nblk;
            const float* W = a.in[wsel ? I_WUP2 : I_WUP1]; bf16* dst = (bf16*)(ws + (wsel ? WS_WUP2 : WS_WUP1));
            transpose_item(W, 2 * FF, D, dst + (size_t)up_row(32 * nb) * D, 64 * kb, 32 * nb, scr, lane); continue; }
        r -= 2 * I_UP;
        if (r < 2 * I_DN) { const int wsel = r / I_DN; r %= I_DN; const int nblk = D / 32, kb = r / nblk, nb = r % nblk;
            const float* W = a.in[wsel ? I_WDN2 : I_WDN1]; bf16* dst = (bf16*)(ws + (wsel ? WS_WDN2 : WS_WDN1));
            transpose_item(W, D, FF, dst + (size_t)(32 * nb) * FF, 64 * kb, 32 * nb, scr, lane); continue; }
        r -= 2 * I_DN;
        if (r < I_IN) { const int nblk = IN_COLS / 32, kb = r / nblk, nb = r % nblk, n0 = 32 * nb;
            bf16* dst;
            if (n0 < 512) dst = (bf16*)(ws + WS_WIN1) + (size_t)(1024 + n0) * D;
            else if (n0 < 1024) { const int j = n0 - 512; dst = (bf16*)(ws + WS_WIN1) + (size_t)(256 * (j / 128) + (j % 128)) * D; }
            else if (n0 < 1536) { const int j = n0 - 1024; dst = (bf16*)(ws + WS_WIN1) + (size_t)(256 * (j / 128) + 128 + (j % 128)) * D; }
            else if (n0 < 4608) dst = (bf16*)(ws + WS_WIN1) + (size_t)n0 * D;
            else if (n0 < 5632) dst = (bf16*)(ws + WS_WIN2) + (size_t)(n0 - 4608) * D;
            else if (n0 < 5664) dst = (bf16*)(ws + WS_WIN1) + (size_t)(4608 + n0 - 5632) * D;
            else dst = (bf16*)(ws + WS_WIN2) + (size_t)(1024 + n0 - 5664) * D;
            transpose_item(a.in[I_WIN], IN_COLS, D, dst, 64 * kb, n0, scr, lane); continue; }
        r -= I_IN;
        if (r < I_A) { const int nblk = D / 32, kb = r / nblk, nb = r % nblk; transpose_item(a.in[I_WAO], D, 512, (bf16*)(ws + WS_WA) + (size_t)(32 * nb) * 512, 64 * kb, 32 * nb, scr, lane); continue; }
        r -= I_A;
        { const int wsel = r / I_B; r %= I_B; const int nblk = D / 32, kb = r / nblk, nb = r % nblk;
          transpose_item(a.in[wsel ? I_WOUT : I_WBO], D, D, (bf16*)(ws + (wsel ? WS_WO : WS_WB)) + (size_t)(32 * nb) * D, 64 * kb, 32 * nb, scr, lane); }
    }
}

__device__ __forceinline__ void phase_first(const Args& a, const float* mod, bf16* dst, int tid, int lane, int wave) {
    unsigned char* ws = a.ws;
    const int gw = blockIdx.x * NWAVES + wave, NGW = gridDim.x * NWAVES;
    float* ssq0 = (float*)(ws + WS_SSQ);
    const float* nw = a.in[I_NF1];
    for (int m0 = gw; m0 < M; m0 += 4 * NGW) {
        f32x4 v[4][4];
#pragma unroll
        for (int q = 0; q < 4; ++q) { const int mq = (m0 + q * NGW < M) ? m0 + q * NGW : m0; const GAS f32x4* xr = (const GAS f32x4*)(a.in[I_X] + (size_t)mq * D) + lane;
#pragma unroll
            for (int j = 0; j < 4; ++j) v[q][j] = xr[64 * j]; }
#pragma unroll
        for (int q = 0; q < 4; ++q) { const int m = m0 + q * NGW; if (m >= M) break; const int b = m / SEQ; const float* sc = mod + b * (NMOD * D) + 1 * D; float s = 0.f;
#pragma unroll
            for (int j = 0; j < 4; ++j) s += (v[q][j].x * v[q][j].x + v[q][j].y * v[q][j].y) + (v[q][j].z * v[q][j].z + v[q][j].w * v[q][j].w);
            s = wave_sum(s);
            f32x4 y[4]; float amax = 1e-30f;
#pragma unroll
            for (int j = 0; j < 4; ++j) { const int c = 4 * lane + 256 * j; const f32x4 w = *(const f32x4*)(nw + c), s1 = *(const f32x4*)(sc + c);
                y[j] = v[q][j] * w * (s1 + 1.0f);
                amax = __builtin_fmaxf(__builtin_fmaxf(amax, __builtin_fmaxf(__builtin_fabsf(y[j].x), __builtin_fabsf(y[j].y))), __builtin_fmaxf(__builtin_fabsf(y[j].z), __builtin_fabsf(y[j].w))); }
            amax = wave_max(amax);
            const float qs = 127.f * __builtin_amdgcn_rcpf(amax);
            if (lane == 0) ssq0[m] = __builtin_amdgcn_rsqf(s * (1.f / D) + EPS) * amax * (1.f / 127.f);
            GAS unsigned* o4 = (GAS unsigned*)((unsigned char*)dst + (size_t)m * D) + lane;
#pragma unroll
            for (int j = 0; j < 4; ++j) o4[64 * j] = i8x4(y[j].x * qs, y[j].y * qs, y[j].z * qs, y[j].w * qs); }
    }
    for (int it = gw; it < 2 * (2 * FF / 4); it += NGW) {
        const int sel = it >= 2 * FF / 4, r0 = 4 * (sel ? it - 2 * FF / 4 : it);
        const bf16* W = (const bf16*)(ws + (sel ? WS_WUP2 : WS_WUP1)); float* out = (float*)(ws + WS_BW + (sel ? BW_UP2 : BW_UP1)); const int shi = sel ? 6 : 0;
        v4u wr_[4][2];
#pragma unroll
        for (int q = 0; q < 4; ++q) { wr_[q][0] = *(const GAS v4u*)(W + (size_t)(r0 + q) * D + 16 * lane); wr_[q][1] = *(const GAS v4u*)(W + (size_t)(r0 + q) * D + 16 * lane + 8); }
        f32x4 shv[4][4];
#pragma unroll
        for (int b = 0; b < 4; ++b)
#pragma unroll
            for (int e = 0; e < 4; ++e) shv[b][e] = *(const f32x4*)(mod + b * (NMOD * D) + shi * D + 16 * lane + 4 * e);
#pragma unroll
        for (int q = 0; q < 4; ++q) { float wv[16]; unpack8f(wr_[q][0], wv); unpack8f(wr_[q][1], wv + 8); float acc[4];
#pragma unroll
            for (int b = 0; b < 4; ++b) { float s = 0.f;
#pragma unroll
                for (int e = 0; e < 4; ++e) s += (wv[4 * e] * shv[b][e].x + wv[4 * e + 1] * shv[b][e].y) + (wv[4 * e + 2] * shv[b][e].z + wv[4 * e + 3] * shv[b][e].w);
                acc[b] = wave_sum(s); }
            if (lane < 4) out[(size_t)lane * (2 * FF) + r0 + q] = (lane == 0) ? acc[0] : (lane == 1) ? acc[1] : (lane == 2) ? acc[2] : acc[3];
            float amax = 1e-30f;
#pragma unroll
            for (int e = 0; e < 16; ++e) amax = __builtin_fmaxf(amax, __builtin_fabsf(wv[e]));
            amax = wave_max(amax);
            const float qs = 127.f * __builtin_amdgcn_rcpf(amax);
            v4u o; o.x = i8x4(wv[0] * qs, wv[1] * qs, wv[2] * qs, wv[3] * qs); o.y = i8x4(wv[4] * qs, wv[5] * qs, wv[6] * qs, wv[7] * qs);
            o.z = i8x4(wv[8] * qs, wv[9] * qs, wv[10] * qs, wv[11] * qs); o.w = i8x4(wv[12] * qs, wv[13] * qs, wv[14] * qs, wv[15] * qs);
            *(GAS v4u*)(ws + (sel ? WS_WUP2I8 : WS_WUP1I8) + (size_t)(r0 + q) * D + 16 * lane) = o;
            if (lane == 0) ((float*)(ws + WS_CF))[sel * (2 * FF) + r0 + q] = amax * (1.f / 127.f); }
    }
    for (int r = gw; r < N_IN2; r += NGW) {
        const bf16* W = (const bf16*)(ws + WS_WIN2) + (size_t)r * D + 16 * lane;
        const v4u w0 = *(const GAS v4u*)W, w1 = *(const GAS v4u*)(W + 8);
        float wv[16]; unpack8f(w0, wv); unpack8f(w1, wv + 8);
        float amax = 1e-30f;
#pragma unroll
        for (int e = 0; e < 16; ++e) amax = __builtin_fmaxf(amax, __builtin_fabsf(wv[e]));
        amax = wave_max(amax);
        const float qs = 127.f * __builtin_amdgcn_rcpf(amax);
        v4u o; o.x = i8x4(wv[0] * qs, wv[1] * qs, wv[2] * qs, wv[3] * qs); o.y = i8x4(wv[4] * qs, wv[5] * qs, wv[6] * qs, wv[7] * qs);
        o.z = i8x4(wv[8] * qs, wv[9] * qs, wv[10] * qs, wv[11] * qs); o.w = i8x4(wv[12] * qs, wv[13] * qs, wv[14] * qs, wv[15] * qs);
        *(GAS v4u*)(ws + WS_WIN2I8 + (size_t)r * D + 16 * lane) = o;
        if (lane == 0) ((float*)(ws + WS_CF3))[r] = amax * (1.f / 127.f);
    }
    float* cwp = (float*)(ws + WS_CW);
    for (int i = blockIdx.x * 512 + tid; i < 2 * 4 * D; i += gridDim.x * 512) { const int k = i >> 12, b = (i >> 10) & 3, c = i & 1023;
        cwp[i] = a.in[k ? I_NF2 : I_NMIX][c] * (1.0f + mod[b * (NMOD * D) + (k ? 7 : 4) * D + c]); }
}
__device__ __forceinline__ void phase_mix_norm(const bf16* h, const float* ssq, const float* cw, const float* sh, bf16* dst, unsigned char* dst8, float* rsx, int lane, int wave) {
    const int gw = blockIdx.x * NWAVES + wave, NGW = gridDim.x * NWAVES;
    for (int m0 = gw; m0 < M; m0 += 4 * NGW) {
        v4u hv[4][2];
#pragma unroll
        for (int q = 0; q < 4; ++q) { const int mq = (m0 + q * NGW < M) ? m0 + q * NGW : m0; const GAS v4u* hr = (const GAS v4u*)(h + (size_t)mq * D) + lane; hv[q][0] = hr[0]; hv[q][1] = hr[64]; }
#pragma unroll
        for (int q = 0; q < 4; ++q) { const int m = m0 + q * NGW; if (m >= M) break; const int b = m / SEQ; const float rstd = pg8::row_rstd(ssq, m); GAS v4u* orow = (GAS v4u*)(dst + (size_t)m * D) + lane;
            float yy[2][8]; float amax = 1e-30f;
#pragma unroll
            for (int j = 0; j < 2; ++j) { float x[8]; unpack8f(hv[q][j], x); const int c = 8 * lane + 512 * j;
                const f32x4 w0 = *(const f32x4*)(cw + b * 1024 + c), w1 = *(const f32x4*)(cw + b * 1024 + c + 4), s0 = *(const f32x4*)(sh + (size_t)b * (NMOD * D) + c), s1 = *(const f32x4*)(sh + (size_t)b * (NMOD * D) + c + 4);
                float y[8] = {x[0] * rstd * w0.x + s0.x, x[1] * rstd * w0.y + s0.y, x[2] * rstd * w0.z + s0.z, x[3] * rstd * w0.w + s0.w, x[4] * rstd * w1.x + s1.x, x[5] * rstd * w1.y + s1.y, x[6] * rstd * w1.z + s1.z, x[7] * rstd * w1.w + s1.w};
                orow[64 * j] = pack8f(y);
#pragma unroll
                for (int e = 0; e < 8; ++e) { yy[j][e] = y[e]; amax = __builtin_fmaxf(amax, __builtin_fabsf(y[e])); } }
            amax = wave_max(amax);
            const float qs = 127.f * __builtin_amdgcn_rcpf(amax);
            typedef unsigned u32x2_ __attribute__((ext_vector_type(2)));
#pragma unroll
            for (int j = 0; j < 2; ++j) *(GAS u32x2_*)(dst8 + (size_t)m * D + 8 * lane + 512 * j) = (u32x2_){i8x4(yy[j][0] * qs, yy[j][1] * qs, yy[j][2] * qs, yy[j][3] * qs), i8x4(yy[j][4] * qs, yy[j][5] * qs, yy[j][6] * qs, yy[j][7] * qs)};
            if (lane == 0) rsx[m] = amax * (1.f / 127.f); }
    }
}
__device__ __forceinline__ void phase_final_norm(const bf16* h3, const float* ssq, float* out, const float* nw, int lane, int wave) {
    const int gw = blockIdx.x * NWAVES + wave, NGW = gridDim.x * NWAVES;
    for (int m0 = gw; m0 < M; m0 += 4 * NGW) {
        v4u hv[4][2];
#pragma unroll
        for (int q = 0; q < 4; ++q) { const int mq = (m0 + q * NGW < M) ? m0 + q * NGW : m0; const GAS v4u* hr = (const GAS v4u*)(h3 + (size_t)mq * D) + lane; hv[q][0] = hr[0]; hv[q][1] = hr[64]; }
#pragma unroll
        for (int q = 0; q < 4; ++q) { const int m = m0 + q * NGW; if (m >= M) break; const float rstd = pg8::row_rstd(ssq, m); GAS f32x4* orow = (GAS f32x4*)(out + (size_t)m * D);
#pragma unroll
            for (int j = 0; j < 2; ++j) { float x[8]; unpack8f(hv[q][j], x); const int c = 8 * lane + 512 * j;
                const f32x4 w0 = *(const f32x4*)(nw + c), w1 = *(const f32x4*)(nw + c + 4);
                orow[(c >> 2)] = (f32x4){x[0] * rstd * w0.x, x[1] * rstd * w0.y, x[2] * rstd * w0.z, x[3] * rstd * w0.w};
                orow[(c >> 2) + 1] = (f32x4){x[4] * rstd * w1.x, x[5] * rstd * w1.y, x[6] * rstd * w1.z, x[7] * rstd * w1.w}; } }
    }
}
__device__ __forceinline__ void phase_rstd_q(const float* ssq16, float* rstd, const bf16* a16, unsigned char* a8, int lane, int wave) {
    const int gw = blockIdx.x * NWAVES + wave, NGW = gridDim.x * NWAVES;
    for (int m0 = gw; m0 < M; m0 += 4 * NGW) {
        v4u hv[4][2];
#pragma unroll
        for (int q = 0; q < 4; ++q) { const int mq = (m0 + q * NGW < M) ? m0 + q * NGW : m0; const GAS v4u* hr = (const GAS v4u*)(a16 + (size_t)mq * D) + 2 * lane; hv[q][0] = hr[0]; hv[q][1] = hr[1]; }
#pragma unroll
        for (int q = 0; q < 4; ++q) { const int m = m0 + q * NGW; if (m >= M) break;
            float x[16]; unpack8f(hv[q][0], x); unpack8f(hv[q][1], x + 8);
            float amax = 1e-30f;
#pragma unroll
            for (int e = 0; e < 16; ++e) amax = __builtin_fmaxf(amax, __builtin_fabsf(x[e]));
            amax = wave_max(amax);
            const float qs = 127.f * __builtin_amdgcn_rcpf(amax);
            v4u o; o.x = i8x4(x[0] * qs, x[1] * qs, x[2] * qs, x[3] * qs); o.y = i8x4(x[4] * qs, x[5] * qs, x[6] * qs, x[7] * qs);
            o.z = i8x4(x[8] * qs, x[9] * qs, x[10] * qs, x[11] * qs); o.w = i8x4(x[12] * qs, x[13] * qs, x[14] * qs, x[15] * qs);
            *((GAS v4u*)(a8 + (size_t)m * D) + lane) = o;
            if (lane == 0) rstd[m] = pg8::row_rstd(ssq16, m) * amax * (1.f / 127.f); }
    }
}
__device__ __forceinline__ void phase_rstd(const float* ssq16, float* rstd, int tid) {
    for (int m = blockIdx.x * 512 + tid; m < M; m += gridDim.x * 512) rstd[m] = pg8::row_rstd(ssq16, m);
}
__device__ __forceinline__ void phase_conv_qkv(const bf16* src, bf16* dst, const float* cw  , bool do_norm, float scale, int lane, int wave) {
    const int gw = blockIdx.x * NWAVES + wave, NGW = gridDim.x * NWAVES;
    const int c0 = (gw & 1) * 512 + 8 * lane;
    float w[5][8];
#pragma unroll
    for (int i = 0; i < 5; ++i)
#pragma unroll
        for (int e = 0; e < 8; ++e) w[i][e] = cw[i * 3072 + c0 + e];
    for (int it = gw; it < 2 * (M / 32); it += NGW) {
        const int r0 = (it >> 1) * 32, s0 = r0 & (SEQ - 1);
        v4u raw[12];
#define CONV_LOAD(ch_) do { _Pragma("unroll") for (int k = 0; k < 12; ++k) { const int ss = s0 + 8 * (ch_) - 2 + k; raw[k] = (v4u){0u, 0u, 0u, 0u}; \
            if (ss >= 0 && ss < SEQ) raw[k] = *(const GAS v4u*)(src + (size_t)(r0 + 8 * (ch_) - 2 + k) * D + c0); } } while (0)
        CONV_LOAD(0);
#pragma unroll 1
        for (int ch = 0; ch < 4; ++ch) {
            float x[12][8];
#pragma unroll
            for (int k = 0; k < 12; ++k) unpack8f(raw[k], x[k]);
            if (ch < 3) CONV_LOAD(ch + 1);
#pragma unroll
            for (int o = 0; o < 8; ++o) { float acc[8]; float ssq = 0.f;
#pragma unroll
                for (int e = 0; e < 8; ++e) { float t = x[o][e] * w[0][e];
#pragma unroll
                    for (int i = 1; i < 5; ++i) t += x[o + i][e] * w[i][e];
                    t = siluf_(t); acc[e] = t; ssq += t * t; }
                if (do_norm) { const float r = scale * __builtin_amdgcn_rsqf(sum16(ssq) + EPS);
#pragma unroll
                    for (int e = 0; e < 8; ++e) acc[e] *= r; }
                *(GAS v4u*)(dst + (size_t)(r0 + 8 * ch + o) * D + c0) = pack8f(acc); }
        }
#undef CONV_LOAD
    }
}
__device__ __forceinline__ void phase_ya(const bf16* cab, const bf16* cv, const float* cw  , bf16* ya, int lane, int wave) {
    const int gw = blockIdx.x * NWAVES + wave, NGW = gridDim.x * NWAVES, c0 = 8 * lane;
    float w[3][8];
#pragma unroll
    for (int i = 0; i < 3; ++i)
#pragma unroll
        for (int e = 0; e < 8; ++e) w[i][e] = cw[i * 512 + c0 + e];
    for (int it = gw; it < M / 32; it += NGW) {
        const int r0 = it * 32, s0 = r0 & (SEQ - 1);
#pragma unroll 1
        for (int ch = 0; ch < 4; ++ch) {
            float x[10][8]; v4u g[8];
#pragma unroll
            for (int k = 0; k < 10; ++k) { const int ss = s0 + 8 * ch - 1 + k; v4u raw = {0u, 0u, 0u, 0u};
                if (ss >= 0 && ss < SEQ) raw = *(const GAS v4u*)(cv + (size_t)(r0 + 8 * ch - 1 + k) * 512 + c0);
                unpack8f(raw, x[k]); }
#pragma unroll
            for (int o = 0; o < 8; ++o) g[o] = *(const GAS v4u*)(cab + (size_t)(r0 + 8 * ch + o) * 512 + c0);
#pragma unroll
            for (int o = 0; o < 8; ++o) { float acc[8], gf[8]; unpack8f(g[o], gf);
#pragma unroll
                for (int e = 0; e < 8; ++e) acc[e] = (x[o][e] * w[0][e] + x[o + 1][e] * w[1][e] + x[o + 2][e] * w[2][e]) * gf[e];
                *(GAS v4u*)(ya + (size_t)(r0 + 8 * ch + o) * 512 + c0) = pack8f(acc); }
        }
    }
}
__device__ __forceinline__ void phase_ba(const bf16* xn, const bf16* wba, float* ba, int lane, int wave) {
    typedef short bf16x8 __attribute__((ext_vector_type(8)));
    const int gw = blockIdx.x * NWAVES + wave, NGW = gridDim.x * NWAVES, c16 = lane & 15, q4 = lane >> 4;
    for (int it = gw; it < M / 16; it += NGW) {
        const bf16* ap = xn + (size_t)(16 * it + c16) * D + 8 * q4; const bf16* bp0 = wba + (size_t)c16 * D + 8 * q4; const bf16* bp1 = bp0 + (size_t)16 * D;
        f32x4 acc0 = {0.f, 0.f, 0.f, 0.f}, acc1 = {0.f, 0.f, 0.f, 0.f};
#pragma unroll 8
        for (int ks = 0; ks < D / 32; ++ks) {
            const bf16x8 a = *(const bf16x8*)(ap + 32 * ks), b0 = *(const bf16x8*)(bp0 + 32 * ks), b1 = *(const bf16x8*)(bp1 + 32 * ks);
            acc0 = __builtin_amdgcn_mfma_f32_16x16x32_bf16(a, b0, acc0, 0, 0, 0); acc1 = __builtin_amdgcn_mfma_f32_16x16x32_bf16(a, b1, acc1, 0, 0, 0); }
#pragma unroll
        for (int r = 0; r < 4; ++r) { float* o = ba + (size_t)(16 * it + 4 * q4 + r) * 32; o[c16] = acc0[r]; o[16 + c16] = acc1[r]; }
    }
}
__device__ __forceinline__ void phase_gb(const Args& a, const float* ba, float* gb, int tid) {
    for (int i = blockIdx.x * 512 + tid; i < M * 32; i += gridDim.x * 512) {
        const int row = i >> 5, j = i & 31, part = j >> 3, h = j & 7; const float x = ba[i]; float r;
        if (part < 2) r = sigmoidf_(x);
        else { const float al = a.in[part == 2 ? I_ALF : I_ALB][h], dt = a.in[part == 2 ? I_DTF : I_DTB][h]; const float y = x + dt;
            const float sp = y > 20.f ? y : log1pf(__expf(y)); r = -__expf(al) * sp; }
        gb[(size_t)part * M * 8 + (size_t)row * 8 + h] = r;
    }
}
namespace scan {
typedef short bf16x8 __attribute__((ext_vector_type(8)));
typedef short s16x4 __attribute__((ext_vector_type(4)));
typedef float f32x4 __attribute__((ext_vector_type(4)));
typedef unsigned u32x2 __attribute__((ext_vector_type(2)));
typedef unsigned long long u64;
typedef u64 u64x2 __attribute__((ext_vector_type(2)));
typedef __bf16 nbf16x8 __attribute__((ext_vector_type(8)));
typedef __bf16 nbf16x2 __attribute__((ext_vector_type(2)));
typedef float f32x8 __attribute__((ext_vector_type(8)));
typedef float f32x2 __attribute__((ext_vector_type(2)));
constexpr int RS = 288, TS = 144, VSS = 80;
constexpr int KNB = 0, QNB = 55296, VSB = 92160, SCB = 102400;
constexpr int KN_BYTES = 18432, VS_BYTES = 5120, SC_BYTES = 1280;
constexpr int ATTB = 106240, ANEGB = 124672, DMB = 143104, SCAN_LDS_END = 147200;
static_assert(SCAN_LDS_END <= LDSCTL_OFF, "scan LDS");
__device__ __forceinline__ bf16x8 frag2(u64 lo, u64 hi) { return __builtin_bit_cast(bf16x8, (u64x2){lo, hi}); }
__device__ __forceinline__ bf16x8 packB(f32x4 a, f32x4 b) { const f32x8 v = {a[0], a[1], a[2], a[3], b[0], b[1], b[2], b[3]}; return __builtin_bit_cast(bf16x8, __builtin_convertvector(v, nbf16x8)); }
__device__ __forceinline__ bf16x8 packB1(f32x4 a) { const f32x8 v = {a[0], a[1], a[2], a[3], 0.f, 0.f, 0.f, 0.f}; return __builtin_bit_cast(bf16x8, __builtin_convertvector(v, nbf16x8)); }
__device__ __forceinline__ unsigned cvt2(float lo, float hi) { const f32x2 v = {lo, hi}; return __builtin_bit_cast(unsigned, __builtin_convertvector(v, nbf16x2)); }
__device__ __forceinline__ unsigned short cvt1(float x) { return (unsigned short)(cvt2(x, 0.f) & 0xffffu); }
#define MFMA16(a, b, c) __builtin_amdgcn_mfma_f32_16x16x32_bf16((a), (b), (c), 0, 0, 0)
__device__ __forceinline__ bf16x8 ldA1(LAS unsigned char* base, int stride, int c16, int q4, int col0) {
    LAS unsigned char* p = base + c16 * stride + (col0 + 4 * q4) * 2; return frag2(*(LAS u64*)p, 0ull); }
__device__ __forceinline__ bf16x8 ldAtr(LAS unsigned char* tile, int c16, int q4, int row0, int dt) {
    LAS unsigned char* p = tile + (row0 + 4 * q4 + (c16 >> 2)) * RS + (32 * (dt >> 1) + 8 * (c16 & 3) + 4 * (dt & 1)) * 2;
    const s16x4 lo = __builtin_amdgcn_ds_read_tr16_b64_v4i16((LAS s16x4*)p), hi = __builtin_amdgcn_ds_read_tr16_b64_v4i16((LAS s16x4*)(p + 16 * RS));
    return (bf16x8){lo[0], lo[1], lo[2], lo[3], hi[0], hi[1], hi[2], hi[3]}; }
__device__ __forceinline__ bf16x8 ldA16(LAS unsigned char* base, int stride, int c16, int q4, int col0) { return *(LAS bf16x8*)(base + c16 * stride + (col0 + 8 * q4) * 2); }
__device__ __forceinline__ int tpos(int tj, int q4) { return 32 * (tj >> 1) + 8 * q4 + 4 * (tj & 1); }
__device__ __forceinline__ void d_invert(f32x4 at, LAS unsigned char* dmb, int c16, int q4) {
    LAS unsigned char* wp = dmb + c16 * 32 + 8 * q4;
    LAS unsigned char* rp = dmb + (4 * q4 + (c16 >> 2)) * 32 + 8 * (c16 & 3);
    const f32x4 z = {0.f, 0.f, 0.f, 0.f};
    f32x4 nt = -at, pt;
#pragma unroll
    for (int r = 0; r < 4; ++r) pt[r] = nt[r] + ((4 * q4 + r == c16) ? 1.f : 0.f);
#pragma unroll
    for (int k = 0; k < 4; ++k) {
        *(LAS u32x2*)wp = (u32x2){cvt2(nt[0], nt[1]), cvt2(nt[2], nt[3])};
        const s16x4 lo = __builtin_amdgcn_ds_read_tr16_b64_v4i16((LAS s16x4*)rp);
        const bf16x8 aop = (bf16x8){lo[0], lo[1], lo[2], lo[3], 0, 0, 0, 0};
        if (k > 0) pt = MFMA16(aop, packB1(pt), pt);
        if (k < 3) nt = MFMA16(aop, packB1(nt), z);
    }
    *(LAS u32x2*)wp = (u32x2){cvt2(pt[0], pt[1]), cvt2(pt[2], pt[3])};
}
template <int NT> __device__ __forceinline__ void c_tiles(LAS unsigned char* kn, LAS unsigned char* qn, LAS float* scf, LAS unsigned char* att, LAS unsigned char* aneg, f32x4& adiag, int ti, int tj0, int c16, int q4) {
    f32x4 acck[NT], accq[NT];
#pragma unroll
    for (int t = 0; t < NT; ++t) { acck[t] = (f32x4){0.f, 0.f, 0.f, 0.f}; accq[t] = (f32x4){0.f, 0.f, 0.f, 0.f}; }
    bf16x8 fa[2][NT], fk[2], fq[2];
#define C_LOAD(bf_, ks_) do { fk[bf_] = *(LAS bf16x8*)(kn + (16 * ti + c16) * RS + (ks_) * 64 + q4 * 16); fq[bf_] = *(LAS bf16x8*)(qn + (16 * ti + c16) * RS + (ks_) * 64 + q4 * 16); \
        _Pragma("unroll") for (int t = 0; t < NT; ++t) fa[bf_][t] = *(LAS bf16x8*)(kn + (16 * (tj0 + t) + c16) * RS + (ks_) * 64 + q4 * 16); } while (0)
    C_LOAD(0, 0);
#pragma unroll
    for (int ks = 0; ks < 4; ++ks) {
        if (ks == 0) C_LOAD(1, 1); else if (ks == 1) C_LOAD(0, 2); else if (ks == 2) C_LOAD(1, 3);
        __builtin_amdgcn_sched_barrier(0);
#pragma unroll
        for (int t = 0; t < NT; ++t) { acck[t] = MFMA16(fa[ks & 1][t], fk[ks & 1], acck[t]); accq[t] = MFMA16(fa[ks & 1][t], fq[ks & 1], accq[t]); }
        __builtin_amdgcn_sched_barrier(0);
    }
#undef C_LOAD
    const int I = 16 * ti + c16;
    const float gi = scf[I], bi = scf[128 + I];
#pragma unroll
    for (int t = 0; t < NT; ++t) {
        const int tj = tj0 + t, J0 = 16 * tj + 4 * q4;
        const f32x4 gj = *(LAS f32x4*)(scf + J0);
        f32x4 a, tt;
#pragma unroll
        for (int r = 0; r < 4; ++r) { const float dec = __expf(gi - gj[r]);
            a[r] = (I > J0 + r) ? bi * acck[t][r] * dec : 0.f; tt[r] = (I >= J0 + r) ? accq[t][r] * dec : 0.f; }
        *(LAS u32x2*)(att + I * TS + tpos(tj, q4) * 2) = (u32x2){cvt2(tt[0], tt[1]), cvt2(tt[2], tt[3])};
        if (tj == ti) adiag = a;
        else *(LAS u32x2*)(aneg + I * TS + tpos(tj, q4) * 2) = (u32x2){cvt2(-a[0], -a[1]), cvt2(-a[2], -a[3])};
    }
}
__device__ __forceinline__ void e_solve(const f32x4 (&rhs)[4], f32x4 (&X)[4], const bf16x8 (&Df)[4], bf16x8 A10, bf16x8 A2x, bf16x8 A3a, bf16x8 A3b) {
    const f32x4 z = {0.f, 0.f, 0.f, 0.f};
    X[0] = MFMA16(Df[0], packB1(rhs[0]), z);
    f32x4 y = MFMA16(A10, packB1(X[0]), rhs[1]);
    X[1] = MFMA16(Df[1], packB1(y), z);
    const bf16x8 x01 = packB(X[0], X[1]);
    y = MFMA16(A2x, x01, rhs[2]);
    f32x4 y3 = MFMA16(A3a, x01, rhs[3]);
    X[2] = MFMA16(Df[2], packB1(y), z);
    y3 = MFMA16(A3b, packB1(X[2]), y3);
    X[3] = MFMA16(Df[3], packB1(y3), z);
}
__device__ __forceinline__ void phase_scan(const bf16* Q, const bf16* K, const bf16* V, const float* gbuf, bf16* OF, bf16* OB, LAS unsigned char* lds, int tid, int lane, int wave) {
    constexpr int NC = SEQ / 64;
    for (int item = blockIdx.x; item < BATCH * NH * 2 * 4; item += gridDim.x) {
        const int xq = item & 7, yq = item >> 3, ci = xq * 8 + (yq >> 2), sl = yq & 3;
        const int b = ci >> 4, h = (ci >> 1) & 7, dir = ci & 1;
        const float* betap = gbuf + (size_t)dir * M * 8 + h; const float* glp = gbuf + (size_t)(2 + dir) * M * 8 + h; bf16* O = dir ? OB : OF;
        const size_t rowbase = (size_t)b * SEQ;
        __syncthreads();
        for (int i = tid; i < 2 * 9216 / 4; i += 512) ((LAS unsigned*)(lds + ATTB))[i] = 0u;
        v4u kreg[2], qreg[2], vreg = {0u, 0u, 0u, 0u}; float greg = 0.f, breg = 0.f;
#define SCAN_LOAD(n_) do { \
            _Pragma("unroll") for (int r = 0; r < 2; ++r) { const int pi = tid + 512 * r, row = pi >> 4, pc = pi & 15; const int p = 64 * (n_) + row; const int s = dir ? (SEQ - 1 - p) : p; \
                const size_t off = (rowbase + s) * D + h * 128 + pc * 8; kreg[r] = *(const GAS v4u*)(K + off); qreg[r] = *(const GAS v4u*)(Q + off); } \
            if (tid < 256) { const int row = tid >> 2, pc = tid & 3; const int p = 64 * (n_) + row; const int s = dir ? (SEQ - 1 - p) : p; vreg = *(const GAS v4u*)(V + (rowbase + s) * D + h * 128 + sl * 32 + pc * 8); } \
            if (wave == 6) { const int p = 64 * (n_) + lane; const int s = dir ? (SEQ - 1 - p) : p; greg = glp[(rowbase + s) * 8]; breg = betap[(rowbase + s) * 8]; } } while (0)
#define SCAN_STAGE(k3_, p2_) do { LAS unsigned char* knw_ = lds + KNB + (k3_) * KN_BYTES; LAS unsigned char* qnw_ = lds + QNB + (p2_) * KN_BYTES; LAS unsigned char* vsw_ = lds + VSB + (p2_) * VS_BYTES; \
            _Pragma("unroll") for (int r = 0; r < 2; ++r) { const int pi = tid + 512 * r, row = pi >> 4, pc = pi & 15; \
                *(LAS v4u*)(knw_ + row * RS + pc * 16) = kreg[r]; *(LAS v4u*)(qnw_ + row * RS + pc * 16) = qreg[r]; } \
            if (tid < 256) { const int row = tid >> 2, pc = tid & 3; *(LAS v4u*)(vsw_ + row * VSS + pc * 16) = vreg; } \
            if (wave == 6) { float g = greg; LAS float* scw = (LAS float*)(lds + SCB + (k3_) * SC_BYTES); \
                g = dpp_add<0x111>(g); g = dpp_add<0x112>(g); g = dpp_add<0x114>(g); g = dpp_add<0x118>(g);        \
                g = dpp_add<0x142, 0xa>(g); g = dpp_add<0x143, 0xc>(g);                                          \
                const float g63 = __shfl(g, 63), eg = __expf(g); \
                scw[lane] = g; scw[64 + lane] = breg * eg; scw[128 + lane] = breg; scw[192 + lane] = eg; scw[256 + lane] = __expf(g63 - g); } } while (0)
        SCAN_LOAD(0);
        SCAN_STAGE(0, 0);
        SCAN_LOAD(1);
        __syncthreads();
#define SCAN_ITER_PTRS \
            const bool have_prod = (n + 1 < NC), have_cons = (n >= 0), have_stage = (n + 2 < NC); (void)have_prod; (void)have_cons; \
            LAS unsigned char* knc = lds + KNB + k3c * KN_BYTES; LAS unsigned char* knp = lds + KNB + k3p * KN_BYTES;              \
            LAS unsigned char* qnc = lds + QNB + (n & 1) * KN_BYTES; LAS unsigned char* qnp = lds + QNB + ((n + 1) & 1) * KN_BYTES; \
            LAS unsigned char* vsc = lds + VSB + (n & 1) * VS_BYTES; \
            LAS float* scc = (LAS float*)(lds + SCB + k3c * SC_BYTES); LAS float* scp = (LAS float*)(lds + SCB + k3p * SC_BYTES); \
            LAS unsigned char* attc = lds + ATTB + (n & 1) * 9216; LAS unsigned char* attp = lds + ATTB + ((n + 1) & 1) * 9216; \
            LAS unsigned char* anegc = lds + ANEGB + (n & 1) * 9216; LAS unsigned char* anegp = lds + ANEGB + ((n + 1) & 1) * 9216; \
            LAS unsigned char* dmc = lds + DMB + (n & 1) * 2048; LAS unsigned char* dmp = lds + DMB + ((n + 1) & 1) * 2048; \
            (void)knc; (void)knp; (void)qnc; (void)qnp; (void)vsc; (void)scc; (void)scp; (void)attc; (void)attp; (void)anegc; (void)anegp; (void)dmc; (void)dmp; \
            int lane_o = lane; asm volatile("" : "+v"(lane_o)); const int c16 = lane_o & 15, q4 = lane_o >> 4;
#define SCAN_ITER_NEXT do { k3c = k3p; k3p = k3s; k3s = (k3s == 2) ? 0 : k3s + 1; } while (0)
        if (wave < 2) {
            f32x4 S[8];
#pragma unroll
            for (int t = 0; t < 8; ++t) S[t] = (f32x4){0.f, 0.f, 0.f, 0.f};
            int k3c = 2, k3p = 0, k3s = 1;
            for (int n = -1; n < NC; ++n) {
                SCAN_ITER_PTRS
                f32x4 R[4], ao[4], vn[4];
                if (have_cons) {
                    bf16x8 Sb[4];
#pragma unroll
                    for (int ks = 0; ks < 4; ++ks) Sb[ks] = packB(S[2 * ks], S[2 * ks + 1]);
                    bf16x8 kf[2][4], qf[2][4]; f32x4 kbv[2], bev[2]; float egv[2]; s16x4 vraw[2];
                    bf16x8 Df[4], A10, A2x, A3a, A3b;
#define F1_LOAD(bf_, it_) do { _Pragma("unroll") for (int ks = 0; ks < 4; ++ks) { kf[bf_][ks] = ldA16(knc + 16 * (it_) * RS, RS, c16, q4, 32 * ks); qf[bf_][ks] = ldA16(qnc + 16 * (it_) * RS, RS, c16, q4, 32 * ks); } \
                        kbv[bf_] = *(LAS f32x4*)(scc + 64 + 16 * (it_) + 4 * q4); bev[bf_] = *(LAS f32x4*)(scc + 128 + 16 * (it_) + 4 * q4); egv[bf_] = scc[192 + 16 * (it_) + c16]; \
                        vraw[bf_] = __builtin_amdgcn_ds_read_tr16_b64_v4i16((LAS s16x4*)(vsc + (16 * (it_) + 4 * q4 + (c16 >> 2)) * VSS + (16 * wave + 4 * (c16 & 3)) * 2)); } while (0)
                    F1_LOAD(0, 0);
#pragma unroll
                    for (int it = 0; it < 4; ++it) {
                        if (it == 0) F1_LOAD(1, 1); else if (it == 1) F1_LOAD(0, 2); else if (it == 2) F1_LOAD(1, 3);
                        else {
#pragma unroll
                            for (int r = 0; r < 4; ++r) Df[r] = ldA1(dmc + r * 512, 32, c16, q4, 0);
                            A10 = frag2(*(LAS u64*)(anegc + (16 + c16) * TS + tpos(0, q4) * 2), 0ull); A2x = ldA16(anegc + 32 * TS, TS, c16, q4, 0);
                            A3a = ldA16(anegc + 48 * TS, TS, c16, q4, 0); A3b = frag2(*(LAS u64*)(anegc + (48 + c16) * TS + tpos(2, q4) * 2), 0ull); }
                        __builtin_amdgcn_sched_barrier(0);
                        const int bf = it & 1;
                        f32x4 ak = {0.f, 0.f, 0.f, 0.f}, aq = {0.f, 0.f, 0.f, 0.f};
#pragma unroll
                        for (int ks = 0; ks < 4; ++ks) { ak = MFMA16(kf[bf][ks], Sb[ks], ak); aq = MFMA16(Sb[ks], qf[bf][ks], aq); }
                        f32x4 vb;
#pragma unroll
                        for (int rr = 0; rr < 4; ++rr) vb[rr] = bf2f((unsigned short)vraw[bf][rr]) * bev[bf][rr];
                        R[it] = vb - kbv[bf] * ak; ao[it] = aq * egv[bf];
                        __builtin_amdgcn_sched_barrier(0);
                    }
#undef F1_LOAD
                    e_solve(R, vn, Df, A10, A2x, A3a, A3b);
                }
                __syncthreads();
                if (have_stage) SCAN_STAGE(k3s, n & 1);
                if (n + 3 < NC) SCAN_LOAD(n + 3);
                if (have_cons) {
                    const float egl = scc[192 + 63];
                    bf16x8 tf[2][4][2];
#define F2_LOAD(bf_, dt0_) do { _Pragma("unroll") for (int d = 0; d < 4; ++d) _Pragma("unroll") for (int s2 = 0; s2 < 2; ++s2) tf[bf_][d][s2] = ldAtr(knc, c16, q4, 32 * s2, (dt0_) + d); } while (0)
                    F2_LOAD(0, 0);
                    F2_LOAD(1, 4);
                    bf16x8 Vb[2], Vd[2];
#pragma unroll
                    for (int s2 = 0; s2 < 2; ++s2) { const f32x4 e0 = *(LAS f32x4*)(scc + 256 + 32 * s2 + 4 * q4), e1 = *(LAS f32x4*)(scc + 256 + 32 * s2 + 16 + 4 * q4);
                        Vb[s2] = packB(vn[2 * s2], vn[2 * s2 + 1]); Vd[s2] = packB(vn[2 * s2] * e0, vn[2 * s2 + 1] * e1); }
                    __builtin_amdgcn_sched_barrier(0);
#pragma unroll
                    for (int d = 0; d < 4; ++d) { f32x4 a = S[d] * egl;
#pragma unroll
                        for (int s2 = 0; s2 < 2; ++s2) a = MFMA16(tf[0][d][s2], Vd[s2], a);
                        S[d] = a; }
#pragma unroll
                    for (int it = 0; it < 4; ++it)
#pragma unroll
                        for (int s2 = 0; s2 < 2; ++s2) tf[0][it][s2] = ldA16(attc + 16 * it * TS, TS, c16, q4, 32 * s2);
                    __builtin_amdgcn_sched_barrier(0);
#pragma unroll
                    for (int d = 0; d < 4; ++d) { f32x4 a = S[4 + d] * egl;
#pragma unroll
                        for (int s2 = 0; s2 < 2; ++s2) a = MFMA16(tf[1][d][s2], Vd[s2], a);
                        S[4 + d] = a; }
                    __builtin_amdgcn_sched_barrier(0);
#undef F2_LOAD
#pragma unroll
                    for (int it = 0; it < 4; ++it) {
#pragma unroll
                        for (int s2 = 0; s2 < 2; ++s2) ao[it] = MFMA16(Vb[s2], tf[0][it][s2], ao[it]);
                        const int p = 64 * n + 16 * it + c16; const int s = dir ? (SEQ - 1 - p) : p;
                        *(GAS u32x2*)(O + (rowbase + s) * D + h * 128 + sl * 32 + 16 * wave + 4 * q4) = (u32x2){cvt2(ao[it][0], ao[it][1]), cvt2(ao[it][2], ao[it][3])}; }
                }
                SCAN_ITER_NEXT;
                __syncthreads();
            }
        } else {
            int k3c = 2, k3p = 0, k3s = 1;
            for (int n = -1; n < NC; ++n) {
                SCAN_ITER_PTRS
                f32x4 adiag = {0.f, 0.f, 0.f, 0.f};
                const int ti = (wave < 4) ? 3 : (wave == 6 || wave == 5) ? 2 : (wave == 7) ? 1 : 0, tj0 = (wave == 3) ? 2 : (wave == 6) ? 1 : 0;
                if (have_prod) {
                    if (wave != 4 && wave != 5) c_tiles<2>(knp, qnp, scp, attp, anegp, adiag, ti, tj0, c16, q4);
                    else c_tiles<1>(knp, qnp, scp, attp, anegp, adiag, ti, tj0, c16, q4); }
                __syncthreads();
                if (have_stage) SCAN_STAGE(k3s, n & 1);
                if (n + 3 < NC) SCAN_LOAD(n + 3);
                if (have_prod && wave != 2 && wave != 5) d_invert(adiag, dmp + ti * 512, c16, q4);
                SCAN_ITER_NEXT;
                __syncthreads();
            }
        }
#undef SCAN_ITER_PTRS
#undef SCAN_ITER_NEXT
#undef SCAN_LOAD
#undef SCAN_STAGE
    }
}
#undef MFMA16
}

__device__ __forceinline__ void phase_onorm(bf16* of, const bf16* ob, const float* dnw, int lane, int wave) {
    const int gw = blockIdx.x * NWAVES + wave, NGW = gridDim.x * NWAVES, hh = lane >> 4, cp = lane & 15;
    float w[8];
#pragma unroll
    for (int e = 0; e < 8; ++e) w[e] = dnw[8 * cp + e];
    for (int it0 = gw; it0 < M * 2; it0 += 4 * NGW) {
        v4u xa[4], ya[4];
#pragma unroll
        for (int q = 0; q < 4; ++q) { const int it = (it0 + q * NGW < M * 2) ? it0 + q * NGW : it0; const size_t off = (size_t)(it >> 1) * D + (4 * (it & 1) + hh) * 128 + 8 * cp; xa[q] = *(const GAS v4u*)(of + off); ya[q] = *(const GAS v4u*)(ob + off); }
#pragma unroll
        for (int q = 0; q < 4; ++q) { const int it = it0 + q * NGW; if (it >= M * 2) break; const size_t off = (size_t)(it >> 1) * D + (4 * (it & 1) + hh) * 128 + 8 * cp;
            float x[8], y[8]; unpack8f(xa[q], x); unpack8f(ya[q], y);
            float ssq = 0.f;
#pragma unroll
            for (int e = 0; e < 8; ++e) { x[e] += y[e]; ssq += x[e] * x[e]; }
            const float r = __builtin_amdgcn_rsqf(sum16(ssq) * (1.f / 128.f) + EPS);
#pragma unroll
            for (int e = 0; e < 8; ++e) x[e] = x[e] * r * w[e];
            *(GAS v4u*)(of + off) = pack8f(x); }
    }
}

template <class Epi, int QMODE = 0> __device__ __forceinline__ void run_gemm(LAS unsigned char* lds, const bf16* A, const bf16* Bt, int N, int K, const Epi& E) {
    pg8::Gemm g{A, Bt, M, N, K}; pg8::StaticOrder S; S.init(M, N, (int)gridDim.x, (int)blockIdx.x);
    pg8::gemm_phase<Epi, pg8::StaticOrder, true, true, QMODE>(lds, g, S, E);
}

__global__ void __launch_bounds__(NWAVES * 64, 2) mk_fwd(Args args) {
    extern __shared__ __attribute__((aligned(16))) unsigned char lds_raw[];
    LAS unsigned char* lds = (LAS unsigned char*)lds_raw;
    volatile LAS unsigned* MISC = (volatile LAS unsigned*)(lds + MISC_OFF);
    const int tid = threadIdx.x, lane = tid & 63, wave = __builtin_amdgcn_readfirstlane(tid >> 6);
    unsigned char* ws = args.ws;
    for (int u = tid; u < (LDS_BYTES - LDSCTL_OFF) / 4; u += NWAVES * 64) ((LAS unsigned*)(lds + LDSCTL_OFF))[u] = 0u;
    __syncthreads();
    XcdBarrier bar; bar.bar = (unsigned*)(ws + WS_CTL); bar.x = 0; bar.st = nullptr;
    const int lo = args.ph_lo, hi = args.ph_hi;
    if (hi - lo > 1) bar = xcd_barrier_post((unsigned*)(ws + WS_CTL), MISC + 8);
    float* mod = (float*)(ws + WS_MOD);
    bf16* XN = (bf16*)(ws + WS_XN); bf16* HID = (bf16*)(ws + WS_HID);


#define IN(k) (lo <= (k) && (k) < hi)
#define TIDS int tid = threadIdx.x; asm volatile("" : "+v"(tid)); const int lane = tid & 63; const int wave = __builtin_amdgcn_readfirstlane(tid >> 6); (void)lane; (void)wave;
#define SEAM(k) do { if (IN(k) && (k) + 1 < hi) xcd_barrier(bar); } while (0)
    const float* ssqv = (const float*)(ws + WS_SSQ); float* ssqw = (float*)(ws + WS_SSQ);
    bf16* HB1 = (bf16*)args.out; bf16* HB2 = (bf16*)(ws + WS_HB2); bf16* HB3 = (bf16*)(ws + WS_HB3);
    const float* cw2 = (const float*)(ws + WS_CW); const float* cw3 = cw2 + 4 * D;
    if (IN(0)) { TIDS phase_prologue(args, lds, tid, lane, wave); } SEAM(0);
    if (IN(1)) { TIDS phase_first(args, mod, XN, tid, lane, wave); } SEAM(1);
    if (IN(2)) { TIDS pg8::EpiGlu<false, true> E{HID, FF, ssqv, (const float*)(ws + WS_BW + BW_UP1), 2 * FF, (LAS float*)(lds + RING_BYTES), (const float*)(ws + WS_CF)};
        run_gemm<pg8::EpiGlu<false, true>, 2>(lds, XN, (const bf16*)(ws + WS_WUP1I8), 2 * FF, D / 2, E); } SEAM(2);
    if (IN(3)) { TIDS pg8::EpiRes<true> E{args.in[I_X], HB1, nullptr, mod + 2 * D, NMOD * D, 0.5f, nullptr, ssqw + (size_t)16 * M}; run_gemm(lds, HID, (const bf16*)(ws + WS_WDN1), D, FF, E); } SEAM(3);
    unsigned char* XN8T = (unsigned char*)args.out + (size_t)M * D * 2;
    if (IN(4)) { TIDS phase_mix_norm(HB1, ssqv + (size_t)16 * M, cw2, mod + 3 * D, XN, XN8T, (float*)(ws + WS_RSX), lane, wave); } SEAM(4);
    if (IN(5)) { TIDS phase_ba(XN, (const bf16*)(ws + WS_WIN1) + (size_t)4608 * D, (float*)(ws + WS_BA), lane, wave);
        pg8::EpiIn1 E{(bf16*)(ws + WS_CV), (bf16*)(ws + WS_CAB), (bf16*)(ws + WS_QRAW), (size_t)M * D, (float*)(ws + WS_BA)};
        run_gemm(lds, XN, (const bf16*)(ws + WS_WIN1), N_IN1, D, E); } SEAM(5);
    if (IN(6)) { TIDS phase_conv_qkv((const bf16*)(ws + WS_QRAW), (bf16*)(ws + WS_QF), args.in[I_CONVDN], true, 0.08838834764831845f, lane, wave);
        phase_ya((const bf16*)(ws + WS_CAB), (const bf16*)(ws + WS_CV), args.in[I_CONVA], (bf16*)(ws + WS_YA), lane, wave);
        phase_gb(args, (const float*)(ws + WS_BA), (float*)(ws + WS_GB), tid);
        { const GAS v4u* src = (const GAS v4u*)XN8T; GAS v4u* dst = (GAS v4u*)(ws + WS_XN); for (size_t i = (size_t)blockIdx.x * 512 + tid; i < (size_t)M * D / 16; i += (size_t)gridDim.x * 512) dst[i] = src[i]; } } SEAM(6);
    bf16* VFp = (bf16*)args.out + (size_t)M * D;
    if (IN(7)) { TIDS phase_conv_qkv((const bf16*)(ws + WS_KRAW), (bf16*)(ws + WS_KF), args.in[I_CONVDN] + 1024, true, 1.0f, lane, wave);
        phase_conv_qkv((const bf16*)(ws + WS_VRAW), VFp, args.in[I_CONVDN] + 2048, false, 1.0f, lane, wave); } SEAM(7);
    if (IN(9)) { TIDS scan::phase_scan((const bf16*)(ws + WS_QF), (const bf16*)(ws + WS_KF), (const bf16*)VFp, (const float*)(ws + WS_GB), (bf16*)(ws + WS_OF), (bf16*)(ws + WS_OB), lds, tid, lane, wave); } SEAM(9);
    if (IN(10)) { TIDS phase_onorm((bf16*)(ws + WS_OF), (const bf16*)(ws + WS_OB), args.in[I_DNNORM], lane, wave); } SEAM(10);
    if (IN(11)) { TIDS pg8::EpiIn2Q E{(bf16*)(ws + WS_OF), (bf16*)(ws + WS_SGA), (bf16*)(ws + WS_SGB), (const float*)(ws + WS_RSX), (const float*)(ws + WS_CF3), (LAS float*)(lds + RING_BYTES)};
        run_gemm<pg8::EpiIn2Q, 2>(lds, XN, (const bf16*)(ws + WS_WIN2I8), N_IN2, D / 2, E); } SEAM(11);
    if (IN(12)) { TIDS pg8::EpiMul E{(bf16*)(ws + WS_SGA)}; run_gemm(lds, (const bf16*)(ws + WS_YA), (const bf16*)(ws + WS_WA), D, 512, E);
        asm volatile("s_waitcnt vmcnt(0)" ::: "memory"); __builtin_amdgcn_fence(__ATOMIC_ACQUIRE, "agent"); asm volatile("s_waitcnt vmcnt(0)" ::: "memory"); __syncthreads(); }
    if (IN(13)) { TIDS pg8::EpiMerge E{(const bf16*)(ws + WS_SGA), (bf16*)(ws + WS_SGB)}; run_gemm(lds, (const bf16*)(ws + WS_OF), (const bf16*)(ws + WS_WB), D, D, E); } SEAM(13);
    if (IN(14)) { TIDS pg8::EpiRes<false> E{HB1, HB2, XN, mod + 5 * D, NMOD * D, 1.0f, cw3, ssqw + (size_t)32 * M}; run_gemm(lds, (const bf16*)(ws + WS_SGB), (const bf16*)(ws + WS_WO), D, D, E); } SEAM(14);
    if (IN(15)) { TIDS phase_rstd_q(ssqv + (size_t)32 * M, ssqw + (size_t)M, XN, ws + WS_YA, lane, wave); } SEAM(15);
    if (IN(16)) { TIDS pg8::EpiGlu<false, true> E{HID, FF, ssqv + (size_t)M, (const float*)(ws + WS_BW + BW_UP2), 2 * FF, (LAS float*)(lds + RING_BYTES), (const float*)(ws + WS_CF) + 2 * FF};
        run_gemm<pg8::EpiGlu<false, true>, 2>(lds, (const bf16*)(ws + WS_YA), (const bf16*)(ws + WS_WUP2I8), 2 * FF, D / 2, E); } SEAM(16);
    if (IN(17)) { TIDS pg8::EpiRes<false> E{HB2, HB3, nullptr, mod + 8 * D, NMOD * D, 0.5f, nullptr, ssqw + (size_t)48 * M}; run_gemm(lds, HID, (const bf16*)(ws + WS_WDN2), D, FF, E); } SEAM(17);
    if (IN(18)) { TIDS phase_final_norm(HB3, ssqv + (size_t)48 * M, args.out, args.in[I_NFIN], lane, wave); }
#undef IN
#undef SEAM
}

extern "C" void kernel_launch(void* const* d_in, const int* in_sizes, int n_in, void* d_out, int out_size, void* d_ws, size_t ws_size, hipStream_t stream) {
    static int grid = 0;
    if (grid == 0) {
        if (n_in != 23 || in_sizes[0] != M * D || out_size != M * D || ws_size < WS_END) { fprintf(stderr, "kernel_launch: unexpected problem: n_in %d in0 %d out %d ws %zu (need %zu)\n", n_in, n_in > 0 ? in_sizes[0] : -1, out_size, ws_size, (size_t)WS_END); grid = -1; return; }
        int dev = 0, cus = 0, per_cu = 0;
        if (hipGetDevice(&dev) != hipSuccess || hipDeviceGetAttribute(&cus, hipDeviceAttributeMultiprocessorCount, dev) != hipSuccess) { grid = -1; return; }
        if (hipFuncSetAttribute((const void*)mk_fwd, hipFuncAttributeMaxDynamicSharedMemorySize, LDS_BYTES) != hipSuccess) { fprintf(stderr, "kernel_launch: hipFuncSetAttribute failed\n"); grid = -1; return; }
        if (hipOccupancyMaxActiveBlocksPerMultiprocessor(&per_cu, (const void*)mk_fwd, NWAVES * 64, LDS_BYTES) != hipSuccess || per_cu < 1)
            fprintf(stderr, "kernel_launch: note: occupancy query reports %d workgroups per CU\n", per_cu);
        (void)hipGetLastError();
        grid = cus;
    }
    if (grid < 0) return;
    (void)hipMemsetAsync((char*)d_ws + WS_CTL, 0, CTL_ZERO_BYTES, stream);
    Args a{};
    for (int i = 0; i < 23; ++i) a.in[i] = (const float*)d_in[i];
    a.out = (float*)d_out; a.ws = (unsigned char*)d_ws;
#if MK_SPLIT
    for (int ph = 0; ph < NPHASE; ++ph) { a.ph_lo = ph; a.ph_hi = ph + 1; hipLaunchKernelGGL(mk_fwd, dim3(grid), dim3(NWAVES * 64), LDS_BYTES, stream, a); }
#else
    a.ph_lo = 0; a.ph_hi = NPHASE; hipLaunchKernelGGL(mk_fwd, dim3(grid), dim3(NWAVES * 64), LDS_BYTES, stream, a);
#endif
    const hipError_t le = hipPeekAtLastError();
    if (le != hipSuccess) fprintf(stderr, "kernel_launch: launch failed: %s\n", hipGetErrorName(le));
}
```

```cpp
#include <hip/hip_runtime.h>
#include <cstdio>
#include <cstdint>
namespace pg8 {
#define PG8_LAS __attribute__((address_space(3)))
typedef unsigned short bf16_t;
typedef short bf16x8 __attribute__((ext_vector_type(8)));
typedef float f32x4 __attribute__((ext_vector_type(4)));
typedef unsigned u32x4 __attribute__((ext_vector_type(4)));
constexpr int BM = 256, BK = 64, HALF = 128, HTB = HALF * BK * 2  , STAGE_BYTES = 8 * HTB, NXCD = 8, WGM = 8;

__host__ __device__ __forceinline__ int lds_byte(int r, int c) { const int st = (r >> 4) * 2 + (c >> 5), rr = r & 15, cc = c & 31, ob = rr * 64 + cc * 2; return st * 1024 + (ob ^ (((ob >> 9) & 1) << 5)); }
__host__ __device__ __forceinline__ void stage_rc(int b, int& R, int& C) { const int st = b / 1024, sb = b % 1024, swz = sb ^ (((sb >> 9) & 1) << 5); R = (st >> 1) * 16 + swz / 64; C = (st & 1) * 32 + (swz % 64) / 2; }
__host__ __device__ __forceinline__ int perm32(int rho) { const int n = rho >> 4, i = rho & 15; return 8 * (i >> 2) + 4 * n + (i & 3); }

struct Unit { int pm, pn; };
struct Gemm { const bf16_t* A; const bf16_t* Bt; int M, N, K; };

struct StaticOrder {
    int nM, nN, nwg, G, c;
    __host__ __device__ void init(int M, int N, int G_, int c_) { nM = M / BM; nN = N / BM; nwg = nM * nN; G = G_; c = c_; }
    __host__ __device__ bool next(int i, Unit& u) const {
        const long L = (long)i * G + c; if (L >= nwg) return false;
        int wgid = (int)L; { const int q = nwg / NXCD, r = nwg % NXCD, xcd = wgid % NXCD, off = wgid / NXCD; wgid = (xcd < r ? xcd * (q + 1) : r * (q + 1) + (xcd - r) * q) + off; }
        const int nig = WGM * nN, gid = wgid / nig, fm = gid * WGM, gsz = (nM - fm) < WGM ? (nM - fm) : WGM;
        u.pm = fm + ((wgid % nig) % gsz); u.pn = (wgid % nig) / gsz; return true;
    }
    __device__ __forceinline__ void a_ready(const Unit&) const {}
    __device__ __forceinline__ void done(const Unit&) const {}
};
__device__ __forceinline__ unsigned cvt_pk_bf16(float lo, float hi) { typedef float f32x2_ __attribute__((ext_vector_type(2))); typedef __bf16 bf16x2_ __attribute__((ext_vector_type(2)));
    const f32x2_ v = {lo, hi}; return __builtin_bit_cast(unsigned, __builtin_convertvector(v, bf16x2_)); }
__device__ __forceinline__ float fast_sigmoid(float x) { return __builtin_amdgcn_rcpf(1.0f + __builtin_amdgcn_exp2f(-1.4426950408889634f * x)); }
__device__ __forceinline__ float fast_silu(float x) { return x * fast_sigmoid(x); }
__device__ __forceinline__ f32x4 silu4(f32x4 v) { return (f32x4){fast_silu(v[0]), fast_silu(v[1]), fast_silu(v[2]), fast_silu(v[3])}; }
__device__ __forceinline__ f32x4 sigm4(f32x4 v) { return (f32x4){fast_sigmoid(v[0]), fast_sigmoid(v[1]), fast_sigmoid(v[2]), fast_sigmoid(v[3])}; }
__device__ __forceinline__ u32x4 pack8(f32x4 v0, f32x4 v1) { u32x4 w; w.x = cvt_pk_bf16(v0[0], v0[1]); w.y = cvt_pk_bf16(v0[2], v0[3]); w.z = cvt_pk_bf16(v1[0], v1[1]); w.w = cvt_pk_bf16(v1[2], v1[3]); return w; }
__device__ __forceinline__ void unpack8(u32x4 w, f32x4& v0, f32x4& v1) {
    v0 = (f32x4){__uint_as_float(w.x << 16), __uint_as_float(w.x & 0xffff0000u), __uint_as_float(w.y << 16), __uint_as_float(w.y & 0xffff0000u)};
    v1 = (f32x4){__uint_as_float(w.z << 16), __uint_as_float(w.z & 0xffff0000u), __uint_as_float(w.w << 16), __uint_as_float(w.w & 0xffff0000u)}; }

__device__ __forceinline__ float row_rstd(const float* ssq, int row) {
    const f32x4 a = *(const f32x4*)(ssq + (size_t)row * 16), b = *(const f32x4*)(ssq + (size_t)row * 16 + 4), c = *(const f32x4*)(ssq + (size_t)row * 16 + 8), d = *(const f32x4*)(ssq + (size_t)row * 16 + 12);
    const float s = ((a[0] + a[1]) + (a[2] + a[3])) + ((b[0] + b[1]) + (b[2] + b[3])) + (((c[0] + c[1]) + (c[2] + c[3])) + ((d[0] + d[1]) + (d[2] + d[3])));
    return __builtin_amdgcn_rsqf(s * (1.0f / 1024.0f) + 1e-6f); }
__device__ __forceinline__ unsigned f8x4(float a, float b, float c, float d) {
    a = __builtin_fminf(__builtin_fmaxf(a, -448.f), 448.f); b = __builtin_fminf(__builtin_fmaxf(b, -448.f), 448.f); c = __builtin_fminf(__builtin_fmaxf(c, -448.f), 448.f); d = __builtin_fminf(__builtin_fmaxf(d, -448.f), 448.f);
    unsigned w = 0u; w = __builtin_amdgcn_cvt_pk_fp8_f32(a, b, w, false); w = __builtin_amdgcn_cvt_pk_fp8_f32(c, d, w, true); return w; }
constexpr float W8_SCALE = 64.f;
constexpr float H8_SCALE = 8.f;
template <bool OUT8, bool CS = false> struct EpiGlu {
    static constexpr bool PERM = true, AFTER_DRAIN = false, PREFETCH = true;
    bf16_t* O; int ldo; const float* rstd; const float* bw; int bw_bstride; PG8_LAS float* tbl; const float* cf;
    __device__ __forceinline__ void prefetch(const Unit& u, int par, int wid, int lane) const {
        if (wid < 4) {
            const float* rp = rstd + (size_t)u.pm * BM + 64 * wid + lane;
            const float* bp = bw + (size_t)((u.pm * BM) >> 13) * bw_bstride + u.pn * BM + 64 * wid + lane;
            __builtin_amdgcn_global_load_lds((const unsigned*)rp, (PG8_LAS unsigned*)(tbl + par * 768 + 64 * wid), 4, 0, 0);
            __builtin_amdgcn_global_load_lds((const unsigned*)bp, (PG8_LAS unsigned*)(tbl + par * 768 + 256 + 64 * wid), 4, 0, 0);
            if constexpr (CS) __builtin_amdgcn_global_load_lds((const unsigned*)(cf + (size_t)u.pn * BM + 64 * wid + lane), (PG8_LAS unsigned*)(tbl + par * 768 + 512 + 64 * wid), 4, 0, 0);
        }
    }
    __device__ __forceinline__ void run(const f32x4 (&acc)[2][2][4][2], const Unit& u, int par, int wr, int wc, int fr, int fq) const {
        const int row0 = u.pm * BM + wr * 64 + fr, cl = wc * 32 + 8 * fq, col0 = u.pn * HALF + cl;
        const PG8_LAS float* tr = tbl + par * 768 + wr * 64 + fr; const PG8_LAS float* tb = tbl + par * 768 + 256 + cl;
        const f32x4 ba0 = *(const PG8_LAS f32x4*)tb, ba1 = *(const PG8_LAS f32x4*)(tb + 4), bb0 = *(const PG8_LAS f32x4*)(tb + HALF), bb1 = *(const PG8_LAS f32x4*)(tb + HALF + 4);
        f32x4 ca0 = {1.f, 1.f, 1.f, 1.f}, ca1 = ca0, cb0 = ca0, cb1 = ca0;
        if constexpr (CS) { ca0 = *(const PG8_LAS f32x4*)(tb + 256); ca1 = *(const PG8_LAS f32x4*)(tb + 256 + 4); cb0 = *(const PG8_LAS f32x4*)(tb + 256 + HALF); cb1 = *(const PG8_LAS f32x4*)(tb + 256 + HALF + 4); }
#pragma unroll
        for (int ai = 0; ai < 2; ++ai)
#pragma unroll
            for (int m = 0; m < 4; ++m) { const int row = row0 + ai * HALF + m * 16; const float rr = tr[ai * HALF + m * 16]; bf16_t* rowp = O + (size_t)row * ldo + col0;
                f32x4 h0, h1;
                if constexpr (CS) { h0 = silu4(acc[ai][0][m][0] * (ca0 * rr) + ba0) * (acc[ai][1][m][0] * (cb0 * rr) + bb0); h1 = silu4(acc[ai][0][m][1] * (ca1 * rr) + ba1) * (acc[ai][1][m][1] * (cb1 * rr) + bb1); }
                else { h0 = silu4(acc[ai][0][m][0] * rr + ba0) * (acc[ai][1][m][0] * rr + bb0); h1 = silu4(acc[ai][0][m][1] * rr + ba1) * (acc[ai][1][m][1] * rr + bb1); }
                if constexpr (OUT8) { typedef unsigned u32x2_ __attribute__((ext_vector_type(2))); const f32x4 g0 = h0 * H8_SCALE, g1 = h1 * H8_SCALE;
                    *(u32x2_*)((unsigned char*)O + (size_t)row * ldo + col0) = (u32x2_){f8x4(g0[0], g0[1], g0[2], g0[3]), f8x4(g1[0], g1[1], g1[2], g1[3])}; }
                else *(u32x4*)rowp = pack8(h0, h1); }
    }
};
template <bool BASE_F32> struct EpiRes {
    static constexpr bool PERM = true, AFTER_DRAIN = false, PREFETCH = false;
    const void* base; bf16_t* hout; bf16_t* aout; const float* gate; int gate_bstride; float scale; const float* cw; float* ssq;
    __device__ __forceinline__ void operator()(const f32x4 (&acc)[2][2][4][2], const Unit& u, int wr, int wc, int fr, int fq) const {
        const int row0 = u.pm * BM + wr * 64 + fr, col0 = u.pn * BM + wc * 32 + 8 * fq, b = (u.pm * BM) >> 13;
        f32x4 gv[2][2], cv[2][2];
#pragma unroll
        for (int bj = 0; bj < 2; ++bj)
#pragma unroll
            for (int n = 0; n < 2; ++n) { gv[bj][n] = *(const f32x4*)(gate + (size_t)b * gate_bstride + col0 + bj * HALF + 4 * n);
                cv[bj][n] = aout ? *(const f32x4*)(cw + b * 1024 + col0 + bj * HALF + 4 * n) : (f32x4){0.f, 0.f, 0.f, 0.f}; }
        asm volatile("" ::: "memory");
        constexpr int AHEAD = BASE_F32 ? 3 : 4;
        f32x4 pf[BASE_F32 ? AHEAD : 1][2][2]; u32x4 pb[BASE_F32 ? 1 : AHEAD][2];
#define EPIRES_LOAD(slot, grp) do { const size_t off_ = (size_t)(row0 + ((grp) >> 2) * HALF + ((grp) & 3) * 16) * 1024 + col0; \
            if (BASE_F32) { _Pragma("unroll") for (int bj = 0; bj < 2; ++bj) _Pragma("unroll") for (int n = 0; n < 2; ++n) pf[BASE_F32 ? (slot) : 0][bj][n] = *(const f32x4*)((const float*)base + off_ + bj * HALF + 4 * n); } \
            else { _Pragma("unroll") for (int bj = 0; bj < 2; ++bj) pb[BASE_F32 ? 0 : (slot)][bj] = *(const u32x4*)((const bf16_t*)base + off_ + bj * HALF); } } while (0)
#pragma unroll
        for (int grp = 0; grp < AHEAD; ++grp) EPIRES_LOAD(grp, grp);
#pragma unroll
        for (int grp = 0; grp < 8; ++grp) { const int ai = grp >> 2, m = grp & 3, slot = grp % AHEAD, row = row0 + ai * HALF + m * 16; const size_t off = (size_t)row * 1024 + col0;
            float ss = 0.f;
#pragma unroll
            for (int bj = 0; bj < 2; ++bj) { f32x4 b0, b1;
                if (BASE_F32) { b0 = pf[BASE_F32 ? slot : 0][bj][0]; b1 = pf[BASE_F32 ? slot : 0][bj][1]; } else unpack8(pb[BASE_F32 ? 0 : slot][bj], b0, b1);
                const f32x4 h0 = b0 + (gv[bj][0] * scale) * acc[ai][bj][m][0], h1 = b1 + (gv[bj][1] * scale) * acc[ai][bj][m][1];
                ss += (h0[0] * h0[0] + h0[1] * h0[1]) + (h0[2] * h0[2] + h0[3] * h0[3]) + (h1[0] * h1[0] + h1[1] * h1[1]) + (h1[2] * h1[2] + h1[3] * h1[3]);
                *(u32x4*)(hout + off + bj * HALF) = pack8(h0, h1);
                if (aout) *(u32x4*)(aout + off + bj * HALF) = pack8(h0 * cv[bj][0], h1 * cv[bj][1]); }
            ss += __shfl_xor(ss, 16); ss += __shfl_xor(ss, 32);
            if (fq == 0) ssq[(size_t)row * 16 + u.pn * 4 + wc] = ss;
            if (grp + AHEAD < 8) { asm volatile("" ::: "memory"); EPIRES_LOAD(slot, grp + AHEAD); } }
#undef EPIRES_LOAD
    }
};
struct EpiIn1 {
    static constexpr bool PERM = true, AFTER_DRAIN = false, PREFETCH = false;
    bf16_t* CV; bf16_t* CAB; bf16_t* QKV; size_t qkv_stride; float* BA;
    __device__ __forceinline__ void operator()(const f32x4 (&acc)[2][2][4][2], const Unit& u, int wr, int wc, int fr, int fq) const {
        const int row0 = u.pm * BM + wr * 64 + fr, cl = wc * 32 + 8 * fq; const int pn = u.pn;
        if (pn < 4) {
#pragma unroll
            for (int ai = 0; ai < 2; ++ai)
#pragma unroll
                for (int m = 0; m < 4; ++m) { bf16_t* rowp = CV + (size_t)(row0 + ai * HALF + m * 16) * 512 + pn * HALF + cl;
                    *(u32x4*)rowp = pack8(acc[ai][0][m][0] * acc[ai][1][m][0], acc[ai][0][m][1] * acc[ai][1][m][1]); }
        } else {
            bf16_t* base; int ld, colt;
            if (pn < 6) { base = CAB; ld = 512; colt = (pn - 4) * BM; } else { const int t = pn - 6; base = QKV + (size_t)(t >> 2) * qkv_stride; ld = 1024; colt = (t & 3) * BM; }
#pragma unroll
            for (int ai = 0; ai < 2; ++ai)
#pragma unroll
                for (int m = 0; m < 4; ++m) { bf16_t* rowp = base + (size_t)(row0 + ai * HALF + m * 16) * ld + colt + cl;
#pragma unroll
                    for (int bj = 0; bj < 2; ++bj) *(u32x4*)(rowp + bj * HALF) = pack8(acc[ai][bj][m][0], acc[ai][bj][m][1]); }
        }
    }
};
struct EpiIn2 {
    static constexpr bool PERM = true, AFTER_DRAIN = false, PREFETCH = false;
    bf16_t* YB; bf16_t* SGA; bf16_t* SGB;
    __device__ __forceinline__ void operator()(const f32x4 (&acc)[2][2][4][2], const Unit& u, int wr, int wc, int fr, int fq) const {
        const int row0 = u.pm * BM + wr * 64 + fr, cl = wc * 32 + 8 * fq; const int pn = u.pn;
        long doff = (long)(SGA - YB); if (pn >= 8) doff = (long)(SGB - YB); if (pn < 4) doff = 0; bf16_t* base = YB + doff; const int colt = (pn & 3) * BM;
#pragma unroll
        for (int ai = 0; ai < 2; ++ai)
#pragma unroll
            for (int m = 0; m < 4; ++m) { bf16_t* rowp = base + (size_t)(row0 + ai * HALF + m * 16) * 1024 + colt + cl;
#pragma unroll
                for (int bj = 0; bj < 2; ++bj) {
                    if (pn < 4) { f32x4 o0, o1; unpack8(*(const u32x4*)(rowp + bj * HALF), o0, o1);
                        *(u32x4*)(rowp + bj * HALF) = pack8(o0 * silu4(acc[ai][bj][m][0]), o1 * silu4(acc[ai][bj][m][1])); }
                    else *(u32x4*)(rowp + bj * HALF) = pack8(sigm4(acc[ai][bj][m][0]), sigm4(acc[ai][bj][m][1])); } }
    }
};
struct EpiIn2Q {
    static constexpr bool PERM = true, AFTER_DRAIN = false, PREFETCH = true;
    bf16_t* YB; bf16_t* SGA; bf16_t* SGB; const float* rs; const float* cf; PG8_LAS float* tbl;
    __device__ __forceinline__ void prefetch(const Unit& u, int par, int wid, int lane) const {
        if (wid < 4) {
            __builtin_amdgcn_global_load_lds((const unsigned*)(rs + (size_t)u.pm * BM + 64 * wid + lane), (PG8_LAS unsigned*)(tbl + par * 768 + 64 * wid), 4, 0, 0);
            __builtin_amdgcn_global_load_lds((const unsigned*)(cf + (size_t)u.pn * BM + 64 * wid + lane), (PG8_LAS unsigned*)(tbl + par * 768 + 512 + 64 * wid), 4, 0, 0);
        }
    }
    __device__ __forceinline__ void run(const f32x4 (&acc)[2][2][4][2], const Unit& u, int par, int wr, int wc, int fr, int fq) const {
        const int row0 = u.pm * BM + wr * 64 + fr, cl = wc * 32 + 8 * fq; const int pn = u.pn;
        long doff = (long)(SGA - YB); if (pn >= 8) doff = (long)(SGB - YB); if (pn < 4) doff = 0; bf16_t* base = YB + doff; const int colt = (pn & 3) * BM;
        const PG8_LAS float* tr = tbl + par * 768 + wr * 64 + fr; const PG8_LAS float* tc = tbl + par * 768 + 512 + cl;
        f32x4 cs[2][2]; cs[0][0] = *(const PG8_LAS f32x4*)tc; cs[0][1] = *(const PG8_LAS f32x4*)(tc + 4); cs[1][0] = *(const PG8_LAS f32x4*)(tc + HALF); cs[1][1] = *(const PG8_LAS f32x4*)(tc + HALF + 4);
#pragma unroll
        for (int ai = 0; ai < 2; ++ai)
#pragma unroll
            for (int m = 0; m < 4; ++m) { const float rr = tr[ai * HALF + m * 16]; bf16_t* rowp = base + (size_t)(row0 + ai * HALF + m * 16) * 1024 + colt + cl;
#pragma unroll
                for (int bj = 0; bj < 2; ++bj) { const f32x4 z0 = acc[ai][bj][m][0] * (cs[bj][0] * rr), z1 = acc[ai][bj][m][1] * (cs[bj][1] * rr);
                    if (pn < 4) { f32x4 o0, o1; unpack8(*(const u32x4*)(rowp + bj * HALF), o0, o1);
                        *(u32x4*)(rowp + bj * HALF) = pack8(o0 * silu4(z0), o1 * silu4(z1)); }
                    else *(u32x4*)(rowp + bj * HALF) = pack8(sigm4(z0), sigm4(z1)); } }
    }
};
struct EpiMul {
    static constexpr bool PERM = true, AFTER_DRAIN = false, PREFETCH = false;
    bf16_t* T;
    __device__ __forceinline__ void operator()(const f32x4 (&acc)[2][2][4][2], const Unit& u, int wr, int wc, int fr, int fq) const {
        const int row0 = u.pm * BM + wr * 64 + fr, col0 = u.pn * BM + wc * 32 + 8 * fq;
        u32x4 tv[4][2];
#define EPIMUL_LOAD(slot, grp) do { _Pragma("unroll") for (int bj = 0; bj < 2; ++bj) tv[slot][bj] = *(const u32x4*)(T + (size_t)(row0 + ((grp) >> 2) * HALF + ((grp) & 3) * 16) * 1024 + col0 + bj * HALF); } while (0)
#pragma unroll
        for (int grp = 0; grp < 4; ++grp) EPIMUL_LOAD(grp, grp);
#pragma unroll
        for (int grp = 0; grp < 8; ++grp) { const int ai = grp >> 2, m = grp & 3, slot = grp & 3; bf16_t* rowp = T + (size_t)(row0 + ai * HALF + m * 16) * 1024 + col0;
#pragma unroll
            for (int bj = 0; bj < 2; ++bj) { f32x4 o0, o1; unpack8(tv[slot][bj], o0, o1);
                *(u32x4*)(rowp + bj * HALF) = pack8(o0 * acc[ai][bj][m][0], o1 * acc[ai][bj][m][1]); }
            if (grp + 4 < 8) { asm volatile("" ::: "memory"); EPIMUL_LOAD(slot, grp + 4); } }
#undef EPIMUL_LOAD
    }
};
struct EpiMerge {
    static constexpr bool PERM = true, AFTER_DRAIN = false, PREFETCH = false;
    const bf16_t* T; bf16_t* G;
    __device__ __forceinline__ void operator()(const f32x4 (&acc)[2][2][4][2], const Unit& u, int wr, int wc, int fr, int fq) const {
        const int row0 = u.pm * BM + wr * 64 + fr, col0 = u.pn * BM + wc * 32 + 8 * fq;
        u32x4 tv[4][2], gvv[4][2];
#define EPIMERGE_LOAD(slot, grp) do { const size_t off_ = (size_t)(row0 + ((grp) >> 2) * HALF + ((grp) & 3) * 16) * 1024 + col0; \
            _Pragma("unroll") for (int bj = 0; bj < 2; ++bj) { tv[slot][bj] = *(const u32x4*)(T + off_ + bj * HALF); gvv[slot][bj] = *(const u32x4*)(G + off_ + bj * HALF); } } while (0)
#pragma unroll
        for (int grp = 0; grp < 4; ++grp) EPIMERGE_LOAD(grp, grp);
#pragma unroll
        for (int grp = 0; grp < 8; ++grp) { const int ai = grp >> 2, m = grp & 3, slot = grp & 3; const size_t off = (size_t)(row0 + ai * HALF + m * 16) * 1024 + col0;
#pragma unroll
            for (int bj = 0; bj < 2; ++bj) { f32x4 t0, t1, g0, g1; unpack8(tv[slot][bj], t0, t1); unpack8(gvv[slot][bj], g0, g1);
                *(u32x4*)(G + off + bj * HALF) = pack8(t0 + g0 * acc[ai][bj][m][0], t1 + g1 * acc[ai][bj][m][1]); }
            if (grp + 4 < 8) { asm volatile("" ::: "memory"); EPIMERGE_LOAD(slot, grp + 4); } }
#undef EPIMERGE_LOAD
    }
};
typedef int i32x8 __attribute__((ext_vector_type(8)));
typedef int i32x4 __attribute__((ext_vector_type(4)));
template <class Epi, class Sched, bool ALIGN_EPI = false, bool SP2 = false, int QMODE = 0>
__device__ __forceinline__ void gemm_phase(PG8_LAS unsigned char* lds, const Gemm g, const Sched& S, const Epi& E) {
    const int tid = threadIdx.x, wid = __builtin_amdgcn_readfirstlane(tid >> 6), lane = tid & 63, wr = wid >> 2, wc = wid & 3, fr = lane & 15, fq = lane >> 4;
    const int K = g.K, nt = K / BK;
    constexpr bool FP8 = (QMODE == 1), I8 = (QMODE == 2);
    int f8sc = 0x7f7f7f7f; asm volatile("" : "+v"(f8sc)); (void)f8sc;
    unsigned voffA[2], voffB[2];
#pragma unroll
    for (int i = 0; i < 2; ++i) { int R, C; stage_rc(tid * 16 + i * 8192, R, C); const int Rb = Epi::PERM ? ((R & ~31) + perm32(R & 31)) : R;
        voffA[i] = (unsigned)(R * K + C) * 2u; voffB[i] = (unsigned)(Rb * K + C) * 2u; }
    const size_t kstep = (size_t)(BK * 2);
    const size_t hstep = (size_t)HALF * K * 2;
    const size_t tstep = 2 * hstep;
    const unsigned ldsw = (unsigned)wid * 1024u;
    const int aoff = lds_byte(wr * 64 + fr, fq * 8), boff = lds_byte(wc * 32 + fr, fq * 8);
#define PG8_SA(b, h) (((b) * 2 + (h)) * HTB)
#define PG8_SB(b, h) ((4 + (b) * 2 + (h)) * HTB)
#define PG8_STAGE(bufoff, gbase, voff) do { _Pragma("unroll") for (int _i = 0; _i < 2; ++_i) \
        __builtin_amdgcn_global_load_lds((const unsigned*)((const char*)(gbase) + (voff)[_i]), (PG8_LAS unsigned*)(lds + (bufoff) + ldsw + _i * 8192), 16, 0, 0); } while (0)
#define PG8_LDA(dst, b, h) do { _Pragma("unroll") for (int m = 0; m < 4; ++m) { dst[m].lo = *(const PG8_LAS i32x4*)(lds + PG8_SA(b, h) + aoff + m * 2048); dst[m].hi = *(const PG8_LAS i32x4*)(lds + PG8_SA(b, h) + aoff + m * 2048 + 1024); } } while (0)
#define PG8_LDB(dst, b, h) do { _Pragma("unroll") for (int n = 0; n < 2; ++n) { dst[n].lo = *(const PG8_LAS i32x4*)(lds + PG8_SB(b, h) + boff + n * 2048); dst[n].hi = *(const PG8_LAS i32x4*)(lds + PG8_SB(b, h) + boff + n * 2048 + 1024); } } while (0)
#define PG8_MMA(ai, bj, At, Bt) do { __builtin_amdgcn_s_setprio(1); _Pragma("unroll") for (int m = 0; m < 4; ++m) _Pragma("unroll") for (int n = 0; n < 2; ++n) { \
        if constexpr (FP8) asm volatile("v_mfma_scale_f32_16x16x128_f8f6f4 %0, %1, %2, %0, %3, %3 op_sel_hi:[0,0,0]" : "+v"(acc[ai][bj][m][n]) : "v"(Bt[n]), "v"(At[m]), "v"(f8sc));   \
        else if constexpr (I8) { const i32x4 bl_ = Bt[n].lo, bh_ = Bt[n].hi, al_ = At[m].lo, ah_ = At[m].hi; i32x4 c_ = __builtin_bit_cast(i32x4, acc[ai][bj][m][n]); \
               c_ = __builtin_amdgcn_mfma_i32_16x16x64_i8(bl_, al_, c_, 0, 0, 0); c_ = __builtin_amdgcn_mfma_i32_16x16x64_i8(bh_, ah_, c_, 0, 0, 0); acc[ai][bj][m][n] = __builtin_bit_cast(f32x4, c_); } \
        else { const i32x4 bl_ = Bt[n].lo, bh_ = Bt[n].hi, al_ = At[m].lo, ah_ = At[m].hi;        \
               acc[ai][bj][m][n] = __builtin_amdgcn_mfma_f32_16x16x32_bf16(__builtin_bit_cast(bf16x8, bl_), __builtin_bit_cast(bf16x8, al_), acc[ai][bj][m][n], 0, 0, 0); \
               acc[ai][bj][m][n] = __builtin_amdgcn_mfma_f32_16x16x32_bf16(__builtin_bit_cast(bf16x8, bh_), __builtin_bit_cast(bf16x8, ah_), acc[ai][bj][m][n], 0, 0, 0); } } \
        __builtin_amdgcn_s_setprio(0); } while (0)
#define PG8_WAIT_V(n) asm volatile("s_waitcnt vmcnt(" #n ")" ::: "memory")
#define PG8_WAIT_L(n) asm volatile("s_waitcnt lgkmcnt(" #n ")" ::: "memory")
#define PG8_BAR __builtin_amdgcn_s_barrier()
#define PG8_SCHED __builtin_amdgcn_sched_barrier(0)
    Unit cur, nxt; int ui = 0;
    if (!S.next(0, cur)) return;
    if constexpr (Epi::PREFETCH) E.prefetch(cur, 0, wid, lane);
    f32x4 acc[2][2][4][2];
#pragma unroll
    for (int a = 0; a < 2; ++a)
#pragma unroll
        for (int b = 0; b < 2; ++b)
#pragma unroll
            for (int m = 0; m < 4; ++m)
#pragma unroll
                for (int n = 0; n < 2; ++n) acc[a][b][m][n] = (f32x4){0.f, 0.f, 0.f, 0.f};
    i32x8 At[4], B0[2], B1[2];
    const char* cA = (const char*)g.A + (size_t)cur.pm * tstep; const char* cB = (const char*)g.Bt + (size_t)cur.pn * tstep;
    S.a_ready(cur);
    if constexpr (SP2) {
        PG8_STAGE(PG8_SB(0, 0), cB, voffB); PG8_STAGE(PG8_SB(0, 1), cB + hstep, voffB); PG8_STAGE(PG8_SA(0, 0), cA, voffA); PG8_STAGE(PG8_SA(0, 1), cA + hstep, voffA);
        if (wr == 1) PG8_BAR;
        PG8_WAIT_V(2); PG8_BAR;
        PG8_STAGE(PG8_SB(1, 0), cB + kstep, voffB); PG8_STAGE(PG8_SA(1, 0), cA + kstep, voffA); PG8_STAGE(PG8_SB(1, 1), cB + hstep + kstep, voffB);
        PG8_WAIT_V(6); PG8_BAR;
    } else {
        PG8_STAGE(PG8_SB(0, 0), cB, voffB); PG8_STAGE(PG8_SA(0, 0), cA, voffA); PG8_STAGE(PG8_SB(0, 1), cB + hstep, voffB); PG8_STAGE(PG8_SA(0, 1), cA + hstep, voffA);
        if (wr == 1) PG8_BAR;
        PG8_WAIT_V(4); PG8_BAR;
        PG8_STAGE(PG8_SB(1, 0), cB + kstep, voffB); PG8_STAGE(PG8_SA(1, 0), cA + kstep, voffA); PG8_STAGE(PG8_SB(1, 1), cB + hstep + kstep, voffB);
        PG8_WAIT_V(6); PG8_BAR;
    }
    for (;;) {
        const bool has_next = S.next(ui + 1, nxt);
        const char* nA = has_next ? (const char*)g.A + (size_t)nxt.pm * tstep : cA; const char* nB = has_next ? (const char*)g.Bt + (size_t)nxt.pn * tstep : cB;
#pragma unroll 1
        for (int t = 0; t < nt; t += 2) {
            const bool last = (t == nt - 2);
            const char* a1 = cA + (size_t)(t + 1) * kstep;
            const char* a2 = last ? nA : cA + (size_t)(t + 2) * kstep; const char* b2 = last ? nB : cB + (size_t)(t + 2) * kstep;
            const char* a3 = a2 + kstep; const char* b3 = b2 + kstep;
            if (last && has_next) S.a_ready(nxt);
            if constexpr (SP2) {
            PG8_LDB(B0, 0, 0); PG8_LDB(B1, 0, 1); PG8_SCHED; PG8_LDA(At, 0, 0); PG8_STAGE(PG8_SA(1, 1), a1 + hstep, voffA);
            PG8_WAIT_V(8); PG8_WAIT_L(0); PG8_BAR; PG8_MMA(0, 0, At, B0); PG8_MMA(0, 1, At, B1); PG8_BAR; PG8_SCHED;
            PG8_LDA(At, 0, 1); PG8_STAGE(PG8_SB(0, 0), b2, voffB); PG8_STAGE(PG8_SB(0, 1), b2 + hstep, voffB); PG8_STAGE(PG8_SA(0, 0), a2, voffA);
            PG8_WAIT_V(8); PG8_WAIT_L(0); PG8_BAR; PG8_MMA(1, 0, At, B0); PG8_MMA(1, 1, At, B1); PG8_BAR; PG8_SCHED;
            PG8_LDB(B0, 1, 0); PG8_LDB(B1, 1, 1); PG8_SCHED; PG8_LDA(At, 1, 0); PG8_STAGE(PG8_SA(0, 1), a2 + hstep, voffA);
            PG8_WAIT_V(8); PG8_WAIT_L(0); PG8_BAR; PG8_MMA(0, 0, At, B0); PG8_MMA(0, 1, At, B1); PG8_BAR; PG8_SCHED;
            PG8_LDA(At, 1, 1); PG8_STAGE(PG8_SB(1, 0), b3, voffB); PG8_STAGE(PG8_SB(1, 1), b3 + hstep, voffB); PG8_STAGE(PG8_SA(1, 0), a3, voffA);
            PG8_WAIT_V(8); PG8_WAIT_L(0); PG8_BAR; PG8_MMA(1, 0, At, B0); PG8_MMA(1, 1, At, B1); PG8_BAR; PG8_SCHED;
            } else {
            PG8_LDB(B0, 0, 0); PG8_SCHED; PG8_LDA(At, 0, 0); PG8_STAGE(PG8_SA(1, 1), a1 + hstep, voffA);
            PG8_WAIT_L(8); PG8_BAR; PG8_WAIT_L(0); PG8_MMA(0, 0, At, B0); PG8_BAR; PG8_SCHED;
            PG8_LDB(B1, 0, 1); PG8_STAGE(PG8_SB(0, 0), b2, voffB);
            PG8_BAR; PG8_WAIT_L(0); PG8_MMA(0, 1, At, B1); PG8_BAR;
            PG8_LDA(At, 0, 1); PG8_STAGE(PG8_SA(0, 0), a2, voffA);
            PG8_BAR; PG8_WAIT_L(0); PG8_MMA(1, 0, At, B0); PG8_BAR; PG8_SCHED;
            PG8_STAGE(PG8_SB(0, 1), b2 + hstep, voffB);
            PG8_WAIT_V(6); PG8_BAR; PG8_MMA(1, 1, At, B1); PG8_BAR;
            PG8_LDB(B0, 1, 0); PG8_SCHED; PG8_LDA(At, 1, 0); PG8_STAGE(PG8_SA(0, 1), a2 + hstep, voffA);
            PG8_WAIT_L(8); PG8_BAR; PG8_WAIT_L(0); PG8_MMA(0, 0, At, B0); PG8_BAR; PG8_SCHED;
            PG8_LDB(B1, 1, 1); PG8_STAGE(PG8_SB(1, 0), b3, voffB);
            PG8_BAR; PG8_WAIT_L(0); PG8_MMA(0, 1, At, B1); PG8_BAR;
            PG8_LDA(At, 1, 1); PG8_STAGE(PG8_SA(1, 0), a3, voffA);
            PG8_BAR; PG8_WAIT_L(0); PG8_MMA(1, 0, At, B0); PG8_BAR; PG8_SCHED;
            PG8_STAGE(PG8_SB(1, 1), b3 + hstep, voffB);
            PG8_WAIT_V(6); PG8_BAR; PG8_MMA(1, 1, At, B1); PG8_BAR;
            }
        }
        if constexpr (ALIGN_EPI) { if (wr == 0) PG8_BAR; }
        if constexpr (I8) {
_Pragma("unroll") for (int a_ = 0; a_ < 2; ++a_) _Pragma("unroll") for (int b_ = 0; b_ < 2; ++b_) _Pragma("unroll") for (int m_ = 0; m_ < 4; ++m_) _Pragma("unroll") for (int n_ = 0; n_ < 2; ++n_)
                acc[a_][b_][m_][n_] = __builtin_convertvector(__builtin_bit_cast(i32x4, acc[a_][b_][m_][n_]), f32x4); }
        if constexpr (FP8) asm volatile("s_nop 15\n\ts_nop 15" ::: "memory");
        if constexpr (Epi::PREFETCH) { int le = (int)threadIdx.x; asm volatile("" : "+v"(le)); le &= 63;
            E.run(acc, cur, ui & 1, wr, wc, le & 15, le >> 4); S.done(cur); }
        else if constexpr (!Epi::AFTER_DRAIN) { E(acc, cur, wr, wc, fr, fq); S.done(cur); }
        if (!has_next) break;
#pragma unroll
        for (int a = 0; a < 2; ++a)
#pragma unroll
            for (int b = 0; b < 2; ++b)
#pragma unroll
                for (int m = 0; m < 4; ++m)
#pragma unroll
                    for (int n = 0; n < 2; ++n) acc[a][b][m][n] = (f32x4){0.f, 0.f, 0.f, 0.f};
        cur = nxt; cA = nA; cB = nB; ++ui;
        if constexpr (Epi::PREFETCH) { int lp = (int)threadIdx.x; asm volatile("" : "+v"(lp)); E.prefetch(cur, ui & 1, wid, lp & 63); }
        if constexpr (ALIGN_EPI) { if (wr == 1) PG8_BAR; }
    }
    PG8_WAIT_V(0);
    if constexpr (!ALIGN_EPI) { if (wr == 0) PG8_BAR; }
    PG8_BAR;
    if constexpr (Epi::AFTER_DRAIN) { E.fused(acc, cur, wr, wc, fr, fq, lds, wid, lane); S.done(cur); }
#undef PG8_SA
#undef PG8_SB
#undef PG8_STAGE
#undef PG8_LDA
#undef PG8_LDB
#undef PG8_MMA
#undef PG8_WAIT_V
#undef PG8_WAIT_L
#undef PG8_BAR
#undef PG8_SCHED
}
}
#define PG8_SP2 true
#define PG8_ALIGN true
#define GAS __attribute__((address_space(1)))
#define LAS __attribute__((address_space(3)))
typedef unsigned short bf16;
typedef unsigned v4u __attribute__((ext_vector_type(4)));
typedef float f32x4 __attribute__((ext_vector_type(4)));
typedef short bf16x8 __attribute__((ext_vector_type(8)));
typedef GAS unsigned gu32;
typedef GAS unsigned long long gu64;
#define RLX_AGENT __ATOMIC_RELAXED, __HIP_MEMORY_SCOPE_AGENT
#define LDS_WAIT() asm volatile("s_waitcnt lgkmcnt(0)" ::: "memory")
#define VM_WAIT() asm volatile("s_waitcnt vmcnt(0)" ::: "memory")
__device__ __forceinline__ unsigned long long rt() { return __builtin_amdgcn_s_memrealtime(); }
__device__ __forceinline__ unsigned pk2(float lo, float hi) { typedef float f32x2_ __attribute__((ext_vector_type(2))); typedef __bf16 bf16x2_ __attribute__((ext_vector_type(2)));
    const f32x2_ v = {lo, hi}; return __builtin_bit_cast(unsigned, __builtin_convertvector(v, bf16x2_)); }
__device__ __forceinline__ unsigned f2bf(float f) { return pk2(f, 0.f) & 0xffffu; }
#define XB_TMO      128
#define XB_XCNT(j)  (256  + 64 * (j))
#define XB_XSUB(j)  (1280 + 64 * (j))
#define XB_XGEN(j)  (2304 + 64 * (j))
#define XB_TOP      3328
#define XB_TOPGEN   3392
#define XCD_BAR_WORDS 3456
#define XB_SPIN_CAP (1u << 18)

__device__ __forceinline__ unsigned xb_ld(unsigned* p)              { return __hip_atomic_load(p, __ATOMIC_RELAXED, __HIP_MEMORY_SCOPE_AGENT); }
__device__ __forceinline__ unsigned xb_add(unsigned* p, unsigned v) { return __hip_atomic_fetch_add(p, v, __ATOMIC_RELAXED, __HIP_MEMORY_SCOPE_AGENT); }
__device__ __forceinline__ unsigned xb_xcc_id() { return (unsigned)__builtin_amdgcn_s_getreg((3 << 11) | 20) & 0xFu; }
#define XB_SPIN(cond, bar) do { unsigned _sp = 0; while (cond) { __builtin_amdgcn_s_sleep(1); \
    if ((++_sp & 255u) == 0u) { if (xb_ld(&(bar)[XB_TMO])) break; if (_sp > XB_SPIN_CAP) { atomicAdd(&(bar)[XB_TMO], 1u); break; } } } } while (0)

struct XcdBarrier {
    unsigned* bar; unsigned x;
    volatile LAS unsigned* st;
};

__device__ __forceinline__ XcdBarrier xcd_barrier_post(unsigned* bar, volatile LAS unsigned* st) {
    XcdBarrier b; b.bar = bar; b.x = xb_xcc_id(); b.st = st;
    if (threadIdx.x == 0) (void)xb_add(&bar[XB_XCNT(b.x)], 1u);
    return b;
}
__device__ __forceinline__ void xcd_barrier_complete(unsigned* bar, unsigned x, unsigned& nloc, unsigned& nx) {
    const unsigned G = gridDim.x * gridDim.y * gridDim.z;
    unsigned sum, cnt, mine, sp = 0u;
    for (;;) {
        sum = 0u; cnt = 0u; mine = 0u;
#pragma unroll
        for (unsigned j = 0; j < 16; ++j) { const unsigned c = xb_ld(&bar[XB_XCNT(j)]); sum += c; cnt += (c > 0u) ? 1u : 0u; mine = (j == x) ? c : mine; }
        if (sum == G) break;
        __builtin_amdgcn_s_sleep(1);
        if ((++sp & 255u) == 0u) { if (xb_ld(&bar[XB_TMO])) break; if (sp > XB_SPIN_CAP) { atomicAdd(&bar[XB_TMO], 1u); break; } }
    }
    nloc = mine > 0u ? mine : 1u; nx = cnt > 0u ? cnt : 1u;
}

__device__ __forceinline__ void xcd_barrier(const XcdBarrier& b) {
    asm volatile("s_waitcnt vmcnt(0)" ::: "memory");
    __syncthreads();
    if (threadIdx.x == 0) {
        unsigned* bar = b.bar;
        __builtin_amdgcn_s_waitcnt(0);
        unsigned nloc = b.st[0], nx = b.st[1];
        if (nloc == 0u) { xcd_barrier_complete(bar, b.x, nloc, nx); b.st[0] = nloc; b.st[1] = nx; }
        const unsigned old = xb_add(&bar[XB_XSUB(b.x)], 1u);
        const unsigned gen = old / nloc;
        if (old + 1u == (gen + 1u) * nloc) {
            __builtin_amdgcn_fence(__ATOMIC_RELEASE, "agent");
            asm volatile("s_waitcnt vmcnt(0)" ::: "memory");
            const unsigned og = xb_add(&bar[XB_TOP], 1u);
            const unsigned tg = og / nx;
            if (og + 1u == (tg + 1u) * nx) xb_add(&bar[XB_TOPGEN], 1u);
            else XB_SPIN(xb_ld(&bar[XB_TOPGEN]) == tg, bar);
            __builtin_amdgcn_fence(__ATOMIC_ACQUIRE, "agent");
            xb_add(&bar[XB_XGEN(b.x)], 1u);
            asm volatile("s_waitcnt vmcnt(0)" ::: "memory");
        } else {
            XB_SPIN(xb_ld(&bar[XB_XGEN(b.x)]) == gen, bar);
            __builtin_amdgcn_fence(__ATOMIC_ACQUIRE, "agent");
            asm volatile("s_waitcnt vmcnt(0)" ::: "memory");
        }
    }
    __syncthreads();
}

constexpr int NWAVES = 8;
constexpr int BATCH = 4, SEQ = 8192, D = 1024, M = BATCH * SEQ, FF = 2816, NH = 8, DK = 128, DV = 128;
constexpr int IN_COLS = 7712, NMOD = 9;
constexpr int N_IN1 = 18 * 256, N_IN2 = 12 * 256;
constexpr float EPS = 1e-6f;
#ifndef MK_SPLIT
#define MK_SPLIT 0
#endif
constexpr int NPHASE = 19;

constexpr size_t MiB = 1u << 20;
constexpr size_t WS_CTL = 0, CTL_ZERO_BYTES = 64 * 1024;
constexpr size_t WS_MOD = 256 * 1024;
constexpr size_t WS_WUP1 = 1 * MiB, WS_WDN1 = 12 * MiB, WS_WUP2 = 18 * MiB, WS_WDN2 = 29 * MiB, WS_WIN1 = 35 * MiB, WS_WIN2 = 45 * MiB, WS_WA = 51 * MiB, WS_WB = 52 * MiB, WS_WO = 54 * MiB;
constexpr size_t WS_XN = 64 * MiB;
constexpr size_t WS_HID = 128 * MiB;
constexpr size_t WS_QRAW = 128 * MiB, WS_KRAW = 192 * MiB, WS_VRAW = 256 * MiB;
constexpr size_t WS_CAB = 320 * MiB, WS_CV = 352 * MiB;
constexpr size_t WS_QF = 384 * MiB;
constexpr size_t WS_YA = 448 * MiB;
constexpr size_t WS_BA = 480 * MiB;
constexpr size_t WS_GB = 484 * MiB;
constexpr size_t WS_SSQ = 56 * MiB;
constexpr size_t WS_BW = 17 * MiB + 512 * 1024;
constexpr size_t BW_UP1 = 0, BW_IN1 = 96 * 1024, BW_IN2 = 176 * 1024, BW_UP2 = 224 * 1024;
constexpr size_t WS_CW = 34 * MiB + 512 * 1024;
constexpr size_t WS_HB2 = 304 * MiB, WS_HB3 = 384 * MiB;
constexpr size_t WS_WDN1F8 = 488 * MiB;
constexpr size_t WS_WUP1I8 = 491 * MiB, WS_WUP2I8 = 497 * MiB;
constexpr size_t WS_CF = 503 * MiB;
constexpr size_t WS_WIN2I8 = 504 * MiB;
constexpr size_t WS_CF3 = 507 * MiB, WS_RSX = 507 * MiB + 512 * 1024;
constexpr size_t WS_END = 508 * MiB;
constexpr size_t WS_KF = WS_QRAW, WS_VF = WS_KRAW;
constexpr size_t WS_OF = WS_VRAW, WS_OB = WS_CAB;
constexpr size_t WS_SGA = WS_QF, WS_SGB = WS_QRAW;
static_assert(WS_WUP1 + (size_t)2 * FF * D * 2 <= WS_WDN1 && WS_WDN1 + (size_t)D * FF * 2 <= WS_WUP2 && WS_WIN1 + (size_t)N_IN1 * D * 2 <= WS_WIN2 && WS_WIN2 + (size_t)N_IN2 * D * 2 <= WS_WA && WS_WO + 2 * MiB <= WS_XN, "weights map");
static_assert(WS_HID + (size_t)M * FF * 2 <= WS_CAB + 64 * MiB && WS_GB + (size_t)4 * M * 8 * 4 <= WS_END, "activation map");

constexpr int RING_OFF = 0, RING_BYTES = 131072;
constexpr int LDS_BYTES = 163840;
constexpr int LDSCTL_OFF = LDS_BYTES - 512, MISC_OFF = LDSCTL_OFF + 320;

struct Args { const float* in[23]; float* out; unsigned char* ws; int ph_lo, ph_hi; };
enum { I_X = 0, I_C, I_WADA, I_BADA, I_NF1, I_WUP1, I_WDN1, I_NMIX, I_WIN, I_CONVA, I_CONVDN, I_ALF, I_DTF, I_ALB, I_DTB, I_DNNORM, I_WAO, I_WBO, I_WOUT, I_NF2, I_WUP2, I_WDN2, I_NFIN };

template <int CTRL, int ROW_MASK = 0xf> __device__ __forceinline__ float dpp_add(float v) {
    return v + __builtin_bit_cast(float, __builtin_amdgcn_update_dpp(0, __builtin_bit_cast(int, v), CTRL, ROW_MASK, 0xf, false)); }
__device__ __forceinline__ float sum16(float v) {
    v = dpp_add<0x128>(v); v = dpp_add<0x124>(v); v = dpp_add<0x122>(v); v = dpp_add<0x121>(v);
    return v;
}
__device__ __forceinline__ float wave_sum(float v) {
    v = sum16(v);
    return (__builtin_bit_cast(float, __builtin_amdgcn_readlane(__builtin_bit_cast(int, v), 0)) + __builtin_bit_cast(float, __builtin_amdgcn_readlane(__builtin_bit_cast(int, v), 16)))
      + (__builtin_bit_cast(float, __builtin_amdgcn_readlane(__builtin_bit_cast(int, v), 32)) + __builtin_bit_cast(float, __builtin_amdgcn_readlane(__builtin_bit_cast(int, v), 48)));
}
template <int CTRL> __device__ __forceinline__ float dpp_max(float v) { return __builtin_fmaxf(v, __builtin_bit_cast(float, __builtin_amdgcn_update_dpp(__builtin_bit_cast(int, v), __builtin_bit_cast(int, v), CTRL, 0xf, 0xf, false))); }
__device__ __forceinline__ float wave_max(float v) {
    v = dpp_max<0x128>(v); v = dpp_max<0x124>(v); v = dpp_max<0x122>(v); v = dpp_max<0x121>(v);
    return __builtin_fmaxf(__builtin_fmaxf(__builtin_bit_cast(float, __builtin_amdgcn_readlane(__builtin_bit_cast(int, v), 0)), __builtin_bit_cast(float, __builtin_amdgcn_readlane(__builtin_bit_cast(int, v), 16))),
                           __builtin_fmaxf(__builtin_bit_cast(float, __builtin_amdgcn_readlane(__builtin_bit_cast(int, v), 32)), __builtin_bit_cast(float, __builtin_amdgcn_readlane(__builtin_bit_cast(int, v), 48))));
}
__device__ __forceinline__ unsigned i8x4(float a, float b, float c, float d) {
    const int qa = (int)__builtin_rintf(a), qb = (int)__builtin_rintf(b), qc = (int)__builtin_rintf(c), qd = (int)__builtin_rintf(d);
    return ((unsigned)qa & 0xffu) | (((unsigned)qb & 0xffu) << 8) | (((unsigned)qc & 0xffu) << 16) | ((unsigned)qd << 24); }
__device__ __forceinline__ float bf2f(unsigned short b) { return __uint_as_float((unsigned)b << 16); }
__device__ __forceinline__ void unpack8f(v4u w, float* f) {
    f[0] = __uint_as_float(w.x << 16); f[1] = __uint_as_float(w.x & 0xffff0000u); f[2] = __uint_as_float(w.y << 16); f[3] = __uint_as_float(w.y & 0xffff0000u);
    f[4] = __uint_as_float(w.z << 16); f[5] = __uint_as_float(w.z & 0xffff0000u); f[6] = __uint_as_float(w.w << 16); f[7] = __uint_as_float(w.w & 0xffff0000u); }
__device__ __forceinline__ v4u pack8f(const float* f) { v4u w; w.x = pk2(f[0], f[1]); w.y = pk2(f[2], f[3]); w.z = pk2(f[4], f[5]); w.w = pk2(f[6], f[7]); return w; }
__device__ __forceinline__ float sigmoidf_(float x) { return __builtin_amdgcn_rcpf(1.0f + __expf(-x)); }
__device__ __forceinline__ float siluf_(float x) { return x * __builtin_amdgcn_rcpf(1.0f + __expf(-x)); }

using pg8::f8x4; using pg8::W8_SCALE; using pg8::H8_SCALE;
__device__ __forceinline__ void transpose_item(const float* W, int N, int K, bf16* dst0  , int k0, int n0, LAS float* scr, int lane, unsigned char* dst8 = nullptr  ) {
#pragma unroll 8
    for (int i = 0; i < 32; ++i) { const int kk = 2 * i + (lane >> 5); scr[kk * 33 + (lane & 31)] = W[(size_t)(k0 + kk) * N + n0 + (lane & 31)]; }
    LDS_WAIT(); asm volatile("" ::: "memory");
    const int c = lane & 7;
#pragma unroll
    for (int j = 0; j < 4; ++j) { const int n = (lane >> 3) + 8 * j; const LAS float* s = scr + (8 * c) * 33 + n;
        v4u o; o.x = pk2(s[0 * 33], s[1 * 33]); o.y = pk2(s[2 * 33], s[3 * 33]); o.z = pk2(s[4 * 33], s[5 * 33]); o.w = pk2(s[6 * 33], s[7 * 33]);
        *(GAS v4u*)(dst0 + (size_t)n * K + k0 + 8 * c) = o;
        if (dst8) { typedef unsigned u32x2_ __attribute__((ext_vector_type(2)));
            *(GAS u32x2_*)(dst8 + (size_t)n * K + k0 + 8 * c) = (u32x2_){f8x4(W8_SCALE * s[0 * 33], W8_SCALE * s[1 * 33], W8_SCALE * s[2 * 33], W8_SCALE * s[3 * 33]), f8x4(W8_SCALE * s[4 * 33], W8_SCALE * s[5 * 33], W8_SCALE * s[6 * 33], W8_SCALE * s[7 * 33])}; } }
    LDS_WAIT(); asm volatile("" ::: "memory");
}
__device__ __forceinline__ int up_row(int n0) { const int part = n0 / FF, j = n0 % FF; return 256 * (j / 128) + 128 * part + (j % 128); }

__device__ __forceinline__ void phase_prologue(const Args& a, LAS unsigned char* lds, int tid, int lane, int wave) {
    unsigned char* ws = a.ws;
    LAS float* cact = (LAS float*)lds;
    LAS float* red = (LAS float*)(lds + 16384);
    for (int i = tid; i < 4096; i += 512) cact[i] = siluf_(a.in[I_C][i]);
    __syncthreads();
    float* mod = (float*)(ws + WS_MOD);
    for (int it = blockIdx.x; it < (NMOD * D) / 32; it += gridDim.x) {
        const int n0 = it * 32, col = tid & 31, kg = tid >> 5;
        float a0 = 0.f, a1 = 0.f, a2 = 0.f, a3 = 0.f;
        const float* wp = a.in[I_WADA] + (size_t)(kg * 64) * (NMOD * D) + n0 + col;
#pragma unroll 8
        for (int kk = 0; kk < 64; ++kk) { const float w = wp[(size_t)kk * (NMOD * D)]; const int k = kg * 64 + kk;
            a0 += cact[k] * w; a1 += cact[1024 + k] * w; a2 += cact[2048 + k] * w; a3 += cact[3072 + k] * w; }
        red[(kg * 4 + 0) * 32 + col] = a0; red[(kg * 4 + 1) * 32 + col] = a1; red[(kg * 4 + 2) * 32 + col] = a2; red[(kg * 4 + 3) * 32 + col] = a3;
        __syncthreads();
        if (tid < 128) { const int b = tid >> 5, c2 = tid & 31; float s = 0.f;
#pragma unroll
            for (int g = 0; g < 16; ++g) s += red[(g * 4 + b) * 32 + c2];
            mod[b * (NMOD * D) + n0 + c2] = s + a.in[I_BADA][n0 + c2]; }
        __syncthreads();
    }
    __syncthreads();
    LAS float* scr = (LAS float*)(lds + wave * 16384);
    const int gw = blockIdx.x * NWAVES + wave, NGW = gridDim.x * NWAVES;
    constexpr int I_UP = (D / 64) * (2 * FF / 32), I_DN = (FF / 64) * (D / 32), I_IN = (D / 64) * (IN_COLS / 32), I_A = (512 / 64) * (D / 32), I_B = (D / 64) * (D / 32);
    constexpr int NITEMS = 2 * I_UP + 2 * I_DN + I_IN + I_A + 2 * I_B;
    for (int it = gw; it < NITEMS; it += NGW) {
        int r = it;
        if (r < 2 * I_UP) { const int wsel = r / I_UP; r %= I_UP; const int nblk = 2 * FF / 32, kb = r / nblk, nb = r % nblk;
            const float* W = a.in[wsel ? I_WUP2 : I_WUP1]; bf16* dst = (bf16*)(ws + (wsel ? WS_WUP2 : WS_WUP1));
            transpose_item(W, 2 * FF, D, dst + (size_t)up_row(32 * nb) * D, 64 * kb, 32 * nb, scr, lane); continue; }
        r -= 2 * I_UP;
        if (r < 2 * I_DN) { const int wsel = r / I_DN; r %= I_DN; const int nblk = D / 32, kb = r / nblk, nb = r % nblk;
            const float* W = a.in[wsel ? I_WDN2 : I_WDN1]; bf16* dst = (bf16*)(ws + (wsel ? WS_WDN2 : WS_WDN1));
            transpose_item(W, D, FF, dst + (size_t)(32 * nb) * FF, 64 * kb, 32 * nb, scr, lane); continue; }
        r -= 2 * I_DN;
        if (r < I_IN) { const int nblk = IN_COLS / 32, kb = r / nblk, nb = r % nblk, n0 = 32 * nb;
            bf16* dst;
            if (n0 < 512) dst = (bf16*)(ws + WS_WIN1) + (size_t)(1024 + n0) * D;
            else if (n0 < 1024) { const int j = n0 - 512; dst = (bf16*)(ws + WS_WIN1) + (size_t)(256 * (j / 128) + (j % 128)) * D; }
            else if (n0 < 1536) { const int j = n0 - 1024; dst = (bf16*)(ws + WS_WIN1) + (size_t)(256 * (j / 128) + 128 + (j % 128)) * D; }
            else if (n0 < 4608) dst = (bf16*)(ws + WS_WIN1) + (size_t)n0 * D;
            else if (n0 < 5632) dst = (bf16*)(ws + WS_WIN2) + (size_t)(n0 - 4608) * D;
            else if (n0 < 5664) dst = (bf16*)(ws + WS_WIN1) + (size_t)(4608 + n0 - 5632) * D;
            else dst = (bf16*)(ws + WS_WIN2) + (size_t)(1024 + n0 - 5664) * D;
            transpose_item(a.in[I_WIN], IN_COLS, D, dst, 64 * kb, n0, scr, lane); continue; }
        r -= I_IN;
        if (r < I_A) { const int nblk = D / 32, kb = r / nblk, nb = r % nblk; transpose_item(a.in[I_WAO], D, 512, (bf16*)(ws + WS_WA) + (size_t)(32 * nb) * 512, 64 * kb, 32 * nb, scr, lane); continue; }
        r -= I_A;
        { const int wsel = r / I_B; r %= I_B; const int nblk = D / 32, kb = r / nblk, nb = r % nblk;
          transpose_item(a.in[wsel ? I_WOUT : I_WBO], D, D, (bf16*)(ws + (wsel ? WS_WO : WS_WB)) + (size_t)(32 * nb) * D, 64 * kb, 32 * nb, scr, lane); }
    }
}

__device__ __forceinline__ void phase_first(const Args& a, const float* mod, bf16* dst, int tid, int lane, int wave) {
    unsigned char* ws = a.ws;
    const int gw = blockIdx.x * NWAVES + wave, NGW = gridDim.x * NWAVES;
    float* ssq0 = (float*)(ws + WS_SSQ);
    const float* nw = a.in[I_NF1];
    for (int m0 = gw; m0 < M; m0 += 4 * NGW) {
        f32x4 v[4][4];
#pragma unroll
        for (int q = 0; q < 4; ++q) { const int mq = (m0 + q * NGW < M) ? m0 + q * NGW : m0; const GAS f32x4* xr = (const GAS f32x4*)(a.in[I_X] + (size_t)mq * D) + lane;
#pragma unroll
            for (int j = 0; j < 4; ++j) v[q][j] = xr[64 * j]; }
#pragma unroll
        for (int q = 0; q < 4; ++q) { const int m = m0 + q * NGW; if (m >= M) break; const int b = m / SEQ; const float* sc = mod + b * (NMOD * D) + 1 * D; float s = 0.f;
#pragma unroll
            for (int j = 0; j < 4; ++j) s += (v[q][j].x * v[q][j].x + v[q][j].y * v[q][j].y) + (v[q][j].z * v[q][j].z + v[q][j].w * v[q][j].w);
            s = wave_sum(s);
            f32x4 y[4]; float amax = 1e-30f;
#pragma unroll
            for (int j = 0; j < 4; ++j) { const int c = 4 * lane + 256 * j; const f32x4 w = *(const f32x4*)(nw + c), s1 = *(const f32x4*)(sc + c);
                y[j] = v[q][j] * w * (s1 + 1.0f);
                amax = __builtin_fmaxf(__builtin_fmaxf(amax, __builtin_fmaxf(__builtin_fabsf(y[j].x), __builtin_fabsf(y[j].y))), __builtin_fmaxf(__builtin_fabsf(y[j].z), __builtin_fabsf(y[j].w))); }
            amax = wave_max(amax);
            const float qs = 127.f * __builtin_amdgcn_rcpf(amax);
            if (lane == 0) ssq0[m] = __builtin_amdgcn_rsqf(s * (1.f / D) + EPS) * amax * (1.f / 127.f);
            GAS unsigned* o4 = (GAS unsigned*)((unsigned char*)dst + (size_t)m * D) + lane;
#pragma unroll
            for (int j = 0; j < 4; ++j) o4[64 * j] = i8x4(y[j].x * qs, y[j].y * qs, y[j].z * qs, y[j].w * qs); }
    }
    for (int it = gw; it < 2 * (2 * FF / 4); it += NGW) {
        const int sel = it >= 2 * FF / 4, r0 = 4 * (sel ? it - 2 * FF / 4 : it);
        const bf16* W = (const bf16*)(ws + (sel ? WS_WUP2 : WS_WUP1)); float* out = (float*)(ws + WS_BW + (sel ? BW_UP2 : BW_UP1)); const int shi = sel ? 6 : 0;
        v4u wr_[4][2];
#pragma unroll
        for (int q = 0; q < 4; ++q) { wr_[q][0] = *(const GAS v4u*)(W + (size_t)(r0 + q) * D + 16 * lane); wr_[q][1] = *(const GAS v4u*)(W + (size_t)(r0 + q) * D + 16 * lane + 8); }
        f32x4 shv[4][4];
#pragma unroll
        for (int b = 0; b < 4; ++b)
#pragma unroll
            for (int e = 0; e < 4; ++e) shv[b][e] = *(const f32x4*)(mod + b * (NMOD * D) + shi * D + 16 * lane + 4 * e);
#pragma unroll
        for (int q = 0; q < 4; ++q) { float wv[16]; unpack8f(wr_[q][0], wv); unpack8f(wr_[q][1], wv + 8); float acc[4];
#pragma unroll
            for (int b = 0; b < 4; ++b) { float s = 0.f;
#pragma unroll
                for (int e = 0; e < 4; ++e) s += (wv[4 * e] * shv[b][e].x + wv[4 * e + 1] * shv[b][e].y) + (wv[4 * e + 2] * shv[b][e].z + wv[4 * e + 3] * shv[b][e].w);
                acc[b] = wave_sum(s); }
            if (lane < 4) out[(size_t)lane * (2 * FF) + r0 + q] = (lane == 0) ? acc[0] : (lane == 1) ? acc[1] : (lane == 2) ? acc[2] : acc[3];
            float amax = 1e-30f;
#pragma unroll
            for (int e = 0; e < 16; ++e) amax = __builtin_fmaxf(amax, __builtin_fabsf(wv[e]));
            amax = wave_max(amax);
            const float qs = 127.f * __builtin_amdgcn_rcpf(amax);
            v4u o; o.x = i8x4(wv[0] * qs, wv[1] * qs, wv[2] * qs, wv[3] * qs); o.y = i8x4(wv[4] * qs, wv[5] * qs, wv[6] * qs, wv[7] * qs);
            o.z = i8x4(wv[8] * qs, wv[9] * qs, wv[10] * qs, wv[11] * qs); o.w = i8x4(wv[12] * qs, wv[13] * qs, wv[14] * qs, wv[15] * qs);
            *(GAS v4u*)(ws + (sel ? WS_WUP2I8 : WS_WUP1I8) + (size_t)(r0 + q) * D + 16 * lane) = o;
            if (lane == 0) ((float*)(ws + WS_CF))[sel * (2 * FF) + r0 + q] = amax * (1.f / 127.f); }
    }
    for (int r = gw; r < N_IN2; r += NGW) {
        const bf16* W = (const bf16*)(ws + WS_WIN2) + (size_t)r * D + 16 * lane;
        const v4u w0 = *(const GAS v4u*)W, w1 = *(const GAS v4u*)(W + 8);
        float wv[16]; unpack8f(w0, wv); unpack8f(w1, wv + 8);
        float amax = 1e-30f;
#pragma unroll
        for (int e = 0; e < 16; ++e) amax = __builtin_fmaxf(amax, __builtin_fabsf(wv[e]));
        amax = wave_max(amax);
        const float qs = 127.f * __builtin_amdgcn_rcpf(amax);
        v4u o; o.x = i8x4(wv[0] * qs, wv[1] * qs, wv[2] * qs, wv[3] * qs); o.y = i8x4(wv[4] * qs, wv[5] * qs, wv[6] * qs, wv[7] * qs);
        o.z = i8x4(wv[8] * qs, wv[9] * qs, wv[10] * qs, wv[11] * qs); o.w = i8x4(wv[12] * qs, wv[13] * qs, wv[14] * qs, wv[15] * qs);
        *(GAS v4u*)(ws + WS_WIN2I8 + (size_t)r * D + 16 * lane) = o;
        if (lane == 0) ((float*)(ws + WS_CF3))[r] = amax * (1.f / 127.f);
    }
    float* cwp = (float*)(ws + WS_CW);
    for (int i = blockIdx.x * 512 + tid; i < 2 * 4 * D; i += gridDim.x * 512) { const int k = i >> 12, b = (i >> 10) & 3, c = i & 1023;
        cwp[i] = a.in[k ? I_NF2 : I_NMIX][c] * (1.0f + mod[b * (NMOD * D) + (k ? 7 : 4) * D + c]); }
}
__device__ __forceinline__ void phase_mix_norm(const bf16* h, const float* ssq, const float* cw, const float* sh, bf16* dst, unsigned char* dst8, float* rsx, int lane, int wave) {
    const int gw = blockIdx.x * NWAVES + wave, NGW = gridDim.x * NWAVES;
    for (int m0 = gw; m0 < M; m0 += 4 * NGW) {
        v4u hv[4][2];
#pragma unroll
        for (int q = 0; q < 4; ++q) { const int mq = (m0 + q * NGW < M) ? m0 + q * NGW : m0; const GAS v4u* hr = (const GAS v4u*)(h + (size_t)mq * D) + lane; hv[q][0] = hr[0]; hv[q][1] = hr[64]; }
#pragma unroll
        for (int q = 0; q < 4; ++q) { const int m = m0 + q * NGW; if (m >= M) break; const int b = m / SEQ; const float rstd = pg8::row_rstd(ssq, m); GAS v4u* orow = (GAS v4u*)(dst + (size_t)m * D) + lane;
            float yy[2][8]; float amax = 1e-30f;
#pragma unroll
            for (int j = 0; j < 2; ++j) { float x[8]; unpack8f(hv[q][j], x); const int c = 8 * lane + 512 * j;
                const f32x4 w0 = *(const f32x4*)(cw + b * 1024 + c), w1 = *(const f32x4*)(cw + b * 1024 + c + 4), s0 = *(const f32x4*)(sh + (size_t)b * (NMOD * D) + c), s1 = *(const f32x4*)(sh + (size_t)b * (NMOD * D) + c + 4);
                float y[8] = {x[0] * rstd * w0.x + s0.x, x[1] * rstd * w0.y + s0.y, x[2] * rstd * w0.z + s0.z, x[3] * rstd * w0.w + s0.w, x[4] * rstd * w1.x + s1.x, x[5] * rstd * w1.y + s1.y, x[6] * rstd * w1.z + s1.z, x[7] * rstd * w1.w + s1.w};
                orow[64 * j] = pack8f(y);
#pragma unroll
                for (int e = 0; e < 8; ++e) { yy[j][e] = y[e]; amax = __builtin_fmaxf(amax, __builtin_fabsf(y[e])); } }
            amax = wave_max(amax);
            const float qs = 127.f * __builtin_amdgcn_rcpf(amax);
            typedef unsigned u32x2_ __attribute__((ext_vector_type(2)));
#pragma unroll
            for (int j = 0; j < 2; ++j) *(GAS u32x2_*)(dst8 + (size_t)m * D + 8 * lane + 512 * j) = (u32x2_){i8x4(yy[j][0] * qs, yy[j][1] * qs, yy[j][2] * qs, yy[j][3] * qs), i8x4(yy[j][4] * qs, yy[j][5] * qs, yy[j][6] * qs, yy[j][7] * qs)};
            if (lane == 0) rsx[m] = amax * (1.f / 127.f); }
    }
}
__device__ __forceinline__ void phase_final_norm(const bf16* h3, const float* ssq, float* out, const float* nw, int lane, int wave) {
    const int gw = blockIdx.x * NWAVES + wave, NGW = gridDim.x * NWAVES;
    for (int m0 = gw; m0 < M; m0 += 4 * NGW) {
        v4u hv[4][2];
#pragma unroll
        for (int q = 0; q < 4; ++q) { const int mq = (m0 + q * NGW < M) ? m0 + q * NGW : m0; const GAS v4u* hr = (const GAS v4u*)(h3 + (size_t)mq * D) + lane; hv[q][0] = hr[0]; hv[q][1] = hr[64]; }
#pragma unroll
        for (int q = 0; q < 4; ++q) { const int m = m0 + q * NGW; if (m >= M) break; const float rstd = pg8::row_rstd(ssq, m); GAS f32x4* orow = (GAS f32x4*)(out + (size_t)m * D);
#pragma unroll
            for (int j = 0; j < 2; ++j) { float x[8]; unpack8f(hv[q][j], x); const int c = 8 * lane + 512 * j;
                const f32x4 w0 = *(const f32x4*)(nw + c), w1 = *(const f32x4*)(nw + c + 4);
                orow[(c >> 2)] = (f32x4){x[0] * rstd * w0.x, x[1] * rstd * w0.y, x[2] * rstd * w0.z, x[3] * rstd * w0.w};
                orow[(c >> 2) + 1] = (f32x4){x[4] * rstd * w1.x, x[5] * rstd * w1.y, x[6] * rstd * w1.z, x[7] * rstd * w1.w}; } }
    }
}
__device__ __forceinline__ void phase_rstd_q(const float* ssq16, float* rstd, const bf16* a16, unsigned char* a8, int lane, int wave) {
    const int gw = blockIdx.x * NWAVES + wave, NGW = gridDim.x * NWAVES;
    for (int m0 = gw; m0 < M; m0 += 4 * NGW) {
        v4u hv[4][2];
#pragma unroll
        for (int q = 0; q < 4; ++q) { const int mq = (m0 + q * NGW < M) ? m0 + q * NGW : m0; const GAS v4u* hr = (const GAS v4u*)(a16 + (size_t)mq * D) + 2 * lane; hv[q][0] = hr[0]; hv[q][1] = hr[1]; }
#pragma unroll
        for (int q = 0; q < 4; ++q) { const int m = m0 + q * NGW; if (m >= M) break;
            float x[16]; unpack8f(hv[q][0], x); unpack8f(hv[q][1], x + 8);
            float amax = 1e-30f;
#pragma unroll
            for (int e = 0; e < 16; ++e) amax = __builtin_fmaxf(amax, __builtin_fabsf(x[e]));
            amax = wave_max(amax);
            const float qs = 127.f * __builtin_amdgcn_rcpf(amax);
            v4u o; o.x = i8x4(x[0] * qs, x[1] * qs, x[2] * qs, x[3] * qs); o.y = i8x4(x[4] * qs, x[5] * qs, x[6] * qs, x[7] * qs);
            o.z = i8x4(x[8] * qs, x[9] * qs, x[10] * qs, x[11] * qs); o.w = i8x4(x[12] * qs, x[13] * qs, x[14] * qs, x[15] * qs);
            *((GAS v4u*)(a8 + (size_t)m * D) + lane) = o;
            if (lane == 0) rstd[m] = pg8::row_rstd(ssq16, m) * amax * (1.f / 127.f); }
    }
}
__device__ __forceinline__ void phase_rstd(const float* ssq16, float* rstd, int tid) {
    for (int m = blockIdx.x * 512 + tid; m < M; m += gridDim.x * 512) rstd[m] = pg8::row_rstd(ssq16, m);
}
__device__ __forceinline__ void phase_conv_qkv(const bf16* src, bf16* dst, const float* cw  , bool do_norm, float scale, int lane, int wave) {
    const int gw = blockIdx.x * NWAVES + wave, NGW = gridDim.x * NWAVES;
    const int c0 = (gw & 1) * 512 + 8 * lane;
    float w[5][8];
#pragma unroll
    for (int i = 0; i < 5; ++i)
#pragma unroll
        for (int e = 0; e < 8; ++e) w[i][e] = cw[i * 3072 + c0 + e];
    for (int it = gw; it < 2 * (M / 32); it += NGW) {
        const int r0 = (it >> 1) * 32, s0 = r0 & (SEQ - 1);
        v4u raw[12];
#define CONV_LOAD(ch_) do { _Pragma("unroll") for (int k = 0; k < 12; ++k) { const int ss = s0 + 8 * (ch_) - 2 + k; raw[k] = (v4u){0u, 0u, 0u, 0u}; \
            if (ss >= 0 && ss < SEQ) raw[k] = *(const GAS v4u*)(src + (size_t)(r0 + 8 * (ch_) - 2 + k) * D + c0); } } while (0)
        CONV_LOAD(0);
#pragma unroll 1
        for (int ch = 0; ch < 4; ++ch) {
            float x[12][8];
#pragma unroll
            for (int k = 0; k < 12; ++k) unpack8f(raw[k], x[k]);
            if (ch < 3) CONV_LOAD(ch + 1);
#pragma unroll
            for (int o = 0; o < 8; ++o) { float acc[8]; float ssq = 0.f;
#pragma unroll
                for (int e = 0; e < 8; ++e) { float t = x[o][e] * w[0][e];
#pragma unroll
                    for (int i = 1; i < 5; ++i) t += x[o + i][e] * w[i][e];
                    t = siluf_(t); acc[e] = t; ssq += t * t; }
                if (do_norm) { const float r = scale * __builtin_amdgcn_rsqf(sum16(ssq) + EPS);
#pragma unroll
                    for (int e = 0; e < 8; ++e) acc[e] *= r; }
                *(GAS v4u*)(dst + (size_t)(r0 + 8 * ch + o) * D + c0) = pack8f(acc); }
        }
#undef CONV_LOAD
    }
}
__device__ __forceinline__ void phase_ya(const bf16* cab, const bf16* cv, const float* cw  , bf16* ya, int lane, int wave) {
    const int gw = blockIdx.x * NWAVES + wave, NGW = gridDim.x * NWAVES, c0 = 8 * lane;
    float w[3][8];
#pragma unroll
    for (int i = 0; i < 3; ++i)
#pragma unroll
        for (int e = 0; e < 8; ++e) w[i][e] = cw[i * 512 + c0 + e];
    for (int it = gw; it < M / 32; it += NGW) {
        const int r0 = it * 32, s0 = r0 & (SEQ - 1);
#pragma unroll 1
        for (int ch = 0; ch < 4; ++ch) {
            float x[10][8]; v4u g[8];
#pragma unroll
            for (int k = 0; k < 10; ++k) { const int ss = s0 + 8 * ch - 1 + k; v4u raw = {0u, 0u, 0u, 0u};
                if (ss >= 0 && ss < SEQ) raw = *(const GAS v4u*)(cv + (size_t)(r0 + 8 * ch - 1 + k) * 512 + c0);
                unpack8f(raw, x[k]); }
#pragma unroll
            for (int o = 0; o < 8; ++o) g[o] = *(const GAS v4u*)(cab + (size_t)(r0 + 8 * ch + o) * 512 + c0);
#pragma unroll
            for (int o = 0; o < 8; ++o) { float acc[8], gf[8]; unpack8f(g[o], gf);
#pragma unroll
                for (int e = 0; e < 8; ++e) acc[e] = (x[o][e] * w[0][e] + x[o + 1][e] * w[1][e] + x[o + 2][e] * w[2][e]) * gf[e];
                *(GAS v4u*)(ya + (size_t)(r0 + 8 * ch + o) * 512 + c0) = pack8f(acc); }
        }
    }
}
__device__ __forceinline__ void phase_ba(const bf16* xn, const bf16* wba, float* ba, int lane, int wave) {
    typedef short bf16x8 __attribute__((ext_vector_type(8)));
    const int gw = blockIdx.x * NWAVES + wave, NGW = gridDim.x * NWAVES, c16 = lane & 15, q4 = lane >> 4;
    for (int it = gw; it < M / 16; it += NGW) {
        const bf16* ap = xn + (size_t)(16 * it + c16) * D + 8 * q4; const bf16* bp0 = wba + (size_t)c16 * D + 8 * q4; const bf16* bp1 = bp0 + (size_t)16 * D;
        f32x4 acc0 = {0.f, 0.f, 0.f, 0.f}, acc1 = {0.f, 0.f, 0.f, 0.f};
#pragma unroll 8
        for (int ks = 0; ks < D / 32; ++ks) {
            const bf16x8 a = *(const bf16x8*)(ap + 32 * ks), b0 = *(const bf16x8*)(bp0 + 32 * ks), b1 = *(const bf16x8*)(bp1 + 32 * ks);
            acc0 = __builtin_amdgcn_mfma_f32_16x16x32_bf16(a, b0, acc0, 0, 0, 0); acc1 = __builtin_amdgcn_mfma_f32_16x16x32_bf16(a, b1, acc1, 0, 0, 0); }
#pragma unroll
        for (int r = 0; r < 4; ++r) { float* o = ba + (size_t)(16 * it + 4 * q4 + r) * 32; o[c16] = acc0[r]; o[16 + c16] = acc1[r]; }
    }
}
__device__ __forceinline__ void phase_gb(const Args& a, const float* ba, float* gb, int tid) {
    for (int i = blockIdx.x * 512 + tid; i < M * 32; i += gridDim.x * 512) {
        const int row = i >> 5, j = i & 31, part = j >> 3, h = j & 7; const float x = ba[i]; float r;
        if (part < 2) r = sigmoidf_(x);
        else { const float al = a.in[part == 2 ? I_ALF : I_ALB][h], dt = a.in[part == 2 ? I_DTF : I_DTB][h]; const float y = x + dt;
            const float sp = y > 20.f ? y : log1pf(__expf(y)); r = -__expf(al) * sp; }
        gb[(size_t)part * M * 8 + (size_t)row * 8 + h] = r;
    }
}
namespace scan {
typedef short bf16x8 __attribute__((ext_vector_type(8)));
typedef short s16x4 __attribute__((ext_vector_type(4)));
typedef float f32x4 __attribute__((ext_vector_type(4)));
typedef unsigned u32x2 __attribute__((ext_vector_type(2)));
typedef unsigned long long u64;
typedef u64 u64x2 __attribute__((ext_vector_type(2)));
typedef __bf16 nbf16x8 __attribute__((ext_vector_type(8)));
typedef __bf16 nbf16x2 __attribute__((ext_vector_type(2)));
typedef float f32x8 __attribute__((ext_vector_type(8)));
typedef float f32x2 __attribute__((ext_vector_type(2)));
constexpr int RS = 288, TS = 144, VSS = 80;
constexpr int KNB = 0, QNB = 55296, VSB = 92160, SCB = 102400;
constexpr int KN_BYTES = 18432, VS_BYTES = 5120, SC_BYTES = 1280;
constexpr int ATTB = 106240, ANEGB = 124672, DMB = 143104, SCAN_LDS_END = 147200;
static_assert(SCAN_LDS_END <= LDSCTL_OFF, "scan LDS");
__device__ __forceinline__ bf16x8 frag2(u64 lo, u64 hi) { return __builtin_bit_cast(bf16x8, (u64x2){lo, hi}); }
__device__ __forceinline__ bf16x8 packB(f32x4 a, f32x4 b) { const f32x8 v = {a[0], a[1], a[2], a[3], b[0], b[1], b[2], b[3]}; return __builtin_bit_cast(bf16x8, __builtin_convertvector(v, nbf16x8)); }
__device__ __forceinline__ bf16x8 packB1(f32x4 a) { const f32x8 v = {a[0], a[1], a[2], a[3], 0.f, 0.f, 0.f, 0.f}; return __builtin_bit_cast(bf16x8, __builtin_convertvector(v, nbf16x8)); }
__device__ __forceinline__ unsigned cvt2(float lo, float hi) { const f32x2 v = {lo, hi}; return __builtin_bit_cast(unsigned, __builtin_convertvector(v, nbf16x2)); }
__device__ __forceinline__ unsigned short cvt1(float x) { return (unsigned short)(cvt2(x, 0.f) & 0xffffu); }
#define MFMA16(a, b, c) __builtin_amdgcn_mfma_f32_16x16x32_bf16((a), (b), (c), 0, 0, 0)
__device__ __forceinline__ bf16x8 ldA1(LAS unsigned char* base, int stride, int c16, int q4, int col0) {
    LAS unsigned char* p = base + c16 * stride + (col0 + 4 * q4) * 2; return frag2(*(LAS u64*)p, 0ull); }
__device__ __forceinline__ bf16x8 ldAtr(LAS unsigned char* tile, int c16, int q4, int row0, int dt) {
    LAS unsigned char* p = tile + (row0 + 4 * q4 + (c16 >> 2)) * RS + (32 * (dt >> 1) + 8 * (c16 & 3) + 4 * (dt & 1)) * 2;
    const s16x4 lo = __builtin_amdgcn_ds_read_tr16_b64_v4i16((LAS s16x4*)p), hi = __builtin_amdgcn_ds_read_tr16_b64_v4i16((LAS s16x4*)(p + 16 * RS));
    return (bf16x8){lo[0], lo[1], lo[2], lo[3], hi[0], hi[1], hi[2], hi[3]}; }
__device__ __forceinline__ bf16x8 ldA16(LAS unsigned char* base, int stride, int c16, int q4, int col0) { return *(LAS bf16x8*)(base + c16 * stride + (col0 + 8 * q4) * 2); }
__device__ __forceinline__ int tpos(int tj, int q4) { return 32 * (tj >> 1) + 8 * q4 + 4 * (tj & 1); }
__device__ __forceinline__ void d_invert(f32x4 at, LAS unsigned char* dmb, int c16, int q4) {
    LAS unsigned char* wp = dmb + c16 * 32 + 8 * q4;
    LAS unsigned char* rp = dmb + (4 * q4 + (c16 >> 2)) * 32 + 8 * (c16 & 3);
    const f32x4 z = {0.f, 0.f, 0.f, 0.f};
    f32x4 nt = -at, pt;
#pragma unroll
    for (int r = 0; r < 4; ++r) pt[r] = nt[r] + ((4 * q4 + r == c16) ? 1.f : 0.f);
#pragma unroll
    for (int k = 0; k < 4; ++k) {
        *(LAS u32x2*)wp = (u32x2){cvt2(nt[0], nt[1]), cvt2(nt[2], nt[3])};
        const s16x4 lo = __builtin_amdgcn_ds_read_tr16_b64_v4i16((LAS s16x4*)rp);
        const bf16x8 aop = (bf16x8){lo[0], lo[1], lo[2], lo[3], 0, 0, 0, 0};
        if (k > 0) pt = MFMA16(aop, packB1(pt), pt);
        if (k < 3) nt = MFMA16(aop, packB1(nt), z);
    }
    *(LAS u32x2*)wp = (u32x2){cvt2(pt[0], pt[1]), cvt2(pt[2], pt[3])};
}
template <int NT> __device__ __forceinline__ void c_tiles(LAS unsigned char* kn, LAS unsigned char* qn, LAS float* scf, LAS unsigned char* att, LAS unsigned char* aneg, f32x4& adiag, int ti, int tj0, int c16, int q4) {
    f32x4 acck[NT], accq[NT];
#pragma unroll
    for (int t = 0; t < NT; ++t) { acck[t] = (f32x4){0.f, 0.f, 0.f, 0.f}; accq[t] = (f32x4){0.f, 0.f, 0.f, 0.f}; }
    bf16x8 fa[2][NT], fk[2], fq[2];
#define C_LOAD(bf_, ks_) do { fk[bf_] = *(LAS bf16x8*)(kn + (16 * ti + c16) * RS + (ks_) * 64 + q4 * 16); fq[bf_] = *(LAS bf16x8*)(qn + (16 * ti + c16) * RS + (ks_) * 64 + q4 * 16); \
        _Pragma("unroll") for (int t = 0; t < NT; ++t) fa[bf_][t] = *(LAS bf16x8*)(kn + (16 * (tj0 + t) + c16) * RS + (ks_) * 64 + q4 * 16); } while (0)
    C_LOAD(0, 0);
#pragma unroll
    for (int ks = 0; ks < 4; ++ks) {
        if (ks == 0) C_LOAD(1, 1); else if (ks == 1) C_LOAD(0, 2); else if (ks == 2) C_LOAD(1, 3);
        __builtin_amdgcn_sched_barrier(0);
#pragma unroll
        for (int t = 0; t < NT; ++t) { acck[t] = MFMA16(fa[ks & 1][t], fk[ks & 1], acck[t]); accq[t] = MFMA16(fa[ks & 1][t], fq[ks & 1], accq[t]); }
        __builtin_amdgcn_sched_barrier(0);
    }
#undef C_LOAD
    const int I = 16 * ti + c16;
    const float gi = scf[I], bi = scf[128 + I];
#pragma unroll
    for (int t = 0; t < NT; ++t) {
        const int tj = tj0 + t, J0 = 16 * tj + 4 * q4;
        const f32x4 gj = *(LAS f32x4*)(scf + J0);
        f32x4 a, tt;
#pragma unroll
        for (int r = 0; r < 4; ++r) { const float dec = __expf(gi - gj[r]);
            a[r] = (I > J0 + r) ? bi * acck[t][r] * dec : 0.f; tt[r] = (I >= J0 + r) ? accq[t][r] * dec : 0.f; }
        *(LAS u32x2*)(att + I * TS + tpos(tj, q4) * 2) = (u32x2){cvt2(tt[0], tt[1]), cvt2(tt[2], tt[3])};
        if (tj == ti) adiag = a;
        else *(LAS u32x2*)(aneg + I * TS + tpos(tj, q4) * 2) = (u32x2){cvt2(-a[0], -a[1]), cvt2(-a[2], -a[3])};
    }
}
__device__ __forceinline__ void e_solve(const f32x4 (&rhs)[4], f32x4 (&X)[4], const bf16x8 (&Df)[4], bf16x8 A10, bf16x8 A2x, bf16x8 A3a, bf16x8 A3b) {
    const f32x4 z = {0.f, 0.f, 0.f, 0.f};
    X[0] = MFMA16(Df[0], packB1(rhs[0]), z);
    f32x4 y = MFMA16(A10, packB1(X[0]), rhs[1]);
    X[1] = MFMA16(Df[1], packB1(y), z);
    const bf16x8 x01 = packB(X[0], X[1]);
    y = MFMA16(A2x, x01, rhs[2]);
    f32x4 y3 = MFMA16(A3a, x01, rhs[3]);
    X[2] = MFMA16(Df[2], packB1(y), z);
    y3 = MFMA16(A3b, packB1(X[2]), y3);
    X[3] = MFMA16(Df[3], packB1(y3), z);
}
__device__ __forceinline__ void phase_scan(const bf16* Q, const bf16* K, const bf16* V, const float* gbuf, bf16* OF, bf16* OB, LAS unsigned char* lds, int tid, int lane, int wave) {
    constexpr int NC = SEQ / 64;
    for (int item = blockIdx.x; item < BATCH * NH * 2 * 4; item += gridDim.x) {
        const int xq = item & 7, yq = item >> 3, ci = xq * 8 + (yq >> 2), sl = yq & 3;
        const int b = ci >> 4, h = (ci >> 1) & 7, dir = ci & 1;
        const float* betap = gbuf + (size_t)dir * M * 8 + h; const float* glp = gbuf + (size_t)(2 + dir) * M * 8 + h; bf16* O = dir ? OB : OF;
        const size_t rowbase = (size_t)b * SEQ;
        __syncthreads();
        for (int i = tid; i < 2 * 9216 / 4; i += 512) ((LAS unsigned*)(lds + ATTB))[i] = 0u;
        v4u kreg[2], qreg[2], vreg = {0u, 0u, 0u, 0u}; float greg = 0.f, breg = 0.f;
#define SCAN_LOAD(n_) do { \
            _Pragma("unroll") for (int r = 0; r < 2; ++r) { const int pi = tid + 512 * r, row = pi >> 4, pc = pi & 15; const int p = 64 * (n_) + row; const int s = dir ? (SEQ - 1 - p) : p; \
                const size_t off = (rowbase + s) * D + h * 128 + pc * 8; kreg[r] = *(const GAS v4u*)(K + off); qreg[r] = *(const GAS v4u*)(Q + off); } \
            if (tid < 256) { const int row = tid >> 2, pc = tid & 3; const int p = 64 * (n_) + row; const int s = dir ? (SEQ - 1 - p) : p; vreg = *(const GAS v4u*)(V + (rowbase + s) * D + h * 128 + sl * 32 + pc * 8); } \
            if (wave == 6) { const int p = 64 * (n_) + lane; const int s = dir ? (SEQ - 1 - p) : p; greg = glp[(rowbase + s) * 8]; breg = betap[(rowbase + s) * 8]; } } while (0)
#define SCAN_STAGE(k3_, p2_) do { LAS unsigned char* knw_ = lds + KNB + (k3_) * KN_BYTES; LAS unsigned char* qnw_ = lds + QNB + (p2_) * KN_BYTES; LAS unsigned char* vsw_ = lds + VSB + (p2_) * VS_BYTES; \
            _Pragma("unroll") for (int r = 0; r < 2; ++r) { const int pi = tid + 512 * r, row = pi >> 4, pc = pi & 15; \
                *(LAS v4u*)(knw_ + row * RS + pc * 16) = kreg[r]; *(LAS v4u*)(qnw_ + row * RS + pc * 16) = qreg[r]; } \
            if (tid < 256) { const int row = tid >> 2, pc = tid & 3; *(LAS v4u*)(vsw_ + row * VSS + pc * 16) = vreg; } \
            if (wave == 6) { float g = greg; LAS float* scw = (LAS float*)(lds + SCB + (k3_) * SC_BYTES); \
                g = dpp_add<0x111>(g); g = dpp_add<0x112>(g); g = dpp_add<0x114>(g); g = dpp_add<0x118>(g);        \
                g = dpp_add<0x142, 0xa>(g); g = dpp_add<0x143, 0xc>(g);                                          \
                const float g63 = __shfl(g, 63), eg = __expf(g); \
                scw[lane] = g; scw[64 + lane] = breg * eg; scw[128 + lane] = breg; scw[192 + lane] = eg; scw[256 + lane] = __expf(g63 - g); } } while (0)
        SCAN_LOAD(0);
        SCAN_STAGE(0, 0);
        SCAN_LOAD(1);
        __syncthreads();
#define SCAN_ITER_PTRS \
            const bool have_prod = (n + 1 < NC), have_cons = (n >= 0), have_stage = (n + 2 < NC); (void)have_prod; (void)have_cons; \
            LAS unsigned char* knc = lds + KNB + k3c * KN_BYTES; LAS unsigned char* knp = lds + KNB + k3p * KN_BYTES;              \
            LAS unsigned char* qnc = lds + QNB + (n & 1) * KN_BYTES; LAS unsigned char* qnp = lds + QNB + ((n + 1) & 1) * KN_BYTES; \
            LAS unsigned char* vsc = lds + VSB + (n & 1) * VS_BYTES; \
            LAS float* scc = (LAS float*)(lds + SCB + k3c * SC_BYTES); LAS float* scp = (LAS float*)(lds + SCB + k3p * SC_BYTES); \
            LAS unsigned char* attc = lds + ATTB + (n & 1) * 9216; LAS unsigned char* attp = lds + ATTB + ((n + 1) & 1) * 9216; \
            LAS unsigned char* anegc = lds + ANEGB + (n & 1) * 9216; LAS unsigned char* anegp = lds + ANEGB + ((n + 1) & 1) * 9216; \
            LAS unsigned char* dmc = lds + DMB + (n & 1) * 2048; LAS unsigned char* dmp = lds + DMB + ((n + 1) & 1) * 2048; \
            (void)knc; (void)knp; (void)qnc; (void)qnp; (void)vsc; (void)scc; (void)scp; (void)attc; (void)attp; (void)anegc; (void)anegp; (void)dmc; (void)dmp; \
            int lane_o = lane; asm volatile("" : "+v"(lane_o)); const int c16 = lane_o & 15, q4 = lane_o >> 4;
#define SCAN_ITER_NEXT do { k3c = k3p; k3p = k3s; k3s = (k3s == 2) ? 0 : k3s + 1; } while (0)
        if (wave < 2) {
            f32x4 S[8];
#pragma unroll
            for (int t = 0; t < 8; ++t) S[t] = (f32x4){0.f, 0.f, 0.f, 0.f};
            int k3c = 2, k3p = 0, k3s = 1;
            for (int n = -1; n < NC; ++n) {
                SCAN_ITER_PTRS
                f32x4 R[4], ao[4], vn[4];
                if (have_cons) {
                    bf16x8 Sb[4];
#pragma unroll
                    for (int ks = 0; ks < 4; ++ks) Sb[ks] = packB(S[2 * ks], S[2 * ks + 1]);
                    bf16x8 kf[2][4], qf[2][4]; f32x4 kbv[2], bev[2]; float egv[2]; s16x4 vraw[2];
                    bf16x8 Df[4], A10, A2x, A3a, A3b;
#define F1_LOAD(bf_, it_) do { _Pragma("unroll") for (int ks = 0; ks < 4; ++ks) { kf[bf_][ks] = ldA16(knc + 16 * (it_) * RS, RS, c16, q4, 32 * ks); qf[bf_][ks] = ldA16(qnc + 16 * (it_) * RS, RS, c16, q4, 32 * ks); } \
                        kbv[bf_] = *(LAS f32x4*)(scc + 64 + 16 * (it_) + 4 * q4); bev[bf_] = *(LAS f32x4*)(scc + 128 + 16 * (it_) + 4 * q4); egv[bf_] = scc[192 + 16 * (it_) + c16]; \
                        vraw[bf_] = __builtin_amdgcn_ds_read_tr16_b64_v4i16((LAS s16x4*)(vsc + (16 * (it_) + 4 * q4 + (c16 >> 2)) * VSS + (16 * wave + 4 * (c16 & 3)) * 2)); } while (0)
                    F1_LOAD(0, 0);
#pragma unroll
                    for (int it = 0; it < 4; ++it) {
                        if (it == 0) F1_LOAD(1, 1); else if (it == 1) F1_LOAD(0, 2); else if (it == 2) F1_LOAD(1, 3);
                        else {
#pragma unroll
                            for (int r = 0; r < 4; ++r) Df[r] = ldA1(dmc + r * 512, 32, c16, q4, 0);
                            A10 = frag2(*(LAS u64*)(anegc + (16 + c16) * TS + tpos(0, q4) * 2), 0ull); A2x = ldA16(anegc + 32 * TS, TS, c16, q4, 0);
                            A3a = ldA16(anegc + 48 * TS, TS, c16, q4, 0); A3b = frag2(*(LAS u64*)(anegc + (48 + c16) * TS + tpos(2, q4) * 2), 0ull); }
                        __builtin_amdgcn_sched_barrier(0);
                        const int bf = it & 1;
                        f32x4 ak = {0.f, 0.f, 0.f, 0.f}, aq = {0.f, 0.f, 0.f, 0.f};
#pragma unroll
                        for (int ks = 0; ks < 4; ++ks) { ak = MFMA16(kf[bf][ks], Sb[ks], ak); aq = MFMA16(Sb[ks], qf[bf][ks], aq); }
                        f32x4 vb;
#pragma unroll
                        for (int rr = 0; rr < 4; ++rr) vb[rr] = bf2f((unsigned short)vraw[bf][rr]) * bev[bf][rr];
                        R[it] = vb - kbv[bf] * ak; ao[it] = aq * egv[bf];
                        __builtin_amdgcn_sched_barrier(0);
                    }
#undef F1_LOAD
                    e_solve(R, vn, Df, A10, A2x, A3a, A3b);
                }
                __syncthreads();
                if (have_stage) SCAN_STAGE(k3s, n & 1);
                if (n + 3 < NC) SCAN_LOAD(n + 3);
                if (have_cons) {
                    const float egl = scc[192 + 63];
                    bf16x8 tf[2][4][2];
#define F2_LOAD(bf_, dt0_) do { _Pragma("unroll") for (int d = 0; d < 4; ++d) _Pragma("unroll") for (int s2 = 0; s2 < 2; ++s2) tf[bf_][d][s2] = ldAtr(knc, c16, q4, 32 * s2, (dt0_) + d); } while (0)
                    F2_LOAD(0, 0);
                    F2_LOAD(1, 4);
                    bf16x8 Vb[2], Vd[2];
#pragma unroll
                    for (int s2 = 0; s2 < 2; ++s2) { const f32x4 e0 = *(LAS f32x4*)(scc + 256 + 32 * s2 + 4 * q4), e1 = *(LAS f32x4*)(scc + 256 + 32 * s2 + 16 + 4 * q4);
                        Vb[s2] = packB(vn[2 * s2], vn[2 * s2 + 1]); Vd[s2] = packB(vn[2 * s2] * e0, vn[2 * s2 + 1] * e1); }
                    __builtin_amdgcn_sched_barrier(0);
#pragma unroll
                    for (int d = 0; d < 4; ++d) { f32x4 a = S[d] * egl;
#pragma unroll
                        for (int s2 = 0; s2 < 2; ++s2) a = MFMA16(tf[0][d][s2], Vd[s2], a);
                        S[d] = a; }
#pragma unroll
                    for (int it = 0; it < 4; ++it)
#pragma unroll
                        for (int s2 = 0; s2 < 2; ++s2) tf[0][it][s2] = ldA16(attc + 16 * it * TS, TS, c16, q4, 32 * s2);
                    __builtin_amdgcn_sched_barrier(0);
#pragma unroll
                    for (int d = 0; d < 4; ++d) { f32x4 a = S[4 + d] * egl;
#pragma unroll
                        for (int s2 = 0; s2 < 2; ++s2) a = MFMA16(tf[1][d][s2], Vd[s2], a);
                        S[4 + d] = a; }
                    __builtin_amdgcn_sched_barrier(0);
#undef F2_LOAD
#pragma unroll
                    for (int it = 0; it < 4; ++it) {
#pragma unroll
                        for (int s2 = 0; s2 < 2; ++s2) ao[it] = MFMA16(Vb[s2], tf[0][it][s2], ao[it]);
                        const int p = 64 * n + 16 * it + c16; const int s = dir ? (SEQ - 1 - p) : p;
                        *(GAS u32x2*)(O + (rowbase + s) * D + h * 128 + sl * 32 + 16 * wave + 4 * q4) = (u32x2){cvt2(ao[it][0], ao[it][1]), cvt2(ao[it][2], ao[it][3])}; }
                }
                SCAN_ITER_NEXT;
                __syncthreads();
            }
        } else {
            int k3c = 2, k3p = 0, k3s = 1;
            for (int n = -1; n < NC; ++n) {
                SCAN_ITER_PTRS
                f32x4 adiag = {0.f, 0.f, 0.f, 0.f};
                const int ti = (wave < 4) ? 3 : (wave == 6 || wave == 5) ? 2 : (wave == 7) ? 1 : 0, tj0 = (wave == 3) ? 2 : (wave == 6) ? 1 : 0;
                if (have_prod) {
                    if (wave != 4 && wave != 5) c_tiles<2>(knp, qnp, scp, attp, anegp, adiag, ti, tj0, c16, q4);
                    else c_tiles<1>(knp, qnp, scp, attp, anegp, adiag, ti, tj0, c16, q4); }
                __syncthreads();
                if (have_stage) SCAN_STAGE(k3s, n & 1);
                if (n + 3 < NC) SCAN_LOAD(n + 3);
                if (have_prod && wave != 2 && wave != 5) d_invert(adiag, dmp + ti * 512, c16, q4);
                SCAN_ITER_NEXT;
                __syncthreads();
            }
        }
#undef SCAN_ITER_PTRS
#undef SCAN_ITER_NEXT
#undef SCAN_LOAD
#undef SCAN_STAGE
    }
}
#undef MFMA16
}

__device__ __forceinline__ void phase_onorm(bf16* of, const bf16* ob, const float* dnw, int lane, int wave) {
    const int gw = blockIdx.x * NWAVES + wave, NGW = gridDim.x * NWAVES, hh = lane >> 4, cp = lane & 15;
    float w[8];
#pragma unroll
    for (int e = 0; e < 8; ++e) w[e] = dnw[8 * cp + e];
    for (int it0 = gw; it0 < M * 2; it0 += 4 * NGW) {
        v4u xa[4], ya[4];
#pragma unroll
        for (int q = 0; q < 4; ++q) { const int it = (it0 + q * NGW < M * 2) ? it0 + q * NGW : it0; const size_t off = (size_t)(it >> 1) * D + (4 * (it & 1) + hh) * 128 + 8 * cp; xa[q] = *(const GAS v4u*)(of + off); ya[q] = *(const GAS v4u*)(ob + off); }
#pragma unroll
        for (int q = 0; q < 4; ++q) { const int it = it0 + q * NGW; if (it >= M * 2) break; const size_t off = (size_t)(it >> 1) * D + (4 * (it & 1) + hh) * 128 + 8 * cp;
            float x[8], y[8]; unpack8f(xa[q], x); unpack8f(ya[q], y);
            float ssq = 0.f;
#pragma unroll
            for (int e = 0; e < 8; ++e) { x[e] += y[e]; ssq += x[e] * x[e]; }
            const float r = __builtin_amdgcn_rsqf(sum16(ssq) * (1.f / 128.f) + EPS);
#pragma unroll
            for (int e = 0; e < 8; ++e) x[e] = x[e] * r * w[e];
            *(GAS v4u*)(of + off) = pack8f(x); }
    }
}

template <class Epi, int QMODE = 0> __device__ __forceinline__ void run_gemm(LAS unsigned char* lds, const bf16* A, const bf16* Bt, int N, int K, const Epi& E) {
    pg8::Gemm g{A, Bt, M, N, K}; pg8::StaticOrder S; S.init(M, N, (int)gridDim.x, (int)blockIdx.x);
    pg8::gemm_phase<Epi, pg8::StaticOrder, true, true, QMODE>(lds, g, S, E);
}

__global__ void __launch_bounds__(NWAVES * 64, 2) mk_fwd(Args args) {
    extern __shared__ __attribute__((aligned(16))) unsigned char lds_raw[];
    LAS unsigned char* lds = (LAS unsigned char*)lds_raw;
    volatile LAS unsigned* MISC = (volatile LAS unsigned*)(lds + MISC_OFF);
    const int tid = threadIdx.x, lane = tid & 63, wave = __builtin_amdgcn_readfirstlane(tid >> 6);
    unsigned char* ws = args.ws;
    for (int u = tid; u < (LDS_BYTES - LDSCTL_OFF) / 4; u += NWAVES * 64) ((LAS unsigned*)(lds + LDSCTL_OFF))[u] = 0u;
    __syncthreads();
    XcdBarrier bar; bar.bar = (unsigned*)(ws + WS_CTL); bar.x = 0; bar.st = nullptr;
    const int lo = args.ph_lo, hi = args.ph_hi;
    if (hi - lo > 1) bar = xcd_barrier_post((unsigned*)(ws + WS_CTL), MISC + 8);
    float* mod = (float*)(ws + WS_MOD);
    bf16* XN = (bf16*)(ws + WS_XN); bf16* HID = (bf16*)(ws + WS_HID);


#define IN(k) (lo <= (k) && (k) < hi)
#define TIDS int tid = threadIdx.x; asm volatile("" : "+v"(tid)); const int lane = tid & 63; const int wave = __builtin_amdgcn_readfirstlane(tid >> 6); (void)lane; (void)wave;
#define SEAM(k) do { if (IN(k) && (k) + 1 < hi) xcd_barrier(bar); } while (0)
    const float* ssqv = (const float*)(ws + WS_SSQ); float* ssqw = (float*)(ws + WS_SSQ);
    bf16* HB1 = (bf16*)args.out; bf16* HB2 = (bf16*)(ws + WS_HB2); bf16* HB3 = (bf16*)(ws + WS_HB3);
    const float* cw2 = (const float*)(ws + WS_CW); const float* cw3 = cw2 + 4 * D;
    if (IN(0)) { TIDS phase_prologue(args, lds, tid, lane, wave); } SEAM(0);
    if (IN(1)) { TIDS phase_first(args, mod, XN, tid, lane, wave); } SEAM(1);
    if (IN(2)) { TIDS pg8::EpiGlu<false, true> E{HID, FF, ssqv, (const float*)(ws + WS_BW + BW_UP1), 2 * FF, (LAS float*)(lds + RING_BYTES), (const float*)(ws + WS_CF)};
        run_gemm<pg8::EpiGlu<false, true>, 2>(lds, XN, (const bf16*)(ws + WS_WUP1I8), 2 * FF, D / 2, E); } SEAM(2);
    if (IN(3)) { TIDS pg8::EpiRes<true> E{args.in[I_X], HB1, nullptr, mod + 2 * D, NMOD * D, 0.5f, nullptr, ssqw + (size_t)16 * M}; run_gemm(lds, HID, (const bf16*)(ws + WS_WDN1), D, FF, E); } SEAM(3);
    bf16* XNB = (bf16*)args.out + (size_t)M * D;
    if (IN(4)) { TIDS phase_mix_norm(HB1, ssqv + (size_t)16 * M, cw2, mod + 3 * D, XNB, (unsigned char*)(ws + WS_XN), (float*)(ws + WS_RSX), lane, wave); } SEAM(4);
    if (IN(5)) { TIDS phase_ba(XNB, (const bf16*)(ws + WS_WIN1) + (size_t)4608 * D, (float*)(ws + WS_BA), lane, wave);
        pg8::EpiIn1 E{(bf16*)(ws + WS_CV), (bf16*)(ws + WS_CAB), (bf16*)(ws + WS_QRAW), (size_t)M * D, (float*)(ws + WS_BA)};
        run_gemm(lds, XNB, (const bf16*)(ws + WS_WIN1), N_IN1, D, E); } SEAM(5);
    if (IN(6)) { TIDS phase_conv_qkv((const bf16*)(ws + WS_QRAW), (bf16*)(ws + WS_QF), args.in[I_CONVDN], true, 0.08838834764831845f, lane, wave);
        phase_ya((const bf16*)(ws + WS_CAB), (const bf16*)(ws + WS_CV), args.in[I_CONVA], (bf16*)(ws + WS_YA), lane, wave);
        phase_gb(args, (const float*)(ws + WS_BA), (float*)(ws + WS_GB), tid); } SEAM(6);
    bf16* VFp = (bf16*)args.out + (size_t)M * D;
    if (IN(7)) { TIDS phase_conv_qkv((const bf16*)(ws + WS_KRAW), (bf16*)(ws + WS_KF), args.in[I_CONVDN] + 1024, true, 1.0f, lane, wave);
        phase_conv_qkv((const bf16*)(ws + WS_VRAW), VFp, args.in[I_CONVDN] + 2048, false, 1.0f, lane, wave); } SEAM(7);
    if (IN(9)) { TIDS scan::phase_scan((const bf16*)(ws + WS_QF), (const bf16*)(ws + WS_KF), (const bf16*)VFp, (const float*)(ws + WS_GB), (bf16*)(ws + WS_OF), (bf16*)(ws + WS_OB), lds, tid, lane, wave); } SEAM(9);
    if (IN(10)) { TIDS phase_onorm((bf16*)(ws + WS_OF), (const bf16*)(ws + WS_OB), args.in[I_DNNORM], lane, wave); } SEAM(10);
    if (IN(11)) { TIDS pg8::EpiIn2Q E{(bf16*)(ws + WS_OF), (bf16*)(ws + WS_SGA), (bf16*)(ws + WS_SGB), (const float*)(ws + WS_RSX), (const float*)(ws + WS_CF3), (LAS float*)(lds + RING_BYTES)};
        run_gemm<pg8::EpiIn2Q, 2>(lds, XN, (const bf16*)(ws + WS_WIN2I8), N_IN2, D / 2, E); } SEAM(11);
    if (IN(12)) { TIDS pg8::EpiMul E{(bf16*)(ws + WS_SGA)}; run_gemm(lds, (const bf16*)(ws + WS_YA), (const bf16*)(ws + WS_WA), D, 512, E);
        asm volatile("s_waitcnt vmcnt(0)" ::: "memory"); __builtin_amdgcn_fence(__ATOMIC_ACQUIRE, "agent"); asm volatile("s_waitcnt vmcnt(0)" ::: "memory"); __syncthreads(); }
    if (IN(13)) { TIDS pg8::EpiMerge E{(const bf16*)(ws + WS_SGA), (bf16*)(ws + WS_SGB)}; run_gemm(lds, (const bf16*)(ws + WS_OF), (const bf16*)(ws + WS_WB), D, D, E); } SEAM(13);
    if (IN(14)) { TIDS pg8::EpiRes<false> E{HB1, HB2, XN, mod + 5 * D, NMOD * D, 1.0f, cw3, ssqw + (size_t)32 * M}; run_gemm(lds, (const bf16*)(ws + WS_SGB), (const bf16*)(ws + WS_WO), D, D, E); } SEAM(14);
    if (IN(15)) { TIDS phase_rstd_q(ssqv + (size_t)32 * M, ssqw + (size_t)M, XN, ws + WS_YA, lane, wave); } SEAM(15);
    if (IN(16)) { TIDS pg8::EpiGlu<false, true> E{HID, FF, ssqv + (size_t)M, (const float*)(ws + WS_BW + BW_UP2), 2 * FF, (LAS float*)(lds + RING_BYTES), (const float*)(ws + WS_CF) + 2 * FF};
        run_gemm<pg8::EpiGlu<false, true>, 2>(lds, (const bf16*)(ws + WS_YA), (const bf16*)(ws + WS_WUP2I8), 2 * FF, D / 2, E); } SEAM(16);
    if (IN(17)) { TIDS pg8::EpiRes<false> E{HB2, HB3, nullptr, mod + 8 * D, NMOD * D, 0.5f, nullptr, ssqw + (size_t)48 * M}; run_gemm(lds, HID, (const bf16*)(ws + WS_WDN2), D, FF, E); } SEAM(17);
    if (IN(18)) { TIDS phase_final_norm(HB3, ssqv + (size_t)48 * M, args.out, args.in[I_NFIN], lane, wave); }
#undef IN
#undef SEAM
}

extern "C" void kernel_launch(void* const* d_in, const int* in_sizes, int n_in, void* d_out, int out_size, void* d_ws, size_t ws_size, hipStream_t stream) {
    static int grid = 0;
    if (grid == 0) {
        if (n_in != 23 || in_sizes[0] != M * D || out_size != M * D || ws_size < WS_END) { fprintf(stderr, "kernel_launch: unexpected problem: n_in %d in0 %d out %d ws %zu (need %zu)\n", n_in, n_in > 0 ? in_sizes[0] : -1, out_size, ws_size, (size_t)WS_END); grid = -1; return; }
        int dev = 0, cus = 0, per_cu = 0;
        if (hipGetDevice(&dev) != hipSuccess || hipDeviceGetAttribute(&cus, hipDeviceAttributeMultiprocessorCount, dev) != hipSuccess) { grid = -1; return; }
        if (hipFuncSetAttribute((const void*)mk_fwd, hipFuncAttributeMaxDynamicSharedMemorySize, LDS_BYTES) != hipSuccess) { fprintf(stderr, "kernel_launch: hipFuncSetAttribute failed\n"); grid = -1; return; }
        if (hipOccupancyMaxActiveBlocksPerMultiprocessor(&per_cu, (const void*)mk_fwd, NWAVES * 64, LDS_BYTES) != hipSuccess || per_cu < 1)
            fprintf(stderr, "kernel_launch: note: occupancy query reports %d workgroups per CU\n", per_cu);
        (void)hipGetLastError();
        grid = cus;
    }
    if (grid < 0) return;
    (void)hipMemsetAsync((char*)d_ws + WS_CTL, 0, CTL_ZERO_BYTES, stream);
    Args a{};
    for (int i = 0; i < 23; ++i) a.in[i] = (const float*)d_in[i];
    a.out = (float*)d_out; a.ws = (unsigned char*)d_ws;
#if MK_SPLIT
    for (int ph = 0; ph < NPHASE; ++ph) { a.ph_lo = ph; a.ph_hi = ph + 1; hipLaunchKernelGGL(mk_fwd, dim3(grid), dim3(NWAVES * 64), LDS_BYTES, stream, a); }
#else
    a.ph_lo = 0; a.ph_hi = NPHASE; hipLaunchKernelGGL(mk_fwd, dim3(grid), dim3(NWAVES * 64), LDS_BYTES, stream, a);
#endif
    const hipError_t le = hipPeekAtLastError();
    if (le != hipSuccess) fprintf(stderr, "kernel_launch: launch failed: %s\n", hipGetErrorName(le));
}
```

```cpp
#include <hip/hip_runtime.h>
#include <cstdio>
#include <cstdint>
namespace pg8 {
#define PG8_LAS __attribute__((address_space(3)))
typedef unsigned short bf16_t;
typedef short bf16x8 __attribute__((ext_vector_type(8)));
typedef float f32x4 __attribute__((ext_vector_type(4)));
typedef unsigned u32x4 __attribute__((ext_vector_type(4)));
constexpr int BM = 256, BK = 64, HALF = 128, HTB = HALF * BK * 2  , STAGE_BYTES = 8 * HTB, NXCD = 8, WGM = 8;

__host__ __device__ __forceinline__ int lds_byte(int r, int c) { const int st = (r >> 4) * 2 + (c >> 5), rr = r & 15, cc = c & 31, ob = rr * 64 + cc * 2; return st * 1024 + (ob ^ (((ob >> 9) & 1) << 5)); }
__host__ __device__ __forceinline__ void stage_rc(int b, int& R, int& C) { const int st = b / 1024, sb = b % 1024, swz = sb ^ (((sb >> 9) & 1) << 5); R = (st >> 1) * 16 + swz / 64; C = (st & 1) * 32 + (swz % 64) / 2; }
__host__ __device__ __forceinline__ int perm32(int rho) { const int n = rho >> 4, i = rho & 15; return 8 * (i >> 2) + 4 * n + (i & 3); }

struct Unit { int pm, pn; };
struct Gemm { const bf16_t* A; const bf16_t* Bt; int M, N, K; };

struct StaticOrder {
    int nM, nN, nwg, G, c;
    __host__ __device__ void init(int M, int N, int G_, int c_) { nM = M / BM; nN = N / BM; nwg = nM * nN; G = G_; c = c_; }
    __host__ __device__ bool next(int i, Unit& u) const {
        const long L = (long)i * G + c; if (L >= nwg) return false;
        int wgid = (int)L; { const int q = nwg / NXCD, r = nwg % NXCD, xcd = wgid % NXCD, off = wgid / NXCD; wgid = (xcd < r ? xcd * (q + 1) : r * (q + 1) + (xcd - r) * q) + off; }
        const int nig = WGM * nN, gid = wgid / nig, fm = gid * WGM, gsz = (nM - fm) < WGM ? (nM - fm) : WGM;
        u.pm = fm + ((wgid % nig) % gsz); u.pn = (wgid % nig) / gsz; return true;
    }
    __device__ __forceinline__ void a_ready(const Unit&) const {}
    __device__ __forceinline__ void done(const Unit&) const {}
};
__device__ __forceinline__ unsigned cvt_pk_bf16(float lo, float hi) { typedef float f32x2_ __attribute__((ext_vector_type(2))); typedef __bf16 bf16x2_ __attribute__((ext_vector_type(2)));
    const f32x2_ v = {lo, hi}; return __builtin_bit_cast(unsigned, __builtin_convertvector(v, bf16x2_)); }
__device__ __forceinline__ float fast_sigmoid(float x) { return __builtin_amdgcn_rcpf(1.0f + __builtin_amdgcn_exp2f(-1.4426950408889634f * x)); }
__device__ __forceinline__ float fast_silu(float x) { return x * fast_sigmoid(x); }
__device__ __forceinline__ f32x4 silu4(f32x4 v) { return (f32x4){fast_silu(v[0]), fast_silu(v[1]), fast_silu(v[2]), fast_silu(v[3])}; }
__device__ __forceinline__ f32x4 sigm4(f32x4 v) { return (f32x4){fast_sigmoid(v[0]), fast_sigmoid(v[1]), fast_sigmoid(v[2]), fast_sigmoid(v[3])}; }
__device__ __forceinline__ u32x4 pack8(f32x4 v0, f32x4 v1) { u32x4 w; w.x = cvt_pk_bf16(v0[0], v0[1]); w.y = cvt_pk_bf16(v0[2], v0[3]); w.z = cvt_pk_bf16(v1[0], v1[1]); w.w = cvt_pk_bf16(v1[2], v1[3]); return w; }
__device__ __forceinline__ void unpack8(u32x4 w, f32x4& v0, f32x4& v1) {
    v0 = (f32x4){__uint_as_float(w.x << 16), __uint_as_float(w.x & 0xffff0000u), __uint_as_float(w.y << 16), __uint_as_float(w.y & 0xffff0000u)};
    v1 = (f32x4){__uint_as_float(w.z << 16), __uint_as_float(w.z & 0xffff0000u), __uint_as_float(w.w << 16), __uint_as_float(w.w & 0xffff0000u)}; }

__device__ __forceinline__ float row_rstd(const float* ssq, int row) {
    const f32x4 a = *(const f32x4*)(ssq + (size_t)row * 16), b = *(const f32x4*)(ssq + (size_t)row * 16 + 4), c = *(const f32x4*)(ssq + (size_t)row * 16 + 8), d = *(const f32x4*)(ssq + (size_t)row * 16 + 12);
    const float s = ((a[0] + a[1]) + (a[2] + a[3])) + ((b[0] + b[1]) + (b[2] + b[3])) + (((c[0] + c[1]) + (c[2] + c[3])) + ((d[0] + d[1]) + (d[2] + d[3])));
    return __builtin_amdgcn_rsqf(s * (1.0f / 1024.0f) + 1e-6f); }
__device__ __forceinline__ unsigned f8x4(float a, float b, float c, float d) {
    a = __builtin_fminf(__builtin_fmaxf(a, -448.f), 448.f); b = __builtin_fminf(__builtin_fmaxf(b, -448.f), 448.f); c = __builtin_fminf(__builtin_fmaxf(c, -448.f), 448.f); d = __builtin_fminf(__builtin_fmaxf(d, -448.f), 448.f);
    unsigned w = 0u; w = __builtin_amdgcn_cvt_pk_fp8_f32(a, b, w, false); w = __builtin_amdgcn_cvt_pk_fp8_f32(c, d, w, true); return w; }
constexpr float W8_SCALE = 64.f;
constexpr float H8_SCALE = 8.f;
template <bool OUT8, bool CS = false> struct EpiGlu {
    static constexpr bool PERM = true, AFTER_DRAIN = false, PREFETCH = true;
    bf16_t* O; int ldo; const float* rstd; const float* bw; int bw_bstride; PG8_LAS float* tbl; const float* cf;
    __device__ __forceinline__ void prefetch(const Unit& u, int par, int wid, int lane) const {
        if (wid < 4) {
            const float* rp = rstd + (size_t)u.pm * BM + 64 * wid + lane;
            const float* bp = bw + (size_t)((u.pm * BM) >> 13) * bw_bstride + u.pn * BM + 64 * wid + lane;
            __builtin_amdgcn_global_load_lds((const unsigned*)rp, (PG8_LAS unsigned*)(tbl + par * 768 + 64 * wid), 4, 0, 0);
            __builtin_amdgcn_global_load_lds((const unsigned*)bp, (PG8_LAS unsigned*)(tbl + par * 768 + 256 + 64 * wid), 4, 0, 0);
            if constexpr (CS) __builtin_amdgcn_global_load_lds((const unsigned*)(cf + (size_t)u.pn * BM + 64 * wid + lane), (PG8_LAS unsigned*)(tbl + par * 768 + 512 + 64 * wid), 4, 0, 0);
        }
    }
    __device__ __forceinline__ void run(const f32x4 (&acc)[2][2][4][2], const Unit& u, int par, int wr, int wc, int fr, int fq) const {
        const int row0 = u.pm * BM + wr * 64 + fr, cl = wc * 32 + 8 * fq, col0 = u.pn * HALF + cl;
        const PG8_LAS float* tr = tbl + par * 768 + wr * 64 + fr; const PG8_LAS float* tb = tbl + par * 768 + 256 + cl;
        const f32x4 ba0 = *(const PG8_LAS f32x4*)tb, ba1 = *(const PG8_LAS f32x4*)(tb + 4), bb0 = *(const PG8_LAS f32x4*)(tb + HALF), bb1 = *(const PG8_LAS f32x4*)(tb + HALF + 4);
        f32x4 ca0 = {1.f, 1.f, 1.f, 1.f}, ca1 = ca0, cb0 = ca0, cb1 = ca0;
        if constexpr (CS) { ca0 = *(const PG8_LAS f32x4*)(tb + 256); ca1 = *(const PG8_LAS f32x4*)(tb + 256 + 4); cb0 = *(const PG8_LAS f32x4*)(tb + 256 + HALF); cb1 = *(const PG8_LAS f32x4*)(tb + 256 + HALF + 4); }
#pragma unroll
        for (int ai = 0; ai < 2; ++ai)
#pragma unroll
            for (int m = 0; m < 4; ++m) { const int row = row0 + ai * HALF + m * 16; const float rr = tr[ai * HALF + m * 16]; bf16_t* rowp = O + (size_t)row * ldo + col0;
                f32x4 h0, h1;
                if constexpr (CS) { h0 = silu4(acc[ai][0][m][0] * (ca0 * rr) + ba0) * (acc[ai][1][m][0] * (cb0 * rr) + bb0); h1 = silu4(acc[ai][0][m][1] * (ca1 * rr) + ba1) * (acc[ai][1][m][1] * (cb1 * rr) + bb1); }
                else { h0 = silu4(acc[ai][0][m][0] * rr + ba0) * (acc[ai][1][m][0] * rr + bb0); h1 = silu4(acc[ai][0][m][1] * rr + ba1) * (acc[ai][1][m][1] * rr + bb1); }
                if constexpr (OUT8) { typedef unsigned u32x2_ __attribute__((ext_vector_type(2))); const f32x4 g0 = h0 * H8_SCALE, g1 = h1 * H8_SCALE;
                    *(u32x2_*)((unsigned char*)O + (size_t)row * ldo + col0) = (u32x2_){f8x4(g0[0], g0[1], g0[2], g0[3]), f8x4(g1[0], g1[1], g1[2], g1[3])}; }
                else *(u32x4*)rowp = pack8(h0, h1); }
    }
};
template <bool BASE_F32> struct EpiRes {
    static constexpr bool PERM = true, AFTER_DRAIN = false, PREFETCH = false;
    const void* base; bf16_t* hout; bf16_t* aout; const float* gate; int gate_bstride; float scale; const float* cw; float* ssq;
    __device__ __forceinline__ void operator()(const f32x4 (&acc)[2][2][4][2], const Unit& u, int wr, int wc, int fr, int fq) const {
        const int row0 = u.pm * BM + wr * 64 + fr, col0 = u.pn * BM + wc * 32 + 8 * fq, b = (u.pm * BM) >> 13;
        f32x4 gv[2][2], cv[2][2];
#pragma unroll
        for (int bj = 0; bj < 2; ++bj)
#pragma unroll
            for (int n = 0; n < 2; ++n) { gv[bj][n] = *(const f32x4*)(gate + (size_t)b * gate_bstride + col0 + bj * HALF + 4 * n);
                cv[bj][n] = aout ? *(const f32x4*)(cw + b * 1024 + col0 + bj * HALF + 4 * n) : (f32x4){0.f, 0.f, 0.f, 0.f}; }
        asm volatile("" ::: "memory");
        constexpr int AHEAD = BASE_F32 ? 3 : 4;
        f32x4 pf[BASE_F32 ? AHEAD : 1][2][2]; u32x4 pb[BASE_F32 ? 1 : AHEAD][2];
#define EPIRES_LOAD(slot, grp) do { const size_t off_ = (size_t)(row0 + ((grp) >> 2) * HALF + ((grp) & 3) * 16) * 1024 + col0; \
            if (BASE_F32) { _Pragma("unroll") for (int bj = 0; bj < 2; ++bj) _Pragma("unroll") for (int n = 0; n < 2; ++n) pf[BASE_F32 ? (slot) : 0][bj][n] = *(const f32x4*)((const float*)base + off_ + bj * HALF + 4 * n); } \
            else { _Pragma("unroll") for (int bj = 0; bj < 2; ++bj) pb[BASE_F32 ? 0 : (slot)][bj] = *(const u32x4*)((const bf16_t*)base + off_ + bj * HALF); } } while (0)
#pragma unroll
        for (int grp = 0; grp < AHEAD; ++grp) EPIRES_LOAD(grp, grp);
#pragma unroll
        for (int grp = 0; grp < 8; ++grp) { const int ai = grp >> 2, m = grp & 3, slot = grp % AHEAD, row = row0 + ai * HALF + m * 16; const size_t off = (size_t)row * 1024 + col0;
            float ss = 0.f;
#pragma unroll
            for (int bj = 0; bj < 2; ++bj) { f32x4 b0, b1;
                if (BASE_F32) { b0 = pf[BASE_F32 ? slot : 0][bj][0]; b1 = pf[BASE_F32 ? slot : 0][bj][1]; } else unpack8(pb[BASE_F32 ? 0 : slot][bj], b0, b1);
                const f32x4 h0 = b0 + (gv[bj][0] * scale) * acc[ai][bj][m][0], h1 = b1 + (gv[bj][1] * scale) * acc[ai][bj][m][1];
                ss += (h0[0] * h0[0] + h0[1] * h0[1]) + (h0[2] * h0[2] + h0[3] * h0[3]) + (h1[0] * h1[0] + h1[1] * h1[1]) + (h1[2] * h1[2] + h1[3] * h1[3]);
                *(u32x4*)(hout + off + bj * HALF) = pack8(h0, h1);
                if (aout) *(u32x4*)(aout + off + bj * HALF) = pack8(h0 * cv[bj][0], h1 * cv[bj][1]); }
            ss += __shfl_xor(ss, 16); ss += __shfl_xor(ss, 32);
            if (fq == 0) ssq[(size_t)row * 16 + u.pn * 4 + wc] = ss;
            if (grp + AHEAD < 8) { asm volatile("" ::: "memory"); EPIRES_LOAD(slot, grp + AHEAD); } }
#undef EPIRES_LOAD
    }
};
struct EpiIn1 {
    static constexpr bool PERM = true, AFTER_DRAIN = false, PREFETCH = false;
    bf16_t* CV; bf16_t* CAB; bf16_t* QKV; size_t qkv_stride; float* BA; int pn_split, pn_add;
    __device__ __forceinline__ void operator()(const f32x4 (&acc)[2][2][4][2], const Unit& u, int wr, int wc, int fr, int fq) const {
        const int row0 = u.pm * BM + wr * 64 + fr, cl = wc * 32 + 8 * fq; const int pn = (u.pn < pn_split) ? u.pn : u.pn + pn_add;
        if (pn < 4) {
#pragma unroll
            for (int ai = 0; ai < 2; ++ai)
#pragma unroll
                for (int m = 0; m < 4; ++m) { bf16_t* rowp = CV + (size_t)(row0 + ai * HALF + m * 16) * 512 + pn * HALF + cl;
                    *(u32x4*)rowp = pack8(acc[ai][0][m][0] * acc[ai][1][m][0], acc[ai][0][m][1] * acc[ai][1][m][1]); }
        } else {
            bf16_t* base; int ld, colt;
            if (pn < 6) { base = CAB; ld = 512; colt = (pn - 4) * BM; } else { const int t = pn - 6; base = QKV + (size_t)(t >> 2) * qkv_stride; ld = 1024; colt = (t & 3) * BM; }
#pragma unroll
            for (int ai = 0; ai < 2; ++ai)
#pragma unroll
                for (int m = 0; m < 4; ++m) { bf16_t* rowp = base + (size_t)(row0 + ai * HALF + m * 16) * ld + colt + cl;
#pragma unroll
                    for (int bj = 0; bj < 2; ++bj) *(u32x4*)(rowp + bj * HALF) = pack8(acc[ai][bj][m][0], acc[ai][bj][m][1]); }
        }
    }
};
struct EpiIn1Q {
    static constexpr bool PERM = true, AFTER_DRAIN = false, PREFETCH = true;
    bf16_t* CV; bf16_t* CAB; bf16_t* QKV; size_t qkv_stride; const float* rs; const float* cf; PG8_LAS float* tbl; int pn_split, pn_add;
    __device__ __forceinline__ void prefetch(const Unit& u, int par, int wid, int lane) const {
        if (wid < 4) {
            __builtin_amdgcn_global_load_lds((const unsigned*)(rs + (size_t)u.pm * BM + 64 * wid + lane), (PG8_LAS unsigned*)(tbl + par * 768 + 64 * wid), 4, 0, 0);
            __builtin_amdgcn_global_load_lds((const unsigned*)(cf + (size_t)u.pn * BM + 64 * wid + lane), (PG8_LAS unsigned*)(tbl + par * 768 + 512 + 64 * wid), 4, 0, 0);
        }
    }
    __device__ __forceinline__ void run(const f32x4 (&acc)[2][2][4][2], const Unit& u, int par, int wr, int wc, int fr, int fq) const {
        const int row0 = u.pm * BM + wr * 64 + fr, cl = wc * 32 + 8 * fq; const int pn = (u.pn < pn_split) ? u.pn : u.pn + pn_add;
        const PG8_LAS float* tr = tbl + par * 768 + wr * 64 + fr; const PG8_LAS float* tc = tbl + par * 768 + 512 + cl;
        const f32x4 ca0 = *(const PG8_LAS f32x4*)tc, ca1 = *(const PG8_LAS f32x4*)(tc + 4), cb0 = *(const PG8_LAS f32x4*)(tc + HALF), cb1 = *(const PG8_LAS f32x4*)(tc + HALF + 4);
        if (pn < 4) {
#pragma unroll
            for (int ai = 0; ai < 2; ++ai)
#pragma unroll
                for (int m = 0; m < 4; ++m) { const float rr = tr[ai * HALF + m * 16]; bf16_t* rowp = CV + (size_t)(row0 + ai * HALF + m * 16) * 512 + pn * HALF + cl;
                    *(u32x4*)rowp = pack8((acc[ai][0][m][0] * (ca0 * rr)) * (acc[ai][1][m][0] * (cb0 * rr)), (acc[ai][0][m][1] * (ca1 * rr)) * (acc[ai][1][m][1] * (cb1 * rr))); }
        } else {
            bf16_t* base; int ld, colt;
            if (pn < 6) { base = CAB; ld = 512; colt = (pn - 4) * BM; } else { const int t = pn - 6; base = QKV + (size_t)(t >> 2) * qkv_stride; ld = 1024; colt = (t & 3) * BM; }
#pragma unroll
            for (int ai = 0; ai < 2; ++ai)
#pragma unroll
                for (int m = 0; m < 4; ++m) { const float rr = tr[ai * HALF + m * 16]; bf16_t* rowp = base + (size_t)(row0 + ai * HALF + m * 16) * ld + colt + cl;
                    *(u32x4*)rowp = pack8(acc[ai][0][m][0] * (ca0 * rr), acc[ai][0][m][1] * (ca1 * rr));
                    *(u32x4*)(rowp + HALF) = pack8(acc[ai][1][m][0] * (cb0 * rr), acc[ai][1][m][1] * (cb1 * rr)); }
        }
    }
};
struct EpiIn2 {
    static constexpr bool PERM = true, AFTER_DRAIN = false, PREFETCH = false;
    bf16_t* YB; bf16_t* SGA; bf16_t* SGB;
    __device__ __forceinline__ void operator()(const f32x4 (&acc)[2][2][4][2], const Unit& u, int wr, int wc, int fr, int fq) const {
        const int row0 = u.pm * BM + wr * 64 + fr, cl = wc * 32 + 8 * fq; const int pn = u.pn;
        long doff = (long)(SGA - YB); if (pn >= 8) doff = (long)(SGB - YB); if (pn < 4) doff = 0; bf16_t* base = YB + doff; const int colt = (pn & 3) * BM;
#pragma unroll
        for (int ai = 0; ai < 2; ++ai)
#pragma unroll
            for (int m = 0; m < 4; ++m) { bf16_t* rowp = base + (size_t)(row0 + ai * HALF + m * 16) * 1024 + colt + cl;
#pragma unroll
                for (int bj = 0; bj < 2; ++bj) {
                    if (pn < 4) { f32x4 o0, o1; unpack8(*(const u32x4*)(rowp + bj * HALF), o0, o1);
                        *(u32x4*)(rowp + bj * HALF) = pack8(o0 * silu4(acc[ai][bj][m][0]), o1 * silu4(acc[ai][bj][m][1])); }
                    else *(u32x4*)(rowp + bj * HALF) = pack8(sigm4(acc[ai][bj][m][0]), sigm4(acc[ai][bj][m][1])); } }
    }
};
struct EpiIn2Q {
    static constexpr bool PERM = true, AFTER_DRAIN = false, PREFETCH = true;
    bf16_t* YB; bf16_t* SGA; bf16_t* SGB; const float* rs; const float* cf; PG8_LAS float* tbl;
    __device__ __forceinline__ void prefetch(const Unit& u, int par, int wid, int lane) const {
        if (wid < 4) {
            __builtin_amdgcn_global_load_lds((const unsigned*)(rs + (size_t)u.pm * BM + 64 * wid + lane), (PG8_LAS unsigned*)(tbl + par * 768 + 64 * wid), 4, 0, 0);
            __builtin_amdgcn_global_load_lds((const unsigned*)(cf + (size_t)u.pn * BM + 64 * wid + lane), (PG8_LAS unsigned*)(tbl + par * 768 + 512 + 64 * wid), 4, 0, 0);
        }
    }
    __device__ __forceinline__ void run(const f32x4 (&acc)[2][2][4][2], const Unit& u, int par, int wr, int wc, int fr, int fq) const {
        const int row0 = u.pm * BM + wr * 64 + fr, cl = wc * 32 + 8 * fq; const int pn = u.pn;
        long doff = (long)(SGA - YB); if (pn >= 8) doff = (long)(SGB - YB); if (pn < 4) doff = 0; bf16_t* base = YB + doff; const int colt = (pn & 3) * BM;
        const PG8_LAS float* tr = tbl + par * 768 + wr * 64 + fr; const PG8_LAS float* tc = tbl + par * 768 + 512 + cl;
        f32x4 cs[2][2]; cs[0][0] = *(const PG8_LAS f32x4*)tc; cs[0][1] = *(const PG8_LAS f32x4*)(tc + 4); cs[1][0] = *(const PG8_LAS f32x4*)(tc + HALF); cs[1][1] = *(const PG8_LAS f32x4*)(tc + HALF + 4);
#pragma unroll
        for (int ai = 0; ai < 2; ++ai)
#pragma unroll
            for (int m = 0; m < 4; ++m) { const float rr = tr[ai * HALF + m * 16]; bf16_t* rowp = base + (size_t)(row0 + ai * HALF + m * 16) * 1024 + colt + cl;
#pragma unroll
                for (int bj = 0; bj < 2; ++bj) { const f32x4 z0 = acc[ai][bj][m][0] * (cs[bj][0] * rr), z1 = acc[ai][bj][m][1] * (cs[bj][1] * rr);
                    if (pn < 4) { f32x4 o0, o1; unpack8(*(const u32x4*)(rowp + bj * HALF), o0, o1);
                        *(u32x4*)(rowp + bj * HALF) = pack8(o0 * silu4(z0), o1 * silu4(z1)); }
                    else *(u32x4*)(rowp + bj * HALF) = pack8(sigm4(z0), sigm4(z1)); } }
    }
};
struct EpiMul {
    static constexpr bool PERM = true, AFTER_DRAIN = false, PREFETCH = false;
    bf16_t* T;
    __device__ __forceinline__ void operator()(const f32x4 (&acc)[2][2][4][2], const Unit& u, int wr, int wc, int fr, int fq) const {
        const int row0 = u.pm * BM + wr * 64 + fr, col0 = u.pn * BM + wc * 32 + 8 * fq;
        u32x4 tv[4][2];
#define EPIMUL_LOAD(slot, grp) do { _Pragma("unroll") for (int bj = 0; bj < 2; ++bj) tv[slot][bj] = *(const u32x4*)(T + (size_t)(row0 + ((grp) >> 2) * HALF + ((grp) & 3) * 16) * 1024 + col0 + bj * HALF); } while (0)
#pragma unroll
        for (int grp = 0; grp < 4; ++grp) EPIMUL_LOAD(grp, grp);
#pragma unroll
        for (int grp = 0; grp < 8; ++grp) { const int ai = grp >> 2, m = grp & 3, slot = grp & 3; bf16_t* rowp = T + (size_t)(row0 + ai * HALF + m * 16) * 1024 + col0;
#pragma unroll
            for (int bj = 0; bj < 2; ++bj) { f32x4 o0, o1; unpack8(tv[slot][bj], o0, o1);
                *(u32x4*)(rowp + bj * HALF) = pack8(o0 * acc[ai][bj][m][0], o1 * acc[ai][bj][m][1]); }
            if (grp + 4 < 8) { asm volatile("" ::: "memory"); EPIMUL_LOAD(slot, grp + 4); } }
#undef EPIMUL_LOAD
    }
};
struct EpiMerge {
    static constexpr bool PERM = true, AFTER_DRAIN = false, PREFETCH = false;
    const bf16_t* T; bf16_t* G;
    __device__ __forceinline__ void operator()(const f32x4 (&acc)[2][2][4][2], const Unit& u, int wr, int wc, int fr, int fq) const {
        const int row0 = u.pm * BM + wr * 64 + fr, col0 = u.pn * BM + wc * 32 + 8 * fq;
        u32x4 tv[4][2], gvv[4][2];
#define EPIMERGE_LOAD(slot, grp) do { const size_t off_ = (size_t)(row0 + ((grp) >> 2) * HALF + ((grp) & 3) * 16) * 1024 + col0; \
            _Pragma("unroll") for (int bj = 0; bj < 2; ++bj) { tv[slot][bj] = *(const u32x4*)(T + off_ + bj * HALF); gvv[slot][bj] = *(const u32x4*)(G + off_ + bj * HALF); } } while (0)
#pragma unroll
        for (int grp = 0; grp < 4; ++grp) EPIMERGE_LOAD(grp, grp);
#pragma unroll
        for (int grp = 0; grp < 8; ++grp) { const int ai = grp >> 2, m = grp & 3, slot = grp & 3; const size_t off = (size_t)(row0 + ai * HALF + m * 16) * 1024 + col0;
#pragma unroll
            for (int bj = 0; bj < 2; ++bj) { f32x4 t0, t1, g0, g1; unpack8(tv[slot][bj], t0, t1); unpack8(gvv[slot][bj], g0, g1);
                *(u32x4*)(G + off + bj * HALF) = pack8(t0 + g0 * acc[ai][bj][m][0], t1 + g1 * acc[ai][bj][m][1]); }
            if (grp + 4 < 8) { asm volatile("" ::: "memory"); EPIMERGE_LOAD(slot, grp + 4); } }
#undef EPIMERGE_LOAD
    }
};
typedef int i32x8 __attribute__((ext_vector_type(8)));
typedef int i32x4 __attribute__((ext_vector_type(4)));
template <class Epi, class Sched, bool ALIGN_EPI = false, bool SP2 = false, int QMODE = 0>
__device__ __forceinline__ void gemm_phase(PG8_LAS unsigned char* lds, const Gemm g, const Sched& S, const Epi& E) {
    const int tid = threadIdx.x, wid = __builtin_amdgcn_readfirstlane(tid >> 6), lane = tid & 63, wr = wid >> 2, wc = wid & 3, fr = lane & 15, fq = lane >> 4;
    const int K = g.K, nt = K / BK;
    constexpr bool FP8 = (QMODE == 1), I8 = (QMODE == 2);
    int f8sc = 0x7f7f7f7f; asm volatile("" : "+v"(f8sc)); (void)f8sc;
    unsigned voffA[2], voffB[2];
#pragma unroll
    for (int i = 0; i < 2; ++i) { int R, C; stage_rc(tid * 16 + i * 8192, R, C); const int Rb = Epi::PERM ? ((R & ~31) + perm32(R & 31)) : R;
        voffA[i] = (unsigned)(R * K + C) * 2u; voffB[i] = (unsigned)(Rb * K + C) * 2u; }
    const size_t kstep = (size_t)(BK * 2);
    const size_t hstep = (size_t)HALF * K * 2;
    const size_t tstep = 2 * hstep;
    const unsigned ldsw = (unsigned)wid * 1024u;
    const int aoff = lds_byte(wr * 64 + fr, fq * 8), boff = lds_byte(wc * 32 + fr, fq * 8);
#define PG8_SA(b, h) (((b) * 2 + (h)) * HTB)
#define PG8_SB(b, h) ((4 + (b) * 2 + (h)) * HTB)
#define PG8_STAGE(bufoff, gbase, voff) do { _Pragma("unroll") for (int _i = 0; _i < 2; ++_i) \
        __builtin_amdgcn_global_load_lds((const unsigned*)((const char*)(gbase) + (voff)[_i]), (PG8_LAS unsigned*)(lds + (bufoff) + ldsw + _i * 8192), 16, 0, 0); } while (0)
#define PG8_LDA(dst, b, h) do { _Pragma("unroll") for (int m = 0; m < 4; ++m) { dst[m].lo = *(const PG8_LAS i32x4*)(lds + PG8_SA(b, h) + aoff + m * 2048); dst[m].hi = *(const PG8_LAS i32x4*)(lds + PG8_SA(b, h) + aoff + m * 2048 + 1024); } } while (0)
#define PG8_LDB(dst, b, h) do { _Pragma("unroll") for (int n = 0; n < 2; ++n) { dst[n].lo = *(const PG8_LAS i32x4*)(lds + PG8_SB(b, h) + boff + n * 2048); dst[n].hi = *(const PG8_LAS i32x4*)(lds + PG8_SB(b, h) + boff + n * 2048 + 1024); } } while (0)
#define PG8_MMA(ai, bj, At, Bt) do { __builtin_amdgcn_s_setprio(1); _Pragma("unroll") for (int m = 0; m < 4; ++m) _Pragma("unroll") for (int n = 0; n < 2; ++n) { \
        if constexpr (FP8) asm volatile("v_mfma_scale_f32_16x16x128_f8f6f4 %0, %1, %2, %0, %3, %3 op_sel_hi:[0,0,0]" : "+v"(acc[ai][bj][m][n]) : "v"(Bt[n]), "v"(At[m]), "v"(f8sc));   \
        else if constexpr (I8) { const i32x4 bl_ = Bt[n].lo, bh_ = Bt[n].hi, al_ = At[m].lo, ah_ = At[m].hi; i32x4 c_ = __builtin_bit_cast(i32x4, acc[ai][bj][m][n]); \
               c_ = __builtin_amdgcn_mfma_i32_16x16x64_i8(bl_, al_, c_, 0, 0, 0); c_ = __builtin_amdgcn_mfma_i32_16x16x64_i8(bh_, ah_, c_, 0, 0, 0); acc[ai][bj][m][n] = __builtin_bit_cast(f32x4, c_); } \
        else { const i32x4 bl_ = Bt[n].lo, bh_ = Bt[n].hi, al_ = At[m].lo, ah_ = At[m].hi;        \
               acc[ai][bj][m][n] = __builtin_amdgcn_mfma_f32_16x16x32_bf16(__builtin_bit_cast(bf16x8, bl_), __builtin_bit_cast(bf16x8, al_), acc[ai][bj][m][n], 0, 0, 0); \
               acc[ai][bj][m][n] = __builtin_amdgcn_mfma_f32_16x16x32_bf16(__builtin_bit_cast(bf16x8, bh_), __builtin_bit_cast(bf16x8, ah_), acc[ai][bj][m][n], 0, 0, 0); } } \
        __builtin_amdgcn_s_setprio(0); } while (0)
#define PG8_WAIT_V(n) asm volatile("s_waitcnt vmcnt(" #n ")" ::: "memory")
#define PG8_WAIT_L(n) asm volatile("s_waitcnt lgkmcnt(" #n ")" ::: "memory")
#define PG8_BAR __builtin_amdgcn_s_barrier()
#define PG8_SCHED __builtin_amdgcn_sched_barrier(0)
    Unit cur, nxt; int ui = 0;
    if (!S.next(0, cur)) return;
    if constexpr (Epi::PREFETCH) E.prefetch(cur, 0, wid, lane);
    f32x4 acc[2][2][4][2];
#pragma unroll
    for (int a = 0; a < 2; ++a)
#pragma unroll
        for (int b = 0; b < 2; ++b)
#pragma unroll
            for (int m = 0; m < 4; ++m)
#pragma unroll
                for (int n = 0; n < 2; ++n) acc[a][b][m][n] = (f32x4){0.f, 0.f, 0.f, 0.f};
    i32x8 At[4], B0[2], B1[2];
    const char* cA = (const char*)g.A + (size_t)cur.pm * tstep; const char* cB = (const char*)g.Bt + (size_t)cur.pn * tstep;
    S.a_ready(cur);
    if constexpr (SP2) {
        PG8_STAGE(PG8_SB(0, 0), cB, voffB); PG8_STAGE(PG8_SB(0, 1), cB + hstep, voffB); PG8_STAGE(PG8_SA(0, 0), cA, voffA); PG8_STAGE(PG8_SA(0, 1), cA + hstep, voffA);
        if (wr == 1) PG8_BAR;
        PG8_WAIT_V(2); PG8_BAR;
        PG8_STAGE(PG8_SB(1, 0), cB + kstep, voffB); PG8_STAGE(PG8_SA(1, 0), cA + kstep, voffA); PG8_STAGE(PG8_SB(1, 1), cB + hstep + kstep, voffB);
        PG8_WAIT_V(6); PG8_BAR;
    } else {
        PG8_STAGE(PG8_SB(0, 0), cB, voffB); PG8_STAGE(PG8_SA(0, 0), cA, voffA); PG8_STAGE(PG8_SB(0, 1), cB + hstep, voffB); PG8_STAGE(PG8_SA(0, 1), cA + hstep, voffA);
        if (wr == 1) PG8_BAR;
        PG8_WAIT_V(4); PG8_BAR;
        PG8_STAGE(PG8_SB(1, 0), cB + kstep, voffB); PG8_STAGE(PG8_SA(1, 0), cA + kstep, voffA); PG8_STAGE(PG8_SB(1, 1), cB + hstep + kstep, voffB);
        PG8_WAIT_V(6); PG8_BAR;
    }
    for (;;) {
        const bool has_next = S.next(ui + 1, nxt);
        const char* nA = has_next ? (const char*)g.A + (size_t)nxt.pm * tstep : cA; const char* nB = has_next ? (const char*)g.Bt + (size_t)nxt.pn * tstep : cB;
#pragma unroll 1
        for (int t = 0; t < nt; t += 2) {
            const bool last = (t == nt - 2);
            const char* a1 = cA + (size_t)(t + 1) * kstep;
            const char* a2 = last ? nA : cA + (size_t)(t + 2) * kstep; const char* b2 = last ? nB : cB + (size_t)(t + 2) * kstep;
            const char* a3 = a2 + kstep; const char* b3 = b2 + kstep;
            if (last && has_next) S.a_ready(nxt);
            if constexpr (SP2) {
            PG8_LDB(B0, 0, 0); PG8_LDB(B1, 0, 1); PG8_SCHED; PG8_LDA(At, 0, 0); PG8_STAGE(PG8_SA(1, 1), a1 + hstep, voffA);
            PG8_WAIT_V(8); PG8_WAIT_L(0); PG8_BAR; PG8_MMA(0, 0, At, B0); PG8_MMA(0, 1, At, B1); PG8_BAR; PG8_SCHED;
            PG8_LDA(At, 0, 1); PG8_STAGE(PG8_SB(0, 0), b2, voffB); PG8_STAGE(PG8_SB(0, 1), b2 + hstep, voffB); PG8_STAGE(PG8_SA(0, 0), a2, voffA);
            PG8_WAIT_V(8); PG8_WAIT_L(0); PG8_BAR; PG8_MMA(1, 0, At, B0); PG8_MMA(1, 1, At, B1); PG8_BAR; PG8_SCHED;
            PG8_LDB(B0, 1, 0); PG8_LDB(B1, 1, 1); PG8_SCHED; PG8_LDA(At, 1, 0); PG8_STAGE(PG8_SA(0, 1), a2 + hstep, voffA);
            PG8_WAIT_V(8); PG8_WAIT_L(0); PG8_BAR; PG8_MMA(0, 0, At, B0); PG8_MMA(0, 1, At, B1); PG8_BAR; PG8_SCHED;
            PG8_LDA(At, 1, 1); PG8_STAGE(PG8_SB(1, 0), b3, voffB); PG8_STAGE(PG8_SB(1, 1), b3 + hstep, voffB); PG8_STAGE(PG8_SA(1, 0), a3, voffA);
            PG8_WAIT_V(8); PG8_WAIT_L(0); PG8_BAR; PG8_MMA(1, 0, At, B0); PG8_MMA(1, 1, At, B1); PG8_BAR; PG8_SCHED;
            } else {
            PG8_LDB(B0, 0, 0); PG8_SCHED; PG8_LDA(At, 0, 0); PG8_STAGE(PG8_SA(1, 1), a1 + hstep, voffA);
            PG8_WAIT_L(8); PG8_BAR; PG8_WAIT_L(0); PG8_MMA(0, 0, At, B0); PG8_BAR; PG8_SCHED;
            PG8_LDB(B1, 0, 1); PG8_STAGE(PG8_SB(0, 0), b2, voffB);
            PG8_BAR; PG8_WAIT_L(0); PG8_MMA(0, 1, At, B1); PG8_BAR;
            PG8_LDA(At, 0, 1); PG8_STAGE(PG8_SA(0, 0), a2, voffA);
            PG8_BAR; PG8_WAIT_L(0); PG8_MMA(1, 0, At, B0); PG8_BAR; PG8_SCHED;
            PG8_STAGE(PG8_SB(0, 1), b2 + hstep, voffB);
            PG8_WAIT_V(6); PG8_BAR; PG8_MMA(1, 1, At, B1); PG8_BAR;
            PG8_LDB(B0, 1, 0); PG8_SCHED; PG8_LDA(At, 1, 0); PG8_STAGE(PG8_SA(0, 1), a2 + hstep, voffA);
            PG8_WAIT_L(8); PG8_BAR; PG8_WAIT_L(0); PG8_MMA(0, 0, At, B0); PG8_BAR; PG8_SCHED;
            PG8_LDB(B1, 1, 1); PG8_STAGE(PG8_SB(1, 0), b3, voffB);
            PG8_BAR; PG8_WAIT_L(0); PG8_MMA(0, 1, At, B1); PG8_BAR;
            PG8_LDA(At, 1, 1); PG8_STAGE(PG8_SA(1, 0), a3, voffA);
            PG8_BAR; PG8_WAIT_L(0); PG8_MMA(1, 0, At, B0); PG8_BAR; PG8_SCHED;
            PG8_STAGE(PG8_SB(1, 1), b3 + hstep, voffB);
            PG8_WAIT_V(6); PG8_BAR; PG8_MMA(1, 1, At, B1); PG8_BAR;
            }
        }
        if constexpr (ALIGN_EPI) { if (wr == 0) PG8_BAR; }
        if constexpr (I8) {
_Pragma("unroll") for (int a_ = 0; a_ < 2; ++a_) _Pragma("unroll") for (int b_ = 0; b_ < 2; ++b_) _Pragma("unroll") for (int m_ = 0; m_ < 4; ++m_) _Pragma("unroll") for (int n_ = 0; n_ < 2; ++n_)
                acc[a_][b_][m_][n_] = __builtin_convertvector(__builtin_bit_cast(i32x4, acc[a_][b_][m_][n_]), f32x4); }
        if constexpr (FP8) asm volatile("s_nop 15\n\ts_nop 15" ::: "memory");
        if constexpr (Epi::PREFETCH) { int le = (int)threadIdx.x; asm volatile("" : "+v"(le)); le &= 63;
            E.run(acc, cur, ui & 1, wr, wc, le & 15, le >> 4); S.done(cur); }
        else if constexpr (!Epi::AFTER_DRAIN) { E(acc, cur, wr, wc, fr, fq); S.done(cur); }
        if (!has_next) break;
#pragma unroll
        for (int a = 0; a < 2; ++a)
#pragma unroll
            for (int b = 0; b < 2; ++b)
#pragma unroll
                for (int m = 0; m < 4; ++m)
#pragma unroll
                    for (int n = 0; n < 2; ++n) acc[a][b][m][n] = (f32x4){0.f, 0.f, 0.f, 0.f};
        cur = nxt; cA = nA; cB = nB; ++ui;
        if constexpr (Epi::PREFETCH) { int lp = (int)threadIdx.x; asm volatile("" : "+v"(lp)); E.prefetch(cur, ui & 1, wid, lp & 63); }
        if constexpr (ALIGN_EPI) { if (wr == 1) PG8_BAR; }
    }
    PG8_WAIT_V(0);
    if constexpr (!ALIGN_EPI) { if (wr == 0) PG8_BAR; }
    PG8_BAR;
    if constexpr (Epi::AFTER_DRAIN) { E.fused(acc, cur, wr, wc, fr, fq, lds, wid, lane); S.done(cur); }
#undef PG8_SA
#undef PG8_SB
#undef PG8_STAGE
#undef PG8_LDA
#undef PG8_LDB
#undef PG8_MMA
#undef PG8_WAIT_V
#undef PG8_WAIT_L
#undef PG8_BAR
#undef PG8_SCHED
}
}
#define PG8_SP2 true
#define PG8_ALIGN true
#define GAS __attribute__((address_space(1)))
#define LAS __attribute__((address_space(3)))
typedef unsigned short bf16;
typedef unsigned v4u __attribute__((ext_vector_type(4)));
typedef float f32x4 __attribute__((ext_vector_type(4)));
typedef short bf16x8 __attribute__((ext_vector_type(8)));
typedef GAS unsigned gu32;
typedef GAS unsigned long long gu64;
#define RLX_AGENT __ATOMIC_RELAXED, __HIP_MEMORY_SCOPE_AGENT
#define LDS_WAIT() asm volatile("s_waitcnt lgkmcnt(0)" ::: "memory")
#define VM_WAIT() asm volatile("s_waitcnt vmcnt(0)" ::: "memory")
__device__ __forceinline__ unsigned long long rt() { return __builtin_amdgcn_s_memrealtime(); }
__device__ __forceinline__ unsigned pk2(float lo, float hi) { typedef float f32x2_ __attribute__((ext_vector_type(2))); typedef __bf16 bf16x2_ __attribute__((ext_vector_type(2)));
    const f32x2_ v = {lo, hi}; return __builtin_bit_cast(unsigned, __builtin_convertvector(v, bf16x2_)); }
__device__ __forceinline__ unsigned f2bf(float f) { return pk2(f, 0.f) & 0xffffu; }
#define XB_TMO      128
#define XB_XCNT(j)  (256  + 64 * (j))
#define XB_XSUB(j)  (1280 + 64 * (j))
#define XB_XGEN(j)  (2304 + 64 * (j))
#define XB_TOP      3328
#define XB_TOPGEN   3392
#define XCD_BAR_WORDS 3456
#define XB_SPIN_CAP (1u << 18)

__device__ __forceinline__ unsigned xb_ld(unsigned* p)              { return __hip_atomic_load(p, __ATOMIC_RELAXED, __HIP_MEMORY_SCOPE_AGENT); }
__device__ __forceinline__ unsigned xb_add(unsigned* p, unsigned v) { return __hip_atomic_fetch_add(p, v, __ATOMIC_RELAXED, __HIP_MEMORY_SCOPE_AGENT); }
__device__ __forceinline__ unsigned xb_xcc_id() { return (unsigned)__builtin_amdgcn_s_getreg((3 << 11) | 20) & 0xFu; }
#define XB_SPIN(cond, bar) do { unsigned _sp = 0; while (cond) { __builtin_amdgcn_s_sleep(1); \
    if ((++_sp & 255u) == 0u) { if (xb_ld(&(bar)[XB_TMO])) break; if (_sp > XB_SPIN_CAP) { atomicAdd(&(bar)[XB_TMO], 1u); break; } } } } while (0)

struct XcdBarrier {
    unsigned* bar; unsigned x;
    volatile LAS unsigned* st;
};

__device__ __forceinline__ XcdBarrier xcd_barrier_post(unsigned* bar, volatile LAS unsigned* st) {
    XcdBarrier b; b.bar = bar; b.x = xb_xcc_id(); b.st = st;
    if (threadIdx.x == 0) (void)xb_add(&bar[XB_XCNT(b.x)], 1u);
    return b;
}
__device__ __forceinline__ void xcd_barrier_complete(unsigned* bar, unsigned x, unsigned& nloc, unsigned& nx) {
    const unsigned G = gridDim.x * gridDim.y * gridDim.z;
    unsigned sum, cnt, mine, sp = 0u;
    for (;;) {
        sum = 0u; cnt = 0u; mine = 0u;
#pragma unroll
        for (unsigned j = 0; j < 16; ++j) { const unsigned c = xb_ld(&bar[XB_XCNT(j)]); sum += c; cnt += (c > 0u) ? 1u : 0u; mine = (j == x) ? c : mine; }
        if (sum == G) break;
        __builtin_amdgcn_s_sleep(1);
        if ((++sp & 255u) == 0u) { if (xb_ld(&bar[XB_TMO])) break; if (sp > XB_SPIN_CAP) { atomicAdd(&bar[XB_TMO], 1u); break; } }
    }
    nloc = mine > 0u ? mine : 1u; nx = cnt > 0u ? cnt : 1u;
}

__device__ __forceinline__ void xcd_barrier(const XcdBarrier& b) {
    asm volatile("s_waitcnt vmcnt(0)" ::: "memory");
    __syncthreads();
    if (threadIdx.x == 0) {
        unsigned* bar = b.bar;
        __builtin_amdgcn_s_waitcnt(0);
        unsigned nloc = b.st[0], nx = b.st[1];
        if (nloc == 0u) { xcd_barrier_complete(bar, b.x, nloc, nx); b.st[0] = nloc; b.st[1] = nx; }
        const unsigned old = xb_add(&bar[XB_XSUB(b.x)], 1u);
        const unsigned gen = old / nloc;
        if (old + 1u == (gen + 1u) * nloc) {
            __builtin_amdgcn_fence(__ATOMIC_RELEASE, "agent");
            asm volatile("s_waitcnt vmcnt(0)" ::: "memory");
            const unsigned og = xb_add(&bar[XB_TOP], 1u);
            const unsigned tg = og / nx;
            if (og + 1u == (tg + 1u) * nx) xb_add(&bar[XB_TOPGEN], 1u);
            else XB_SPIN(xb_ld(&bar[XB_TOPGEN]) == tg, bar);
            __builtin_amdgcn_fence(__ATOMIC_ACQUIRE, "agent");
            xb_add(&bar[XB_XGEN(b.x)], 1u);
            asm volatile("s_waitcnt vmcnt(0)" ::: "memory");
        } else {
            XB_SPIN(xb_ld(&bar[XB_XGEN(b.x)]) == gen, bar);
            __builtin_amdgcn_fence(__ATOMIC_ACQUIRE, "agent");
            asm volatile("s_waitcnt vmcnt(0)" ::: "memory");
        }
    }
    __syncthreads();
}

constexpr int NWAVES = 8;
constexpr int BATCH = 4, SEQ = 8192, D = 1024, M = BATCH * SEQ, FF = 2816, NH = 8, DK = 128, DV = 128;
constexpr int IN_COLS = 7712, NMOD = 9;
constexpr int N_IN1 = 18 * 256, N_IN2 = 12 * 256;
constexpr float EPS = 1e-6f;
#ifndef MK_SPLIT
#define MK_SPLIT 0
#endif
constexpr int NPHASE = 19;

constexpr size_t MiB = 1u << 20;
constexpr size_t WS_CTL = 0, CTL_ZERO_BYTES = 64 * 1024;
constexpr size_t WS_MOD = 256 * 1024;
constexpr size_t WS_WUP1 = 1 * MiB, WS_WDN1 = 12 * MiB, WS_WUP2 = 18 * MiB, WS_WDN2 = 29 * MiB, WS_WIN1 = 35 * MiB, WS_WIN2 = 45 * MiB, WS_WA = 51 * MiB, WS_WB = 52 * MiB, WS_WO = 54 * MiB;
constexpr size_t WS_XN = 64 * MiB;
constexpr size_t WS_HID = 128 * MiB;
constexpr size_t WS_QRAW = 128 * MiB, WS_KRAW = 192 * MiB, WS_VRAW = 256 * MiB;
constexpr size_t WS_CAB = 320 * MiB, WS_CV = 352 * MiB;
constexpr size_t WS_QF = 384 * MiB;
constexpr size_t WS_YA = 448 * MiB;
constexpr size_t WS_BA = 480 * MiB;
constexpr size_t WS_GB = 484 * MiB;
constexpr size_t WS_SSQ = 56 * MiB;
constexpr size_t WS_BW = 17 * MiB + 512 * 1024;
constexpr size_t BW_UP1 = 0, BW_IN1 = 96 * 1024, BW_IN2 = 176 * 1024, BW_UP2 = 224 * 1024;
constexpr size_t WS_CW = 34 * MiB + 512 * 1024;
constexpr size_t WS_HB2 = 304 * MiB, WS_HB3 = 384 * MiB;
constexpr size_t WS_WDN1F8 = 488 * MiB;
constexpr size_t WS_WUP1I8 = 491 * MiB, WS_WUP2I8 = 497 * MiB;
constexpr size_t WS_CF = 503 * MiB;
constexpr size_t WS_WIN2I8 = 504 * MiB;
constexpr size_t WS_CF3 = 507 * MiB, WS_RSX = 507 * MiB + 512 * 1024;
constexpr size_t WS_WIN1I8 = 508 * MiB, WS_CF2 = 507 * MiB + 64 * 1024;
constexpr size_t WS_END = 511 * MiB;
constexpr size_t WS_KF = WS_QRAW, WS_VF = WS_KRAW;
constexpr size_t WS_OF = WS_VRAW, WS_OB = WS_CAB;
constexpr size_t WS_SGA = WS_QF, WS_SGB = WS_QRAW;
static_assert(WS_WUP1 + (size_t)2 * FF * D * 2 <= WS_WDN1 && WS_WDN1 + (size_t)D * FF * 2 <= WS_WUP2 && WS_WIN1 + (size_t)N_IN1 * D * 2 <= WS_WIN2 && WS_WIN2 + (size_t)N_IN2 * D * 2 <= WS_WA && WS_WO + 2 * MiB <= WS_XN, "weights map");
static_assert(WS_HID + (size_t)M * FF * 2 <= WS_CAB + 64 * MiB && WS_GB + (size_t)4 * M * 8 * 4 <= WS_END, "activation map");

constexpr int RING_OFF = 0, RING_BYTES = 131072;
constexpr int LDS_BYTES = 163840;
constexpr int LDSCTL_OFF = LDS_BYTES - 512, MISC_OFF = LDSCTL_OFF + 320;

struct Args { const float* in[23]; float* out; unsigned char* ws; int ph_lo, ph_hi; };
enum { I_X = 0, I_C, I_WADA, I_BADA, I_NF1, I_WUP1, I_WDN1, I_NMIX, I_WIN, I_CONVA, I_CONVDN, I_ALF, I_DTF, I_ALB, I_DTB, I_DNNORM, I_WAO, I_WBO, I_WOUT, I_NF2, I_WUP2, I_WDN2, I_NFIN };

template <int CTRL, int ROW_MASK = 0xf> __device__ __forceinline__ float dpp_add(float v) {
    return v + __builtin_bit_cast(float, __builtin_amdgcn_update_dpp(0, __builtin_bit_cast(int, v), CTRL, ROW_MASK, 0xf, false)); }
__device__ __forceinline__ float sum16(float v) {
    v = dpp_add<0x128>(v); v = dpp_add<0x124>(v); v = dpp_add<0x122>(v); v = dpp_add<0x121>(v);
    return v;
}
__device__ __forceinline__ float wave_sum(float v) {
    v = sum16(v);
    return (__builtin_bit_cast(float, __builtin_amdgcn_readlane(__builtin_bit_cast(int, v), 0)) + __builtin_bit_cast(float, __builtin_amdgcn_readlane(__builtin_bit_cast(int, v), 16)))
      + (__builtin_bit_cast(float, __builtin_amdgcn_readlane(__builtin_bit_cast(int, v), 32)) + __builtin_bit_cast(float, __builtin_amdgcn_readlane(__builtin_bit_cast(int, v), 48)));
}
template <int CTRL> __device__ __forceinline__ float dpp_max(float v) { return __builtin_fmaxf(v, __builtin_bit_cast(float, __builtin_amdgcn_update_dpp(__builtin_bit_cast(int, v), __builtin_bit_cast(int, v), CTRL, 0xf, 0xf, false))); }
__device__ __forceinline__ float wave_max(float v) {
    v = dpp_max<0x128>(v); v = dpp_max<0x124>(v); v = dpp_max<0x122>(v); v = dpp_max<0x121>(v);
    return __builtin_fmaxf(__builtin_fmaxf(__builtin_bit_cast(float, __builtin_amdgcn_readlane(__builtin_bit_cast(int, v), 0)), __builtin_bit_cast(float, __builtin_amdgcn_readlane(__builtin_bit_cast(int, v), 16))),
                           __builtin_fmaxf(__builtin_bit_cast(float, __builtin_amdgcn_readlane(__builtin_bit_cast(int, v), 32)), __builtin_bit_cast(float, __builtin_amdgcn_readlane(__builtin_bit_cast(int, v), 48))));
}
__device__ __forceinline__ unsigned i8x4(float a, float b, float c, float d) {
    const int qa = (int)__builtin_rintf(a), qb = (int)__builtin_rintf(b), qc = (int)__builtin_rintf(c), qd = (int)__builtin_rintf(d);
    return ((unsigned)qa & 0xffu) | (((unsigned)qb & 0xffu) << 8) | (((unsigned)qc & 0xffu) << 16) | ((unsigned)qd << 24); }
__device__ __forceinline__ float bf2f(unsigned short b) { return __uint_as_float((unsigned)b << 16); }
__device__ __forceinline__ void unpack8f(v4u w, float* f) {
    f[0] = __uint_as_float(w.x << 16); f[1] = __uint_as_float(w.x & 0xffff0000u); f[2] = __uint_as_float(w.y << 16); f[3] = __uint_as_float(w.y & 0xffff0000u);
    f[4] = __uint_as_float(w.z << 16); f[5] = __uint_as_float(w.z & 0xffff0000u); f[6] = __uint_as_float(w.w << 16); f[7] = __uint_as_float(w.w & 0xffff0000u); }
__device__ __forceinline__ v4u pack8f(const float* f) { v4u w; w.x = pk2(f[0], f[1]); w.y = pk2(f[2], f[3]); w.z = pk2(f[4], f[5]); w.w = pk2(f[6], f[7]); return w; }
__device__ __forceinline__ float sigmoidf_(float x) { return __builtin_amdgcn_rcpf(1.0f + __expf(-x)); }
__device__ __forceinline__ float siluf_(float x) { return x * __builtin_amdgcn_rcpf(1.0f + __expf(-x)); }

using pg8::f8x4; using pg8::W8_SCALE; using pg8::H8_SCALE;
__device__ __forceinline__ void transpose_item(const float* W, int N, int K, bf16* dst0  , int k0, int n0, LAS float* scr, int lane, unsigned char* dst8 = nullptr  ) {
#pragma unroll 8
    for (int i = 0; i < 32; ++i) { const int kk = 2 * i + (lane >> 5); scr[kk * 33 + (lane & 31)] = W[(size_t)(k0 + kk) * N + n0 + (lane & 31)]; }
    LDS_WAIT(); asm volatile("" ::: "memory");
    const int c = lane & 7;
#pragma unroll
    for (int j = 0; j < 4; ++j) { const int n = (lane >> 3) + 8 * j; const LAS float* s = scr + (8 * c) * 33 + n;
        v4u o; o.x = pk2(s[0 * 33], s[1 * 33]); o.y = pk2(s[2 * 33], s[3 * 33]); o.z = pk2(s[4 * 33], s[5 * 33]); o.w = pk2(s[6 * 33], s[7 * 33]);
        *(GAS v4u*)(dst0 + (size_t)n * K + k0 + 8 * c) = o;
        if (dst8) { typedef unsigned u32x2_ __attribute__((ext_vector_type(2)));
            *(GAS u32x2_*)(dst8 + (size_t)n * K + k0 + 8 * c) = (u32x2_){f8x4(W8_SCALE * s[0 * 33], W8_SCALE * s[1 * 33], W8_SCALE * s[2 * 33], W8_SCALE * s[3 * 33]), f8x4(W8_SCALE * s[4 * 33], W8_SCALE * s[5 * 33], W8_SCALE * s[6 * 33], W8_SCALE * s[7 * 33])}; } }
    LDS_WAIT(); asm volatile("" ::: "memory");
}
__device__ __forceinline__ int up_row(int n0) { const int part = n0 / FF, j = n0 % FF; return 256 * (j / 128) + 128 * part + (j % 128); }

__device__ __forceinline__ void phase_prologue(const Args& a, LAS unsigned char* lds, int tid, int lane, int wave) {
    unsigned char* ws = a.ws;
    LAS float* cact = (LAS float*)lds;
    LAS float* red = (LAS float*)(lds + 16384);
    for (int i = tid; i < 4096; i += 512) cact[i] = siluf_(a.in[I_C][i]);
    __syncthreads();
    float* mod = (float*)(ws + WS_MOD);
    for (int it = blockIdx.x; it < (NMOD * D) / 32; it += gridDim.x) {
        const int n0 = it * 32, col = tid & 31, kg = tid >> 5;
        float a0 = 0.f, a1 = 0.f, a2 = 0.f, a3 = 0.f;
        const float* wp = a.in[I_WADA] + (size_t)(kg * 64) * (NMOD * D) + n0 + col;
#pragma unroll 8
        for (int kk = 0; kk < 64; ++kk) { const float w = wp[(size_t)kk * (NMOD * D)]; const int k = kg * 64 + kk;
            a0 += cact[k] * w; a1 += cact[1024 + k] * w; a2 += cact[2048 + k] * w; a3 += cact[3072 + k] * w; }
        red[(kg * 4 + 0) * 32 + col] = a0; red[(kg * 4 + 1) * 32 + col] = a1; red[(kg * 4 + 2) * 32 + col] = a2; red[(kg * 4 + 3) * 32 + col] = a3;
        __syncthreads();
        if (tid < 128) { const int b = tid >> 5, c2 = tid & 31; float s = 0.f;
#pragma unroll
            for (int g = 0; g < 16; ++g) s += red[(g * 4 + b) * 32 + c2];
            mod[b * (NMOD * D) + n0 + c2] = s + a.in[I_BADA][n0 + c2]; }
        __syncthreads();
    }
    __syncthreads();
    LAS float* scr = (LAS float*)(lds + wave * 16384);
    const int gw = blockIdx.x * NWAVES + wave, NGW = gridDim.x * NWAVES;
    constexpr int I_UP = (D / 64) * (2 * FF / 32), I_DN = (FF / 64) * (D / 32), I_IN = (D / 64) * (IN_COLS / 32), I_A = (512 / 64) * (D / 32), I_B = (D / 64) * (D / 32);
    constexpr int NITEMS = 2 * I_UP + 2 * I_DN + I_IN + I_A + 2 * I_B;
    for (int it = gw; it < NITEMS; it += NGW) {
        int r = it;
        if (r < 2 * I_UP) { const int wsel = r / I_UP; r %= I_UP; const int nblk = 2 * FF / 32, kb = r / nblk, nb = r % nblk;
            const float* W = a.in[wsel ? I_WUP2 : I_WUP1]; bf16* dst = (bf16*)(ws + (wsel ? WS_WUP2 : WS_WUP1));
            transpose_item(W, 2 * FF, D, dst + (size_t)up_row(32 * nb) * D, 64 * kb, 32 * nb, scr, lane); continue; }
        r -= 2 * I_UP;
        if (r < 2 * I_DN) { const int wsel = r / I_DN; r %= I_DN; const int nblk = D / 32, kb = r / nblk, nb = r % nblk;
            const float* W = a.in[wsel ? I_WDN2 : I_WDN1]; bf16* dst = (bf16*)(ws + (wsel ? WS_WDN2 : WS_WDN1));
            transpose_item(W, D, FF, dst + (size_t)(32 * nb) * FF, 64 * kb, 32 * nb, scr, lane); continue; }
        r -= 2 * I_DN;
        if (r < I_IN) { const int nblk = IN_COLS / 32, kb = r / nblk, nb = r % nblk, n0 = 32 * nb;
            bf16* dst;
            if (n0 < 512) dst = (bf16*)(ws + WS_WIN1) + (size_t)(1024 + n0) * D;
            else if (n0 < 1024) { const int j = n0 - 512; dst = (bf16*)(ws + WS_WIN1) + (size_t)(256 * (j / 128) + (j % 128)) * D; }
            else if (n0 < 1536) { const int j = n0 - 1024; dst = (bf16*)(ws + WS_WIN1) + (size_t)(256 * (j / 128) + 128 + (j % 128)) * D; }
            else if (n0 < 4608) dst = (bf16*)(ws + WS_WIN1) + (size_t)n0 * D;
            else if (n0 < 5632) dst = (bf16*)(ws + WS_WIN2) + (size_t)(n0 - 4608) * D;
            else if (n0 < 5664) dst = (bf16*)(ws + WS_WIN1) + (size_t)(4608 + n0 - 5632) * D;
            else dst = (bf16*)(ws + WS_WIN2) + (size_t)(1024 + n0 - 5664) * D;
            transpose_item(a.in[I_WIN], IN_COLS, D, dst, 64 * kb, n0, scr, lane); continue; }
        r -= I_IN;
        if (r < I_A) { const int nblk = D / 32, kb = r / nblk, nb = r % nblk; transpose_item(a.in[I_WAO], D, 512, (bf16*)(ws + WS_WA) + (size_t)(32 * nb) * 512, 64 * kb, 32 * nb, scr, lane); continue; }
        r -= I_A;
        { const int wsel = r / I_B; r %= I_B; const int nblk = D / 32, kb = r / nblk, nb = r % nblk;
          transpose_item(a.in[wsel ? I_WOUT : I_WBO], D, D, (bf16*)(ws + (wsel ? WS_WO : WS_WB)) + (size_t)(32 * nb) * D, 64 * kb, 32 * nb, scr, lane); }
    }
}

__device__ __forceinline__ void phase_first(const Args& a, const float* mod, bf16* dst, int tid, int lane, int wave) {
    unsigned char* ws = a.ws;
    const int gw = blockIdx.x * NWAVES + wave, NGW = gridDim.x * NWAVES;
    float* ssq0 = (float*)(ws + WS_SSQ);
    const float* nw = a.in[I_NF1];
    for (int m0 = gw; m0 < M; m0 += 4 * NGW) {
        f32x4 v[4][4];
#pragma unroll
        for (int q = 0; q < 4; ++q) { const int mq = (m0 + q * NGW < M) ? m0 + q * NGW : m0; const GAS f32x4* xr = (const GAS f32x4*)(a.in[I_X] + (size_t)mq * D) + lane;
#pragma unroll
            for (int j = 0; j < 4; ++j) v[q][j] = xr[64 * j]; }
#pragma unroll
        for (int q = 0; q < 4; ++q) { const int m = m0 + q * NGW; if (m >= M) break; const int b = m / SEQ; const float* sc = mod + b * (NMOD * D) + 1 * D; float s = 0.f;
#pragma unroll
            for (int j = 0; j < 4; ++j) s += (v[q][j].x * v[q][j].x + v[q][j].y * v[q][j].y) + (v[q][j].z * v[q][j].z + v[q][j].w * v[q][j].w);
            s = wave_sum(s);
            f32x4 y[4]; float amax = 1e-30f;
#pragma unroll
            for (int j = 0; j < 4; ++j) { const int c = 4 * lane + 256 * j; const f32x4 w = *(const f32x4*)(nw + c), s1 = *(const f32x4*)(sc + c);
                y[j] = v[q][j] * w * (s1 + 1.0f);
                amax = __builtin_fmaxf(__builtin_fmaxf(amax, __builtin_fmaxf(__builtin_fabsf(y[j].x), __builtin_fabsf(y[j].y))), __builtin_fmaxf(__builtin_fabsf(y[j].z), __builtin_fabsf(y[j].w))); }
            amax = wave_max(amax);
            const float qs = 127.f * __builtin_amdgcn_rcpf(amax);
            if (lane == 0) ssq0[m] = __builtin_amdgcn_rsqf(s * (1.f / D) + EPS) * amax * (1.f / 127.f);
            GAS unsigned* o4 = (GAS unsigned*)((unsigned char*)dst + (size_t)m * D) + lane;
#pragma unroll
            for (int j = 0; j < 4; ++j) o4[64 * j] = i8x4(y[j].x * qs, y[j].y * qs, y[j].z * qs, y[j].w * qs); }
    }
    for (int it = gw; it < 2 * (2 * FF / 4); it += NGW) {
        const int sel = it >= 2 * FF / 4, r0 = 4 * (sel ? it - 2 * FF / 4 : it);
        const bf16* W = (const bf16*)(ws + (sel ? WS_WUP2 : WS_WUP1)); float* out = (float*)(ws + WS_BW + (sel ? BW_UP2 : BW_UP1)); const int shi = sel ? 6 : 0;
        v4u wr_[4][2];
#pragma unroll
        for (int q = 0; q < 4; ++q) { wr_[q][0] = *(const GAS v4u*)(W + (size_t)(r0 + q) * D + 16 * lane); wr_[q][1] = *(const GAS v4u*)(W + (size_t)(r0 + q) * D + 16 * lane + 8); }
        f32x4 shv[4][4];
#pragma unroll
        for (int b = 0; b < 4; ++b)
#pragma unroll
            for (int e = 0; e < 4; ++e) shv[b][e] = *(const f32x4*)(mod + b * (NMOD * D) + shi * D + 16 * lane + 4 * e);
#pragma unroll
        for (int q = 0; q < 4; ++q) { float wv[16]; unpack8f(wr_[q][0], wv); unpack8f(wr_[q][1], wv + 8); float acc[4];
#pragma unroll
            for (int b = 0; b < 4; ++b) { float s = 0.f;
#pragma unroll
                for (int e = 0; e < 4; ++e) s += (wv[4 * e] * shv[b][e].x + wv[4 * e + 1] * shv[b][e].y) + (wv[4 * e + 2] * shv[b][e].z + wv[4 * e + 3] * shv[b][e].w);
                acc[b] = wave_sum(s); }
            if (lane < 4) out[(size_t)lane * (2 * FF) + r0 + q] = (lane == 0) ? acc[0] : (lane == 1) ? acc[1] : (lane == 2) ? acc[2] : acc[3];
            float amax = 1e-30f;
#pragma unroll
            for (int e = 0; e < 16; ++e) amax = __builtin_fmaxf(amax, __builtin_fabsf(wv[e]));
            amax = wave_max(amax);
            const float qs = 127.f * __builtin_amdgcn_rcpf(amax);
            v4u o; o.x = i8x4(wv[0] * qs, wv[1] * qs, wv[2] * qs, wv[3] * qs); o.y = i8x4(wv[4] * qs, wv[5] * qs, wv[6] * qs, wv[7] * qs);
            o.z = i8x4(wv[8] * qs, wv[9] * qs, wv[10] * qs, wv[11] * qs); o.w = i8x4(wv[12] * qs, wv[13] * qs, wv[14] * qs, wv[15] * qs);
            *(GAS v4u*)(ws + (sel ? WS_WUP2I8 : WS_WUP1I8) + (size_t)(r0 + q) * D + 16 * lane) = o;
            if (lane == 0) ((float*)(ws + WS_CF))[sel * (2 * FF) + r0 + q] = amax * (1.f / 127.f); }
    }
    for (int r = gw; r < 3072; r += NGW) {
        const bf16* W = (const bf16*)(ws + WS_WIN1) + (size_t)(r + 1536) * D + 16 * lane;
        const v4u w0 = *(const GAS v4u*)W, w1 = *(const GAS v4u*)(W + 8);
        float wv[16]; unpack8f(w0, wv); unpack8f(w1, wv + 8);
        float amax = 1e-30f;
#pragma unroll
        for (int e = 0; e < 16; ++e) amax = __builtin_fmaxf(amax, __builtin_fabsf(wv[e]));
        amax = wave_max(amax);
        const float qs = 127.f * __builtin_amdgcn_rcpf(amax);
        v4u o; o.x = i8x4(wv[0] * qs, wv[1] * qs, wv[2] * qs, wv[3] * qs); o.y = i8x4(wv[4] * qs, wv[5] * qs, wv[6] * qs, wv[7] * qs);
        o.z = i8x4(wv[8] * qs, wv[9] * qs, wv[10] * qs, wv[11] * qs); o.w = i8x4(wv[12] * qs, wv[13] * qs, wv[14] * qs, wv[15] * qs);
        *(GAS v4u*)(ws + WS_WIN1I8 + (size_t)r * D + 16 * lane) = o;
        if (lane == 0) ((float*)(ws + WS_CF2))[r] = amax * (1.f / 127.f);
    }
    for (int r = gw; r < N_IN2; r += NGW) {
        const bf16* W = (const bf16*)(ws + WS_WIN2) + (size_t)r * D + 16 * lane;
        const v4u w0 = *(const GAS v4u*)W, w1 = *(const GAS v4u*)(W + 8);
        float wv[16]; unpack8f(w0, wv); unpack8f(w1, wv + 8);
        float amax = 1e-30f;
#pragma unroll
        for (int e = 0; e < 16; ++e) amax = __builtin_fmaxf(amax, __builtin_fabsf(wv[e]));
        amax = wave_max(amax);
        const float qs = 127.f * __builtin_amdgcn_rcpf(amax);
        v4u o; o.x = i8x4(wv[0] * qs, wv[1] * qs, wv[2] * qs, wv[3] * qs); o.y = i8x4(wv[4] * qs, wv[5] * qs, wv[6] * qs, wv[7] * qs);
        o.z = i8x4(wv[8] * qs, wv[9] * qs, wv[10] * qs, wv[11] * qs); o.w = i8x4(wv[12] * qs, wv[13] * qs, wv[14] * qs, wv[15] * qs);
        *(GAS v4u*)(ws + WS_WIN2I8 + (size_t)r * D + 16 * lane) = o;
        if (lane == 0) ((float*)(ws + WS_CF3))[r] = amax * (1.f / 127.f);
    }
    float* cwp = (float*)(ws + WS_CW);
    for (int i = blockIdx.x * 512 + tid; i < 2 * 4 * D; i += gridDim.x * 512) { const int k = i >> 12, b = (i >> 10) & 3, c = i & 1023;
        cwp[i] = a.in[k ? I_NF2 : I_NMIX][c] * (1.0f + mod[b * (NMOD * D) + (k ? 7 : 4) * D + c]); }
}
__device__ __forceinline__ void phase_mix_norm(const bf16* h, const float* ssq, const float* cw, const float* sh, bf16* dst, unsigned char* dst8, float* rsx, int lane, int wave) {
    const int gw = blockIdx.x * NWAVES + wave, NGW = gridDim.x * NWAVES;
    for (int m0 = gw; m0 < M; m0 += 4 * NGW) {
        v4u hv[4][2];
#pragma unroll
        for (int q = 0; q < 4; ++q) { const int mq = (m0 + q * NGW < M) ? m0 + q * NGW : m0; const GAS v4u* hr = (const GAS v4u*)(h + (size_t)mq * D) + lane; hv[q][0] = hr[0]; hv[q][1] = hr[64]; }
#pragma unroll
        for (int q = 0; q < 4; ++q) { const int m = m0 + q * NGW; if (m >= M) break; const int b = m / SEQ; const float rstd = pg8::row_rstd(ssq, m); GAS v4u* orow = (GAS v4u*)(dst + (size_t)m * D) + lane;
            float yy[2][8]; float amax = 1e-30f;
#pragma unroll
            for (int j = 0; j < 2; ++j) { float x[8]; unpack8f(hv[q][j], x); const int c = 8 * lane + 512 * j;
                const f32x4 w0 = *(const f32x4*)(cw + b * 1024 + c), w1 = *(const f32x4*)(cw + b * 1024 + c + 4), s0 = *(const f32x4*)(sh + (size_t)b * (NMOD * D) + c), s1 = *(const f32x4*)(sh + (size_t)b * (NMOD * D) + c + 4);
                float y[8] = {x[0] * rstd * w0.x + s0.x, x[1] * rstd * w0.y + s0.y, x[2] * rstd * w0.z + s0.z, x[3] * rstd * w0.w + s0.w, x[4] * rstd * w1.x + s1.x, x[5] * rstd * w1.y + s1.y, x[6] * rstd * w1.z + s1.z, x[7] * rstd * w1.w + s1.w};
                orow[64 * j] = pack8f(y);
#pragma unroll
                for (int e = 0; e < 8; ++e) { yy[j][e] = y[e]; amax = __builtin_fmaxf(amax, __builtin_fabsf(y[e])); } }
            amax = wave_max(amax);
            const float qs = 127.f * __builtin_amdgcn_rcpf(amax);
            typedef unsigned u32x2_ __attribute__((ext_vector_type(2)));
#pragma unroll
            for (int j = 0; j < 2; ++j) *(GAS u32x2_*)(dst8 + (size_t)m * D + 8 * lane + 512 * j) = (u32x2_){i8x4(yy[j][0] * qs, yy[j][1] * qs, yy[j][2] * qs, yy[j][3] * qs), i8x4(yy[j][4] * qs, yy[j][5] * qs, yy[j][6] * qs, yy[j][7] * qs)};
            if (lane == 0) rsx[m] = amax * (1.f / 127.f); }
    }
}
__device__ __forceinline__ void phase_final_norm(const bf16* h3, const float* ssq, float* out, const float* nw, int lane, int wave) {
    const int gw = blockIdx.x * NWAVES + wave, NGW = gridDim.x * NWAVES;
    for (int m0 = gw; m0 < M; m0 += 4 * NGW) {
        v4u hv[4][2];
#pragma unroll
        for (int q = 0; q < 4; ++q) { const int mq = (m0 + q * NGW < M) ? m0 + q * NGW : m0; const GAS v4u* hr = (const GAS v4u*)(h3 + (size_t)mq * D) + lane; hv[q][0] = hr[0]; hv[q][1] = hr[64]; }
#pragma unroll
        for (int q = 0; q < 4; ++q) { const int m = m0 + q * NGW; if (m >= M) break; const float rstd = pg8::row_rstd(ssq, m); GAS f32x4* orow = (GAS f32x4*)(out + (size_t)m * D);
#pragma unroll
            for (int j = 0; j < 2; ++j) { float x[8]; unpack8f(hv[q][j], x); const int c = 8 * lane + 512 * j;
                const f32x4 w0 = *(const f32x4*)(nw + c), w1 = *(const f32x4*)(nw + c + 4);
                orow[(c >> 2)] = (f32x4){x[0] * rstd * w0.x, x[1] * rstd * w0.y, x[2] * rstd * w0.z, x[3] * rstd * w0.w};
                orow[(c >> 2) + 1] = (f32x4){x[4] * rstd * w1.x, x[5] * rstd * w1.y, x[6] * rstd * w1.z, x[7] * rstd * w1.w}; } }
    }
}
__device__ __forceinline__ void phase_rstd_q(const float* ssq16, float* rstd, const bf16* a16, unsigned char* a8, int lane, int wave) {
    const int gw = blockIdx.x * NWAVES + wave, NGW = gridDim.x * NWAVES;
    for (int m0 = gw; m0 < M; m0 += 4 * NGW) {
        v4u hv[4][2];
#pragma unroll
        for (int q = 0; q < 4; ++q) { const int mq = (m0 + q * NGW < M) ? m0 + q * NGW : m0; const GAS v4u* hr = (const GAS v4u*)(a16 + (size_t)mq * D) + 2 * lane; hv[q][0] = hr[0]; hv[q][1] = hr[1]; }
#pragma unroll
        for (int q = 0; q < 4; ++q) { const int m = m0 + q * NGW; if (m >= M) break;
            float x[16]; unpack8f(hv[q][0], x); unpack8f(hv[q][1], x + 8);
            float amax = 1e-30f;
#pragma unroll
            for (int e = 0; e < 16; ++e) amax = __builtin_fmaxf(amax, __builtin_fabsf(x[e]));
            amax = wave_max(amax);
            const float qs = 127.f * __builtin_amdgcn_rcpf(amax);
            v4u o; o.x = i8x4(x[0] * qs, x[1] * qs, x[2] * qs, x[3] * qs); o.y = i8x4(x[4] * qs, x[5] * qs, x[6] * qs, x[7] * qs);
            o.z = i8x4(x[8] * qs, x[9] * qs, x[10] * qs, x[11] * qs); o.w = i8x4(x[12] * qs, x[13] * qs, x[14] * qs, x[15] * qs);
            *((GAS v4u*)(a8 + (size_t)m * D) + lane) = o;
            if (lane == 0) rstd[m] = pg8::row_rstd(ssq16, m) * amax * (1.f / 127.f); }
    }
}
__device__ __forceinline__ void phase_rstd(const float* ssq16, float* rstd, int tid) {
    for (int m = blockIdx.x * 512 + tid; m < M; m += gridDim.x * 512) rstd[m] = pg8::row_rstd(ssq16, m);
}
__device__ __forceinline__ void phase_conv_qkv(const bf16* src, bf16* dst, const float* cw  , bool do_norm, float scale, int lane, int wave) {
    const int gw = blockIdx.x * NWAVES + wave, NGW = gridDim.x * NWAVES;
    const int c0 = (gw & 1) * 512 + 8 * lane;
    float w[5][8];
#pragma unroll
    for (int i = 0; i < 5; ++i)
#pragma unroll
        for (int e = 0; e < 8; ++e) w[i][e] = cw[i * 3072 + c0 + e];
    for (int it = gw; it < 2 * (M / 32); it += NGW) {
        const int r0 = (it >> 1) * 32, s0 = r0 & (SEQ - 1);
        v4u raw[12];
#define CONV_LOAD(ch_) do { _Pragma("unroll") for (int k = 0; k < 12; ++k) { const int ss = s0 + 8 * (ch_) - 2 + k; raw[k] = (v4u){0u, 0u, 0u, 0u}; \
            if (ss >= 0 && ss < SEQ) raw[k] = *(const GAS v4u*)(src + (size_t)(r0 + 8 * (ch_) - 2 + k) * D + c0); } } while (0)
        CONV_LOAD(0);
#pragma unroll 1
        for (int ch = 0; ch < 4; ++ch) {
            float x[12][8];
#pragma unroll
            for (int k = 0; k < 12; ++k) unpack8f(raw[k], x[k]);
            if (ch < 3) CONV_LOAD(ch + 1);
#pragma unroll
            for (int o = 0; o < 8; ++o) { float acc[8]; float ssq = 0.f;
#pragma unroll
                for (int e = 0; e < 8; ++e) { float t = x[o][e] * w[0][e];
#pragma unroll
                    for (int i = 1; i < 5; ++i) t += x[o + i][e] * w[i][e];
                    t = siluf_(t); acc[e] = t; ssq += t * t; }
                if (do_norm) { const float r = scale * __builtin_amdgcn_rsqf(sum16(ssq) + EPS);
#pragma unroll
                    for (int e = 0; e < 8; ++e) acc[e] *= r; }
                *(GAS v4u*)(dst + (size_t)(r0 + 8 * ch + o) * D + c0) = pack8f(acc); }
        }
#undef CONV_LOAD
    }
}
__device__ __forceinline__ void phase_ya(const bf16* cab, const bf16* cv, const float* cw  , bf16* ya, int lane, int wave) {
    const int gw = blockIdx.x * NWAVES + wave, NGW = gridDim.x * NWAVES, c0 = 8 * lane;
    float w[3][8];
#pragma unroll
    for (int i = 0; i < 3; ++i)
#pragma unroll
        for (int e = 0; e < 8; ++e) w[i][e] = cw[i * 512 + c0 + e];
    for (int it = gw; it < M / 32; it += NGW) {
        const int r0 = it * 32, s0 = r0 & (SEQ - 1);
#pragma unroll 1
        for (int ch = 0; ch < 4; ++ch) {
            float x[10][8]; v4u g[8];
#pragma unroll
            for (int k = 0; k < 10; ++k) { const int ss = s0 + 8 * ch - 1 + k; v4u raw = {0u, 0u, 0u, 0u};
                if (ss >= 0 && ss < SEQ) raw = *(const GAS v4u*)(cv + (size_t)(r0 + 8 * ch - 1 + k) * 512 + c0);
                unpack8f(raw, x[k]); }
#pragma unroll
            for (int o = 0; o < 8; ++o) g[o] = *(const GAS v4u*)(cab + (size_t)(r0 + 8 * ch + o) * 512 + c0);
#pragma unroll
            for (int o = 0; o < 8; ++o) { float acc[8], gf[8]; unpack8f(g[o], gf);
#pragma unroll
                for (int e = 0; e < 8; ++e) acc[e] = (x[o][e] * w[0][e] + x[o + 1][e] * w[1][e] + x[o + 2][e] * w[2][e]) * gf[e];
                *(GAS v4u*)(ya + (size_t)(r0 + 8 * ch + o) * 512 + c0) = pack8f(acc); }
        }
    }
}
__device__ __forceinline__ void phase_ba(const bf16* xn, const bf16* wba, float* ba, int lane, int wave) {
    typedef short bf16x8 __attribute__((ext_vector_type(8)));
    const int gw = blockIdx.x * NWAVES + wave, NGW = gridDim.x * NWAVES, c16 = lane & 15, q4 = lane >> 4;
    for (int it = gw; it < M / 16; it += NGW) {
        const bf16* ap = xn + (size_t)(16 * it + c16) * D + 8 * q4; const bf16* bp0 = wba + (size_t)c16 * D + 8 * q4; const bf16* bp1 = bp0 + (size_t)16 * D;
        f32x4 acc0 = {0.f, 0.f, 0.f, 0.f}, acc1 = {0.f, 0.f, 0.f, 0.f};
#pragma unroll 8
        for (int ks = 0; ks < D / 32; ++ks) {
            const bf16x8 a = *(const bf16x8*)(ap + 32 * ks), b0 = *(const bf16x8*)(bp0 + 32 * ks), b1 = *(const bf16x8*)(bp1 + 32 * ks);
            acc0 = __builtin_amdgcn_mfma_f32_16x16x32_bf16(a, b0, acc0, 0, 0, 0); acc1 = __builtin_amdgcn_mfma_f32_16x16x32_bf16(a, b1, acc1, 0, 0, 0); }
#pragma unroll
        for (int r = 0; r < 4; ++r) { float* o = ba + (size_t)(16 * it + 4 * q4 + r) * 32; o[c16] = acc0[r]; o[16 + c16] = acc1[r]; }
    }
}
__device__ __forceinline__ void phase_gb(const Args& a, const float* ba, float* gb, int tid) {
    for (int i = blockIdx.x * 512 + tid; i < M * 32; i += gridDim.x * 512) {
        const int row = i >> 5, j = i & 31, part = j >> 3, h = j & 7; const float x = ba[i]; float r;
        if (part < 2) r = sigmoidf_(x);
        else { const float al = a.in[part == 2 ? I_ALF : I_ALB][h], dt = a.in[part == 2 ? I_DTF : I_DTB][h]; const float y = x + dt;
            const float sp = y > 20.f ? y : log1pf(__expf(y)); r = -__expf(al) * sp; }
        gb[(size_t)part * M * 8 + (size_t)row * 8 + h] = r;
    }
}
namespace scan {
typedef short bf16x8 __attribute__((ext_vector_type(8)));
typedef short s16x4 __attribute__((ext_vector_type(4)));
typedef float f32x4 __attribute__((ext_vector_type(4)));
typedef unsigned u32x2 __attribute__((ext_vector_type(2)));
typedef unsigned long long u64;
typedef u64 u64x2 __attribute__((ext_vector_type(2)));
typedef __bf16 nbf16x8 __attribute__((ext_vector_type(8)));
typedef __bf16 nbf16x2 __attribute__((ext_vector_type(2)));
typedef float f32x8 __attribute__((ext_vector_type(8)));
typedef float f32x2 __attribute__((ext_vector_type(2)));
constexpr int RS = 288, TS = 144, VSS = 80;
constexpr int KNB = 0, QNB = 55296, VSB = 92160, SCB = 102400;
constexpr int KN_BYTES = 18432, VS_BYTES = 5120, SC_BYTES = 1280;
constexpr int ATTB = 106240, ANEGB = 124672, DMB = 143104, SCAN_LDS_END = 147200;
static_assert(SCAN_LDS_END <= LDSCTL_OFF, "scan LDS");
__device__ __forceinline__ bf16x8 frag2(u64 lo, u64 hi) { return __builtin_bit_cast(bf16x8, (u64x2){lo, hi}); }
__device__ __forceinline__ bf16x8 packB(f32x4 a, f32x4 b) { const f32x8 v = {a[0], a[1], a[2], a[3], b[0], b[1], b[2], b[3]}; return __builtin_bit_cast(bf16x8, __builtin_convertvector(v, nbf16x8)); }
__device__ __forceinline__ bf16x8 packB1(f32x4 a) { const f32x8 v = {a[0], a[1], a[2], a[3], 0.f, 0.f, 0.f, 0.f}; return __builtin_bit_cast(bf16x8, __builtin_convertvector(v, nbf16x8)); }
__device__ __forceinline__ unsigned cvt2(float lo, float hi) { const f32x2 v = {lo, hi}; return __builtin_bit_cast(unsigned, __builtin_convertvector(v, nbf16x2)); }
__device__ __forceinline__ unsigned short cvt1(float x) { return (unsigned short)(cvt2(x, 0.f) & 0xffffu); }
#define MFMA16(a, b, c) __builtin_amdgcn_mfma_f32_16x16x32_bf16((a), (b), (c), 0, 0, 0)
__device__ __forceinline__ bf16x8 ldA1(LAS unsigned char* base, int stride, int c16, int q4, int col0) {
    LAS unsigned char* p = base + c16 * stride + (col0 + 4 * q4) * 2; return frag2(*(LAS u64*)p, 0ull); }
__device__ __forceinline__ bf16x8 ldAtr(LAS unsigned char* tile, int c16, int q4, int row0, int dt) {
    LAS unsigned char* p = tile + (row0 + 4 * q4 + (c16 >> 2)) * RS + (32 * (dt >> 1) + 8 * (c16 & 3) + 4 * (dt & 1)) * 2;
    const s16x4 lo = __builtin_amdgcn_ds_read_tr16_b64_v4i16((LAS s16x4*)p), hi = __builtin_amdgcn_ds_read_tr16_b64_v4i16((LAS s16x4*)(p + 16 * RS));
    return (bf16x8){lo[0], lo[1], lo[2], lo[3], hi[0], hi[1], hi[2], hi[3]}; }
__device__ __forceinline__ bf16x8 ldA16(LAS unsigned char* base, int stride, int c16, int q4, int col0) { return *(LAS bf16x8*)(base + c16 * stride + (col0 + 8 * q4) * 2); }
__device__ __forceinline__ int tpos(int tj, int q4) { return 32 * (tj >> 1) + 8 * q4 + 4 * (tj & 1); }
__device__ __forceinline__ void d_invert(f32x4 at, LAS unsigned char* dmb, int c16, int q4) {
    LAS unsigned char* wp = dmb + c16 * 32 + 8 * q4;
    LAS unsigned char* rp = dmb + (4 * q4 + (c16 >> 2)) * 32 + 8 * (c16 & 3);
    const f32x4 z = {0.f, 0.f, 0.f, 0.f};
    f32x4 nt = -at, pt;
#pragma unroll
    for (int r = 0; r < 4; ++r) pt[r] = nt[r] + ((4 * q4 + r == c16) ? 1.f : 0.f);
#pragma unroll
    for (int k = 0; k < 4; ++k) {
        *(LAS u32x2*)wp = (u32x2){cvt2(nt[0], nt[1]), cvt2(nt[2], nt[3])};
        const s16x4 lo = __builtin_amdgcn_ds_read_tr16_b64_v4i16((LAS s16x4*)rp);
        const bf16x8 aop = (bf16x8){lo[0], lo[1], lo[2], lo[3], 0, 0, 0, 0};
        if (k > 0) pt = MFMA16(aop, packB1(pt), pt);
        if (k < 3) nt = MFMA16(aop, packB1(nt), z);
    }
    *(LAS u32x2*)wp = (u32x2){cvt2(pt[0], pt[1]), cvt2(pt[2], pt[3])};
}
template <int NT> __device__ __forceinline__ void c_tiles(LAS unsigned char* kn, LAS unsigned char* qn, LAS float* scf, LAS unsigned char* att, LAS unsigned char* aneg, f32x4& adiag, int ti, int tj0, int c16, int q4) {
    f32x4 acck[NT], accq[NT];
#pragma unroll
    for (int t = 0; t < NT; ++t) { acck[t] = (f32x4){0.f, 0.f, 0.f, 0.f}; accq[t] = (f32x4){0.f, 0.f, 0.f, 0.f}; }
    bf16x8 fa[2][NT], fk[2], fq[2];
#define C_LOAD(bf_, ks_) do { fk[bf_] = *(LAS bf16x8*)(kn + (16 * ti + c16) * RS + (ks_) * 64 + q4 * 16); fq[bf_] = *(LAS bf16x8*)(qn + (16 * ti + c16) * RS + (ks_) * 64 + q4 * 16); \
        _Pragma("unroll") for (int t = 0; t < NT; ++t) fa[bf_][t] = *(LAS bf16x8*)(kn + (16 * (tj0 + t) + c16) * RS + (ks_) * 64 + q4 * 16); } while (0)
    C_LOAD(0, 0);
#pragma unroll
    for (int ks = 0; ks < 4; ++ks) {
        if (ks == 0) C_LOAD(1, 1); else if (ks == 1) C_LOAD(0, 2); else if (ks == 2) C_LOAD(1, 3);
        __builtin_amdgcn_sched_barrier(0);
#pragma unroll
        for (int t = 0; t < NT; ++t) { acck[t] = MFMA16(fa[ks & 1][t], fk[ks & 1], acck[t]); accq[t] = MFMA16(fa[ks & 1][t], fq[ks & 1], accq[t]); }
        __builtin_amdgcn_sched_barrier(0);
    }
#undef C_LOAD
    const int I = 16 * ti + c16;
    const float gi = scf[I], bi = scf[128 + I];
#pragma unroll
    for (int t = 0; t < NT; ++t) {
        const int tj = tj0 + t, J0 = 16 * tj + 4 * q4;
        const f32x4 gj = *(LAS f32x4*)(scf + J0);
        f32x4 a, tt;
#pragma unroll
        for (int r = 0; r < 4; ++r) { const float dec = __expf(gi - gj[r]);
            a[r] = (I > J0 + r) ? bi * acck[t][r] * dec : 0.f; tt[r] = (I >= J0 + r) ? accq[t][r] * dec : 0.f; }
        *(LAS u32x2*)(att + I * TS + tpos(tj, q4) * 2) = (u32x2){cvt2(tt[0], tt[1]), cvt2(tt[2], tt[3])};
        if (tj == ti) adiag = a;
        else *(LAS u32x2*)(aneg + I * TS + tpos(tj, q4) * 2) = (u32x2){cvt2(-a[0], -a[1]), cvt2(-a[2], -a[3])};
    }
}
__device__ __forceinline__ void e_solve(const f32x4 (&rhs)[4], f32x4 (&X)[4], const bf16x8 (&Df)[4], bf16x8 A10, bf16x8 A2x, bf16x8 A3a, bf16x8 A3b) {
    const f32x4 z = {0.f, 0.f, 0.f, 0.f};
    X[0] = MFMA16(Df[0], packB1(rhs[0]), z);
    f32x4 y = MFMA16(A10, packB1(X[0]), rhs[1]);
    X[1] = MFMA16(Df[1], packB1(y), z);
    const bf16x8 x01 = packB(X[0], X[1]);
    y = MFMA16(A2x, x01, rhs[2]);
    f32x4 y3 = MFMA16(A3a, x01, rhs[3]);
    X[2] = MFMA16(Df[2], packB1(y), z);
    y3 = MFMA16(A3b, packB1(X[2]), y3);
    X[3] = MFMA16(Df[3], packB1(y3), z);
}
__device__ __forceinline__ void phase_scan(const bf16* Q, const bf16* K, const bf16* V, const float* gbuf, bf16* OF, bf16* OB, LAS unsigned char* lds, int tid, int lane, int wave) {
    constexpr int NC = SEQ / 64;
    for (int item = blockIdx.x; item < BATCH * NH * 2 * 4; item += gridDim.x) {
        const int xq = item & 7, yq = item >> 3, ci = xq * 8 + (yq >> 2), sl = yq & 3;
        const int b = ci >> 4, h = (ci >> 1) & 7, dir = ci & 1;
        const float* betap = gbuf + (size_t)dir * M * 8 + h; const float* glp = gbuf + (size_t)(2 + dir) * M * 8 + h; bf16* O = dir ? OB : OF;
        const size_t rowbase = (size_t)b * SEQ;
        __syncthreads();
        for (int i = tid; i < 2 * 9216 / 4; i += 512) ((LAS unsigned*)(lds + ATTB))[i] = 0u;
        v4u kreg[2], qreg[2], vreg = {0u, 0u, 0u, 0u}; float greg = 0.f, breg = 0.f;
#define SCAN_LOAD(n_) do { \
            _Pragma("unroll") for (int r = 0; r < 2; ++r) { const int pi = tid + 512 * r, row = pi >> 4, pc = pi & 15; const int p = 64 * (n_) + row; const int s = dir ? (SEQ - 1 - p) : p; \
                const size_t off = (rowbase + s) * D + h * 128 + pc * 8; kreg[r] = *(const GAS v4u*)(K + off); qreg[r] = *(const GAS v4u*)(Q + off); } \
            if (tid < 256) { const int row = tid >> 2, pc = tid & 3; const int p = 64 * (n_) + row; const int s = dir ? (SEQ - 1 - p) : p; vreg = *(const GAS v4u*)(V + (rowbase + s) * D + h * 128 + sl * 32 + pc * 8); } \
            if (wave == 6) { const int p = 64 * (n_) + lane; const int s = dir ? (SEQ - 1 - p) : p; greg = glp[(rowbase + s) * 8]; breg = betap[(rowbase + s) * 8]; } } while (0)
#define SCAN_STAGE(k3_, p2_) do { LAS unsigned char* knw_ = lds + KNB + (k3_) * KN_BYTES; LAS unsigned char* qnw_ = lds + QNB + (p2_) * KN_BYTES; LAS unsigned char* vsw_ = lds + VSB + (p2_) * VS_BYTES; \
            _Pragma("unroll") for (int r = 0; r < 2; ++r) { const int pi = tid + 512 * r, row = pi >> 4, pc = pi & 15; \
                *(LAS v4u*)(knw_ + row * RS + pc * 16) = kreg[r]; *(LAS v4u*)(qnw_ + row * RS + pc * 16) = qreg[r]; } \
            if (tid < 256) { const int row = tid >> 2, pc = tid & 3; *(LAS v4u*)(vsw_ + row * VSS + pc * 16) = vreg; } \
            if (wave == 6) { float g = greg; LAS float* scw = (LAS float*)(lds + SCB + (k3_) * SC_BYTES); \
                g = dpp_add<0x111>(g); g = dpp_add<0x112>(g); g = dpp_add<0x114>(g); g = dpp_add<0x118>(g);        \
                g = dpp_add<0x142, 0xa>(g); g = dpp_add<0x143, 0xc>(g);                                          \
                const float g63 = __shfl(g, 63), eg = __expf(g); \
                scw[lane] = g; scw[64 + lane] = breg * eg; scw[128 + lane] = breg; scw[192 + lane] = eg; scw[256 + lane] = __expf(g63 - g); } } while (0)
        SCAN_LOAD(0);
        SCAN_STAGE(0, 0);
        SCAN_LOAD(1);
        __syncthreads();
#define SCAN_ITER_PTRS \
            const bool have_prod = (n + 1 < NC), have_cons = (n >= 0), have_stage = (n + 2 < NC); (void)have_prod; (void)have_cons; \
            LAS unsigned char* knc = lds + KNB + k3c * KN_BYTES; LAS unsigned char* knp = lds + KNB + k3p * KN_BYTES;              \
            LAS unsigned char* qnc = lds + QNB + (n & 1) * KN_BYTES; LAS unsigned char* qnp = lds + QNB + ((n + 1) & 1) * KN_BYTES; \
            LAS unsigned char* vsc = lds + VSB + (n & 1) * VS_BYTES; \
            LAS float* scc = (LAS float*)(lds + SCB + k3c * SC_BYTES); LAS float* scp = (LAS float*)(lds + SCB + k3p * SC_BYTES); \
            LAS unsigned char* attc = lds + ATTB + (n & 1) * 9216; LAS unsigned char* attp = lds + ATTB + ((n + 1) & 1) * 9216; \
            LAS unsigned char* anegc = lds + ANEGB + (n & 1) * 9216; LAS unsigned char* anegp = lds + ANEGB + ((n + 1) & 1) * 9216; \
            LAS unsigned char* dmc = lds + DMB + (n & 1) * 2048; LAS unsigned char* dmp = lds + DMB + ((n + 1) & 1) * 2048; \
            (void)knc; (void)knp; (void)qnc; (void)qnp; (void)vsc; (void)scc; (void)scp; (void)attc; (void)attp; (void)anegc; (void)anegp; (void)dmc; (void)dmp; \
            int lane_o = lane; asm volatile("" : "+v"(lane_o)); const int c16 = lane_o & 15, q4 = lane_o >> 4;
#define SCAN_ITER_NEXT do { k3c = k3p; k3p = k3s; k3s = (k3s == 2) ? 0 : k3s + 1; } while (0)
        if (wave < 2) {
            f32x4 S[8];
#pragma unroll
            for (int t = 0; t < 8; ++t) S[t] = (f32x4){0.f, 0.f, 0.f, 0.f};
            int k3c = 2, k3p = 0, k3s = 1;
            for (int n = -1; n < NC; ++n) {
                SCAN_ITER_PTRS
                f32x4 R[4], ao[4], vn[4];
                if (have_cons) {
                    bf16x8 Sb[4];
#pragma unroll
                    for (int ks = 0; ks < 4; ++ks) Sb[ks] = packB(S[2 * ks], S[2 * ks + 1]);
                    bf16x8 kf[2][4], qf[2][4]; f32x4 kbv[2], bev[2]; float egv[2]; s16x4 vraw[2];
                    bf16x8 Df[4], A10, A2x, A3a, A3b;
#define F1_LOAD(bf_, it_) do { _Pragma("unroll") for (int ks = 0; ks < 4; ++ks) { kf[bf_][ks] = ldA16(knc + 16 * (it_) * RS, RS, c16, q4, 32 * ks); qf[bf_][ks] = ldA16(qnc + 16 * (it_) * RS, RS, c16, q4, 32 * ks); } \
                        kbv[bf_] = *(LAS f32x4*)(scc + 64 + 16 * (it_) + 4 * q4); bev[bf_] = *(LAS f32x4*)(scc + 128 + 16 * (it_) + 4 * q4); egv[bf_] = scc[192 + 16 * (it_) + c16]; \
                        vraw[bf_] = __builtin_amdgcn_ds_read_tr16_b64_v4i16((LAS s16x4*)(vsc + (16 * (it_) + 4 * q4 + (c16 >> 2)) * VSS + (16 * wave + 4 * (c16 & 3)) * 2)); } while (0)
                    F1_LOAD(0, 0);
#pragma unroll
                    for (int it = 0; it < 4; ++it) {
                        if (it == 0) F1_LOAD(1, 1); else if (it == 1) F1_LOAD(0, 2); else if (it == 2) F1_LOAD(1, 3);
                        else {
#pragma unroll
                            for (int r = 0; r < 4; ++r) Df[r] = ldA1(dmc + r * 512, 32, c16, q4, 0);
                            A10 = frag2(*(LAS u64*)(anegc + (16 + c16) * TS + tpos(0, q4) * 2), 0ull); A2x = ldA16(anegc + 32 * TS, TS, c16, q4, 0);
                            A3a = ldA16(anegc + 48 * TS, TS, c16, q4, 0); A3b = frag2(*(LAS u64*)(anegc + (48 + c16) * TS + tpos(2, q4) * 2), 0ull); }
                        __builtin_amdgcn_sched_barrier(0);
                        const int bf = it & 1;
                        f32x4 ak = {0.f, 0.f, 0.f, 0.f}, aq = {0.f, 0.f, 0.f, 0.f};
#pragma unroll
                        for (int ks = 0; ks < 4; ++ks) { ak = MFMA16(kf[bf][ks], Sb[ks], ak); aq = MFMA16(Sb[ks], qf[bf][ks], aq); }
                        f32x4 vb;
#pragma unroll
                        for (int rr = 0; rr < 4; ++rr) vb[rr] = bf2f((unsigned short)vraw[bf][rr]) * bev[bf][rr];
                        R[it] = vb - kbv[bf] * ak; ao[it] = aq * egv[bf];
                        __builtin_amdgcn_sched_barrier(0);
                    }
#undef F1_LOAD
                    e_solve(R, vn, Df, A10, A2x, A3a, A3b);
                }
                __syncthreads();
                if (have_stage) SCAN_STAGE(k3s, n & 1);
                if (n + 3 < NC) SCAN_LOAD(n + 3);
                if (have_cons) {
                    const float egl = scc[192 + 63];
                    bf16x8 tf[2][4][2];
#define F2_LOAD(bf_, dt0_) do { _Pragma("unroll") for (int d = 0; d < 4; ++d) _Pragma("unroll") for (int s2 = 0; s2 < 2; ++s2) tf[bf_][d][s2] = ldAtr(knc, c16, q4, 32 * s2, (dt0_) + d); } while (0)
                    F2_LOAD(0, 0);
                    F2_LOAD(1, 4);
                    bf16x8 Vb[2], Vd[2];
#pragma unroll
                    for (int s2 = 0; s2 < 2; ++s2) { const f32x4 e0 = *(LAS f32x4*)(scc + 256 + 32 * s2 + 4 * q4), e1 = *(LAS f32x4*)(scc + 256 + 32 * s2 + 16 + 4 * q4);
                        Vb[s2] = packB(vn[2 * s2], vn[2 * s2 + 1]); Vd[s2] = packB(vn[2 * s2] * e0, vn[2 * s2 + 1] * e1); }
                    __builtin_amdgcn_sched_barrier(0);
#pragma unroll
                    for (int d = 0; d < 4; ++d) { f32x4 a = S[d] * egl;
#pragma unroll
                        for (int s2 = 0; s2 < 2; ++s2) a = MFMA16(tf[0][d][s2], Vd[s2], a);
                        S[d] = a; }
#pragma unroll
                    for (int it = 0; it < 4; ++it)
#pragma unroll
                        for (int s2 = 0; s2 < 2; ++s2) tf[0][it][s2] = ldA16(attc + 16 * it * TS, TS, c16, q4, 32 * s2);
                    __builtin_amdgcn_sched_barrier(0);
#pragma unroll
                    for (int d = 0; d < 4; ++d) { f32x4 a = S[4 + d] * egl;
#pragma unroll
                        for (int s2 = 0; s2 < 2; ++s2) a = MFMA16(tf[1][d][s2], Vd[s2], a);
                        S[4 + d] = a; }
                    __builtin_amdgcn_sched_barrier(0);
#undef F2_LOAD
#pragma unroll
                    for (int it = 0; it < 4; ++it) {
#pragma unroll
                        for (int s2 = 0; s2 < 2; ++s2) ao[it] = MFMA16(Vb[s2], tf[0][it][s2], ao[it]);
                        const int p = 64 * n + 16 * it + c16; const int s = dir ? (SEQ - 1 - p) : p;
                        *(GAS u32x2*)(O + (rowbase + s) * D + h * 128 + sl * 32 + 16 * wave + 4 * q4) = (u32x2){cvt2(ao[it][0], ao[it][1]), cvt2(ao[it][2], ao[it][3])}; }
                }
                SCAN_ITER_NEXT;
                __syncthreads();
            }
        } else {
            int k3c = 2, k3p = 0, k3s = 1;
            for (int n = -1; n < NC; ++n) {
                SCAN_ITER_PTRS
                f32x4 adiag = {0.f, 0.f, 0.f, 0.f};
                const int ti = (wave < 4) ? 3 : (wave == 6 || wave == 5) ? 2 : (wave == 7) ? 1 : 0, tj0 = (wave == 3) ? 2 : (wave == 6) ? 1 : 0;
                if (have_prod) {
                    if (wave != 4 && wave != 5) c_tiles<2>(knp, qnp, scp, attp, anegp, adiag, ti, tj0, c16, q4);
                    else c_tiles<1>(knp, qnp, scp, attp, anegp, adiag, ti, tj0, c16, q4); }
                __syncthreads();
                if (have_stage) SCAN_STAGE(k3s, n & 1);
                if (n + 3 < NC) SCAN_LOAD(n + 3);
                if (have_prod && wave != 2 && wave != 5) d_invert(adiag, dmp + ti * 512, c16, q4);
                SCAN_ITER_NEXT;
                __syncthreads();
            }
        }
#undef SCAN_ITER_PTRS
#undef SCAN_ITER_NEXT
#undef SCAN_LOAD
#undef SCAN_STAGE
    }
}
#undef MFMA16
}

__device__ __forceinline__ void phase_onorm(bf16* of, const bf16* ob, const float* dnw, int lane, int wave) {
    const int gw = blockIdx.x * NWAVES + wave, NGW = gridDim.x * NWAVES, hh = lane >> 4, cp = lane & 15;
    float w[8];
#pragma unroll
    for (int e = 0; e < 8; ++e) w[e] = dnw[8 * cp + e];
    for (int it0 = gw; it0 < M * 2; it0 += 4 * NGW) {
        v4u xa[4], ya[4];
#pragma unroll
        for (int q = 0; q < 4; ++q) { const int it = (it0 + q * NGW < M * 2) ? it0 + q * NGW : it0; const size_t off = (size_t)(it >> 1) * D + (4 * (it & 1) + hh) * 128 + 8 * cp; xa[q] = *(const GAS v4u*)(of + off); ya[q] = *(const GAS v4u*)(ob + off); }
#pragma unroll
        for (int q = 0; q < 4; ++q) { const int it = it0 + q * NGW; if (it >= M * 2) break; const size_t off = (size_t)(it >> 1) * D + (4 * (it & 1) + hh) * 128 + 8 * cp;
            float x[8], y[8]; unpack8f(xa[q], x); unpack8f(ya[q], y);
            float ssq = 0.f;
#pragma unroll
            for (int e = 0; e < 8; ++e) { x[e] += y[e]; ssq += x[e] * x[e]; }
            const float r = __builtin_amdgcn_rsqf(sum16(ssq) * (1.f / 128.f) + EPS);
#pragma unroll
            for (int e = 0; e < 8; ++e) x[e] = x[e] * r * w[e];
            *(GAS v4u*)(of + off) = pack8f(x); }
    }
}

template <class Epi, int QMODE = 0> __device__ __forceinline__ void run_gemm(LAS unsigned char* lds, const bf16* A, const bf16* Bt, int N, int K, const Epi& E) {
    pg8::Gemm g{A, Bt, M, N, K}; pg8::StaticOrder S; S.init(M, N, (int)gridDim.x, (int)blockIdx.x);
    pg8::gemm_phase<Epi, pg8::StaticOrder, true, true, QMODE>(lds, g, S, E);
}

__global__ void __launch_bounds__(NWAVES * 64, 2) mk_fwd(Args args) {
    extern __shared__ __attribute__((aligned(16))) unsigned char lds_raw[];
    LAS unsigned char* lds = (LAS unsigned char*)lds_raw;
    volatile LAS unsigned* MISC = (volatile LAS unsigned*)(lds + MISC_OFF);
    const int tid = threadIdx.x, lane = tid & 63, wave = __builtin_amdgcn_readfirstlane(tid >> 6);
    unsigned char* ws = args.ws;
    for (int u = tid; u < (LDS_BYTES - LDSCTL_OFF) / 4; u += NWAVES * 64) ((LAS unsigned*)(lds + LDSCTL_OFF))[u] = 0u;
    __syncthreads();
    XcdBarrier bar; bar.bar = (unsigned*)(ws + WS_CTL); bar.x = 0; bar.st = nullptr;
    const int lo = args.ph_lo, hi = args.ph_hi;
    if (hi - lo > 1) bar = xcd_barrier_post((unsigned*)(ws + WS_CTL), MISC + 8);
    float* mod = (float*)(ws + WS_MOD);
    bf16* XN = (bf16*)(ws + WS_XN); bf16* HID = (bf16*)(ws + WS_HID);


#define IN(k) (lo <= (k) && (k) < hi)
#define TIDS int tid = threadIdx.x; asm volatile("" : "+v"(tid)); const int lane = tid & 63; const int wave = __builtin_amdgcn_readfirstlane(tid >> 6); (void)lane; (void)wave;
#define SEAM(k) do { if (IN(k) && (k) + 1 < hi) xcd_barrier(bar); } while (0)
    const float* ssqv = (const float*)(ws + WS_SSQ); float* ssqw = (float*)(ws + WS_SSQ);
    bf16* HB1 = (bf16*)args.out; bf16* HB2 = (bf16*)(ws + WS_HB2); bf16* HB3 = (bf16*)(ws + WS_HB3);
    const float* cw2 = (const float*)(ws + WS_CW); const float* cw3 = cw2 + 4 * D;
    if (IN(0)) { TIDS phase_prologue(args, lds, tid, lane, wave); } SEAM(0);
    if (IN(1)) { TIDS phase_first(args, mod, XN, tid, lane, wave); } SEAM(1);
    if (IN(2)) { TIDS pg8::EpiGlu<false, true> E{HID, FF, ssqv, (const float*)(ws + WS_BW + BW_UP1), 2 * FF, (LAS float*)(lds + RING_BYTES), (const float*)(ws + WS_CF)};
        run_gemm<pg8::EpiGlu<false, true>, 2>(lds, XN, (const bf16*)(ws + WS_WUP1I8), 2 * FF, D / 2, E); } SEAM(2);
    if (IN(3)) { TIDS pg8::EpiRes<true> E{args.in[I_X], HB1, nullptr, mod + 2 * D, NMOD * D, 0.5f, nullptr, ssqw + (size_t)16 * M}; run_gemm(lds, HID, (const bf16*)(ws + WS_WDN1), D, FF, E); } SEAM(3);
    bf16* XNB = (bf16*)args.out + (size_t)M * D;
    if (IN(4)) { TIDS phase_mix_norm(HB1, ssqv + (size_t)16 * M, cw2, mod + 3 * D, XNB, (unsigned char*)(ws + WS_XN), (float*)(ws + WS_RSX), lane, wave); } SEAM(4);
    if (IN(5)) { TIDS phase_ba(XNB, (const bf16*)(ws + WS_WIN1) + (size_t)4608 * D, (float*)(ws + WS_BA), lane, wave);
        { pg8::EpiIn1Q E{(bf16*)(ws + WS_CV), (bf16*)(ws + WS_CAB), (bf16*)(ws + WS_QRAW), (size_t)M * D, (const float*)(ws + WS_RSX), (const float*)(ws + WS_CF2), (LAS float*)(lds + RING_BYTES), 0, 6};
          run_gemm<pg8::EpiIn1Q, 2>(lds, XN, (const bf16*)(ws + WS_WIN1I8), 3072, D / 2, E); }
        __syncthreads();
        { pg8::EpiIn1 E{(bf16*)(ws + WS_CV), (bf16*)(ws + WS_CAB), (bf16*)(ws + WS_QRAW), (size_t)M * D, (float*)(ws + WS_BA), 6, 0};
          run_gemm(lds, XNB, (const bf16*)(ws + WS_WIN1), 1536, D, E); } } SEAM(5);
    if (IN(6)) { TIDS phase_conv_qkv((const bf16*)(ws + WS_QRAW), (bf16*)(ws + WS_QF), args.in[I_CONVDN], true, 0.08838834764831845f, lane, wave);
        phase_ya((const bf16*)(ws + WS_CAB), (const bf16*)(ws + WS_CV), args.in[I_CONVA], (bf16*)(ws + WS_YA), lane, wave);
        phase_gb(args, (const float*)(ws + WS_BA), (float*)(ws + WS_GB), tid); } SEAM(6);
    bf16* VFp = (bf16*)args.out + (size_t)M * D;
    if (IN(7)) { TIDS phase_conv_qkv((const bf16*)(ws + WS_KRAW), (bf16*)(ws + WS_KF), args.in[I_CONVDN] + 1024, true, 1.0f, lane, wave);
        phase_conv_qkv((const bf16*)(ws + WS_VRAW), VFp, args.in[I_CONVDN] + 2048, false, 1.0f, lane, wave); } SEAM(7);
    if (IN(9)) { TIDS scan::phase_scan((const bf16*)(ws + WS_QF), (const bf16*)(ws + WS_KF), (const bf16*)VFp, (const float*)(ws + WS_GB), (bf16*)(ws + WS_OF), (bf16*)(ws + WS_OB), lds, tid, lane, wave); } SEAM(9);
    if (IN(10)) { TIDS phase_onorm((bf16*)(ws + WS_OF), (const bf16*)(ws + WS_OB), args.in[I_DNNORM], lane, wave); } SEAM(10);
    if (IN(11)) { TIDS pg8::EpiIn2Q E{(bf16*)(ws + WS_OF), (bf16*)(ws + WS_SGA), (bf16*)(ws + WS_SGB), (const float*)(ws + WS_RSX), (const float*)(ws + WS_CF3), (LAS float*)(lds + RING_BYTES)};
        run_gemm<pg8::EpiIn2Q, 2>(lds, XN, (const bf16*)(ws + WS_WIN2I8), N_IN2, D / 2, E); } SEAM(11);
    if (IN(12)) { TIDS pg8::EpiMul E{(bf16*)(ws + WS_SGA)}; run_gemm(lds, (const bf16*)(ws + WS_YA), (const bf16*)(ws + WS_WA), D, 512, E);
        asm volatile("s_waitcnt vmcnt(0)" ::: "memory"); __builtin_amdgcn_fence(__ATOMIC_ACQUIRE, "agent"); asm volatile("s_waitcnt vmcnt(0)" ::: "memory"); __syncthreads(); }
    if (IN(13)) { TIDS pg8::EpiMerge E{(const bf16*)(ws + WS_SGA), (bf16*)(ws + WS_SGB)}; run_gemm(lds, (const bf16*)(ws + WS_OF), (const bf16*)(ws + WS_WB), D, D, E); } SEAM(13);
    if (IN(14)) { TIDS pg8::EpiRes<false> E{HB1, HB2, XN, mod + 5 * D, NMOD * D, 1.0f, cw3, ssqw + (size_t)32 * M}; run_gemm(lds, (const bf16*)(ws + WS_SGB), (const bf16*)(ws + WS_WO), D, D, E); } SEAM(14);
    if (IN(15)) { TIDS phase_rstd_q(ssqv + (size_t)32 * M, ssqw + (size_t)M, XN, ws + WS_YA, lane, wave); } SEAM(15);
    if (IN(16)) { TIDS pg8::EpiGlu<false, true> E{HID, FF, ssqv + (size_t)M, (const float*)(ws + WS_BW + BW_UP2), 2 * FF, (LAS float*)(lds + RING_BYTES), (const float*)(ws + WS_CF) + 2 * FF};
        run_gemm<pg8::EpiGlu<false, true>, 2>(lds, (const bf16*)(ws + WS_YA), (const bf16*)(ws + WS_WUP2I8), 2 * FF, D / 2, E); } SEAM(16);
    if (IN(17)) { TIDS pg8::EpiRes<false> E{HB2, HB3, nullptr, mod + 8 * D, NMOD * D, 0.5f, nullptr, ssqw + (size_t)48 * M}; run_gemm(lds, HID, (const bf16*)(ws + WS_WDN2), D, FF, E); } SEAM(17);
    if (IN(18)) { TIDS phase_final_norm(HB3, ssqv + (size_t)48 * M, args.out, args.in[I_NFIN], lane, wave); }
#undef IN
#undef SEAM
}

extern "C" void kernel_launch(void* const* d_in, const int* in_sizes, int n_in, void* d_out, int out_size, void* d_ws, size_t ws_size, hipStream_t stream) {
    static int grid = 0;
    if (grid == 0) {
        if (n_in != 23 || in_sizes[0] != M * D || out_size != M * D || ws_size < WS_END) { fprintf(stderr, "kernel_launch: unexpected problem: n_in %d in0 %d out %d ws %zu (need %zu)\n", n_in, n_in > 0 ? in_sizes[0] : -1, out_size, ws_size, (size_t)WS_END); grid = -1; return; }
        int dev = 0, cus = 0, per_cu = 0;
        if (hipGetDevice(&dev) != hipSuccess || hipDeviceGetAttribute(&cus, hipDeviceAttributeMultiprocessorCount, dev) != hipSuccess) { grid = -1; return; }
        if (hipFuncSetAttribute((const void*)mk_fwd, hipFuncAttributeMaxDynamicSharedMemorySize, LDS_BYTES) != hipSuccess) { fprintf(stderr, "kernel_launch: hipFuncSetAttribute failed\n"); grid = -1; return; }
        if (hipOccupancyMaxActiveBlocksPerMultiprocessor(&per_cu, (const void*)mk_fwd, NWAVES * 64, LDS_BYTES) != hipSuccess || per_cu < 1)
            fprintf(stderr, "kernel_launch: note: occupancy query reports %d workgroups per CU\n", per_cu);
        (void)hipGetLastError();
        grid = cus;
    }
    if (grid < 0) return;
    (void)hipMemsetAsync((char*)d_ws + WS_CTL, 0, CTL_ZERO_BYTES, stream);
    Args a{};
    for (int i = 0; i < 23; ++i) a.in[i] = (const float*)d_in[i];
    a.out = (float*)d_out; a.ws = (unsigned char*)d_ws;
#if MK_SPLIT
    for (int ph = 0; ph < NPHASE; ++ph) { a.ph_lo = ph; a.ph_hi = ph + 1; hipLaunchKernelGGL(mk_fwd, dim3(grid), dim3(NWAVES * 64), LDS_BYTES, stream, a); }
#else
    a.ph_lo = 0; a.ph_hi = NPHASE; hipLaunchKernelGGL(mk_fwd, dim3(grid), dim3(NWAVES * 64), LDS_BYTES, stream, a);
#endif
    const hipError_t le = hipPeekAtLastError();
    if (le != hipSuccess) fprintf(stderr, "kernel_launch: launch failed: %s\n", hipGetErrorName(le));
}
```

```cpp
#include <hip/hip_runtime.h>
#include <cstdio>
#include <cstdint>
namespace pg8 {
#define PG8_LAS __attribute__((address_space(3)))
typedef unsigned short bf16_t;
typedef short bf16x8 __attribute__((ext_vector_type(8)));
typedef float f32x4 __attribute__((ext_vector_type(4)));
typedef unsigned u32x4 __attribute__((ext_vector_type(4)));
constexpr int BM = 256, BK = 64, HALF = 128, HTB = HALF * BK * 2  , STAGE_BYTES = 8 * HTB, NXCD = 8, WGM = 8;

__host__ __device__ __forceinline__ int lds_byte(int r, int c) { const int st = (r >> 4) * 2 + (c >> 5), rr = r & 15, cc = c & 31, ob = rr * 64 + cc * 2; return st * 1024 + (ob ^ (((ob >> 9) & 1) << 5)); }
__host__ __device__ __forceinline__ void stage_rc(int b, int& R, int& C) { const int st = b / 1024, sb = b % 1024, swz = sb ^ (((sb >> 9) & 1) << 5); R = (st >> 1) * 16 + swz / 64; C = (st & 1) * 32 + (swz % 64) / 2; }
__host__ __device__ __forceinline__ int perm32(int rho) { const int n = rho >> 4, i = rho & 15; return 8 * (i >> 2) + 4 * n + (i & 3); }

struct Unit { int pm, pn; };
struct Gemm { const bf16_t* A; const bf16_t* Bt; int M, N, K; size_t bstride; };

struct StaticOrder {
    int nM, nN, nwg, G, c;
    __host__ __device__ void init(int M, int N, int G_, int c_) { nM = M / BM; nN = N / BM; nwg = nM * nN; G = G_; c = c_; }
    __host__ __device__ bool next(int i, Unit& u) const {
        const long L = (long)i * G + c; if (L >= nwg) return false;
        int wgid = (int)L; { const int q = nwg / NXCD, r = nwg % NXCD, xcd = wgid % NXCD, off = wgid / NXCD; wgid = (xcd < r ? xcd * (q + 1) : r * (q + 1) + (xcd - r) * q) + off; }
        const int nig = WGM * nN, gid = wgid / nig, fm = gid * WGM, gsz = (nM - fm) < WGM ? (nM - fm) : WGM;
        u.pm = fm + ((wgid % nig) % gsz); u.pn = (wgid % nig) / gsz; return true;
    }
    __device__ __forceinline__ void a_ready(const Unit&) const {}
    __device__ __forceinline__ void done(const Unit&) const {}
};
__device__ __forceinline__ unsigned cvt_pk_bf16(float lo, float hi) { typedef float f32x2_ __attribute__((ext_vector_type(2))); typedef __bf16 bf16x2_ __attribute__((ext_vector_type(2)));
    const f32x2_ v = {lo, hi}; return __builtin_bit_cast(unsigned, __builtin_convertvector(v, bf16x2_)); }
__device__ __forceinline__ float fast_sigmoid(float x) { return __builtin_amdgcn_rcpf(1.0f + __builtin_amdgcn_exp2f(-1.4426950408889634f * x)); }
__device__ __forceinline__ float fast_silu(float x) { return x * fast_sigmoid(x); }
__device__ __forceinline__ f32x4 silu4(f32x4 v) { return (f32x4){fast_silu(v[0]), fast_silu(v[1]), fast_silu(v[2]), fast_silu(v[3])}; }
__device__ __forceinline__ f32x4 sigm4(f32x4 v) { return (f32x4){fast_sigmoid(v[0]), fast_sigmoid(v[1]), fast_sigmoid(v[2]), fast_sigmoid(v[3])}; }
__device__ __forceinline__ u32x4 pack8(f32x4 v0, f32x4 v1) { u32x4 w; w.x = cvt_pk_bf16(v0[0], v0[1]); w.y = cvt_pk_bf16(v0[2], v0[3]); w.z = cvt_pk_bf16(v1[0], v1[1]); w.w = cvt_pk_bf16(v1[2], v1[3]); return w; }
__device__ __forceinline__ void unpack8(u32x4 w, f32x4& v0, f32x4& v1) {
    v0 = (f32x4){__uint_as_float(w.x << 16), __uint_as_float(w.x & 0xffff0000u), __uint_as_float(w.y << 16), __uint_as_float(w.y & 0xffff0000u)};
    v1 = (f32x4){__uint_as_float(w.z << 16), __uint_as_float(w.z & 0xffff0000u), __uint_as_float(w.w << 16), __uint_as_float(w.w & 0xffff0000u)}; }

__device__ __forceinline__ float row_rstd(const float* ssq, int row) {
    const f32x4 a = *(const f32x4*)(ssq + (size_t)row * 16), b = *(const f32x4*)(ssq + (size_t)row * 16 + 4), c = *(const f32x4*)(ssq + (size_t)row * 16 + 8), d = *(const f32x4*)(ssq + (size_t)row * 16 + 12);
    const float s = ((a[0] + a[1]) + (a[2] + a[3])) + ((b[0] + b[1]) + (b[2] + b[3])) + (((c[0] + c[1]) + (c[2] + c[3])) + ((d[0] + d[1]) + (d[2] + d[3])));
    return __builtin_amdgcn_rsqf(s * (1.0f / 1024.0f) + 1e-6f); }
__device__ __forceinline__ unsigned f8x4(float a, float b, float c, float d) {
    a = __builtin_fminf(__builtin_fmaxf(a, -448.f), 448.f); b = __builtin_fminf(__builtin_fmaxf(b, -448.f), 448.f); c = __builtin_fminf(__builtin_fmaxf(c, -448.f), 448.f); d = __builtin_fminf(__builtin_fmaxf(d, -448.f), 448.f);
    unsigned w = 0u; w = __builtin_amdgcn_cvt_pk_fp8_f32(a, b, w, false); w = __builtin_amdgcn_cvt_pk_fp8_f32(c, d, w, true); return w; }
constexpr float W8_SCALE = 64.f;
constexpr float H8_SCALE = 8.f;
template <bool OUT8, bool CS = false> struct EpiGlu {
    static constexpr bool PERM = true, AFTER_DRAIN = false, PREFETCH = true;
    bf16_t* O; int ldo; const float* rstd; const float* bw; int bw_bstride; PG8_LAS float* tbl; const float* cf;
    __device__ __forceinline__ void prefetch(const Unit& u, int par, int wid, int lane) const {
        if (wid < 4) {
            const float* rp = rstd + (size_t)u.pm * BM + 64 * wid + lane;
            const float* bp = bw + (size_t)((u.pm * BM) >> 13) * bw_bstride + u.pn * BM + 64 * wid + lane;
            __builtin_amdgcn_global_load_lds((const unsigned*)rp, (PG8_LAS unsigned*)(tbl + par * 768 + 64 * wid), 4, 0, 0);
            __builtin_amdgcn_global_load_lds((const unsigned*)bp, (PG8_LAS unsigned*)(tbl + par * 768 + 256 + 64 * wid), 4, 0, 0);
            if constexpr (CS) __builtin_amdgcn_global_load_lds((const unsigned*)(cf + (size_t)u.pn * BM + 64 * wid + lane), (PG8_LAS unsigned*)(tbl + par * 768 + 512 + 64 * wid), 4, 0, 0);
        }
    }
    __device__ __forceinline__ void run(const f32x4 (&acc)[2][2][4][2], const Unit& u, int par, int wr, int wc, int fr, int fq) const {
        const int row0 = u.pm * BM + wr * 64 + fr, cl = wc * 32 + 8 * fq, col0 = u.pn * HALF + cl;
        const PG8_LAS float* tr = tbl + par * 768 + wr * 64 + fr; const PG8_LAS float* tb = tbl + par * 768 + 256 + cl;
        const f32x4 ba0 = *(const PG8_LAS f32x4*)tb, ba1 = *(const PG8_LAS f32x4*)(tb + 4), bb0 = *(const PG8_LAS f32x4*)(tb + HALF), bb1 = *(const PG8_LAS f32x4*)(tb + HALF + 4);
        f32x4 ca0 = {1.f, 1.f, 1.f, 1.f}, ca1 = ca0, cb0 = ca0, cb1 = ca0;
        if constexpr (CS) { ca0 = *(const PG8_LAS f32x4*)(tb + 256); ca1 = *(const PG8_LAS f32x4*)(tb + 256 + 4); cb0 = *(const PG8_LAS f32x4*)(tb + 256 + HALF); cb1 = *(const PG8_LAS f32x4*)(tb + 256 + HALF + 4); }
#pragma unroll
        for (int ai = 0; ai < 2; ++ai)
#pragma unroll
            for (int m = 0; m < 4; ++m) { const int row = row0 + ai * HALF + m * 16; const float rr = tr[ai * HALF + m * 16]; bf16_t* rowp = O + (size_t)row * ldo + col0;
                f32x4 h0, h1;
                if constexpr (CS) { h0 = silu4(acc[ai][0][m][0] * (ca0 * rr) + ba0) * (acc[ai][1][m][0] * (cb0 * rr) + bb0); h1 = silu4(acc[ai][0][m][1] * (ca1 * rr) + ba1) * (acc[ai][1][m][1] * (cb1 * rr) + bb1); }
                else { h0 = silu4(acc[ai][0][m][0] * rr + ba0) * (acc[ai][1][m][0] * rr + bb0); h1 = silu4(acc[ai][0][m][1] * rr + ba1) * (acc[ai][1][m][1] * rr + bb1); }
                if constexpr (OUT8) { typedef unsigned u32x2_ __attribute__((ext_vector_type(2))); const f32x4 g0 = h0 * H8_SCALE, g1 = h1 * H8_SCALE;
                    *(u32x2_*)((unsigned char*)O + (size_t)row * ldo + col0) = (u32x2_){f8x4(g0[0], g0[1], g0[2], g0[3]), f8x4(g1[0], g1[1], g1[2], g1[3])}; }
                else *(u32x4*)rowp = pack8(h0, h1); }
    }
};
template <bool BASE_F32> struct EpiRes {
    static constexpr bool PERM = true, AFTER_DRAIN = false, PREFETCH = false;
    const void* base; bf16_t* hout; bf16_t* aout; const float* gate; int gate_bstride; float scale; const float* cw; float* ssq;
    __device__ __forceinline__ void operator()(const f32x4 (&acc)[2][2][4][2], const Unit& u, int wr, int wc, int fr, int fq) const {
        const int row0 = u.pm * BM + wr * 64 + fr, col0 = u.pn * BM + wc * 32 + 8 * fq, b = (u.pm * BM) >> 13;
        f32x4 gv[2][2], cv[2][2];
#pragma unroll
        for (int bj = 0; bj < 2; ++bj)
#pragma unroll
            for (int n = 0; n < 2; ++n) { gv[bj][n] = *(const f32x4*)(gate + (size_t)b * gate_bstride + col0 + bj * HALF + 4 * n);
                cv[bj][n] = aout ? *(const f32x4*)(cw + b * 1024 + col0 + bj * HALF + 4 * n) : (f32x4){0.f, 0.f, 0.f, 0.f}; }
        asm volatile("" ::: "memory");
        constexpr int AHEAD = BASE_F32 ? 3 : 4;
        f32x4 pf[BASE_F32 ? AHEAD : 1][2][2]; u32x4 pb[BASE_F32 ? 1 : AHEAD][2];
#define EPIRES_LOAD(slot, grp) do { const size_t off_ = (size_t)(row0 + ((grp) >> 2) * HALF + ((grp) & 3) * 16) * 1024 + col0; \
            if (BASE_F32) { _Pragma("unroll") for (int bj = 0; bj < 2; ++bj) _Pragma("unroll") for (int n = 0; n < 2; ++n) pf[BASE_F32 ? (slot) : 0][bj][n] = *(const f32x4*)((const float*)base + off_ + bj * HALF + 4 * n); } \
            else { _Pragma("unroll") for (int bj = 0; bj < 2; ++bj) pb[BASE_F32 ? 0 : (slot)][bj] = *(const u32x4*)((const bf16_t*)base + off_ + bj * HALF); } } while (0)
#pragma unroll
        for (int grp = 0; grp < AHEAD; ++grp) EPIRES_LOAD(grp, grp);
#pragma unroll
        for (int grp = 0; grp < 8; ++grp) { const int ai = grp >> 2, m = grp & 3, slot = grp % AHEAD, row = row0 + ai * HALF + m * 16; const size_t off = (size_t)row * 1024 + col0;
            float ss = 0.f;
#pragma unroll
            for (int bj = 0; bj < 2; ++bj) { f32x4 b0, b1;
                if (BASE_F32) { b0 = pf[BASE_F32 ? slot : 0][bj][0]; b1 = pf[BASE_F32 ? slot : 0][bj][1]; } else unpack8(pb[BASE_F32 ? 0 : slot][bj], b0, b1);
                const f32x4 h0 = b0 + (gv[bj][0] * scale) * acc[ai][bj][m][0], h1 = b1 + (gv[bj][1] * scale) * acc[ai][bj][m][1];
                ss += (h0[0] * h0[0] + h0[1] * h0[1]) + (h0[2] * h0[2] + h0[3] * h0[3]) + (h1[0] * h1[0] + h1[1] * h1[1]) + (h1[2] * h1[2] + h1[3] * h1[3]);
                *(u32x4*)(hout + off + bj * HALF) = pack8(h0, h1);
                if (aout) *(u32x4*)(aout + off + bj * HALF) = pack8(h0 * cv[bj][0], h1 * cv[bj][1]); }
            ss += __shfl_xor(ss, 16); ss += __shfl_xor(ss, 32);
            if (fq == 0) ssq[(size_t)row * 16 + u.pn * 4 + wc] = ss;
            if (grp + AHEAD < 8) { asm volatile("" ::: "memory"); EPIRES_LOAD(slot, grp + AHEAD); } }
#undef EPIRES_LOAD
    }
};
struct EpiIn1 {
    static constexpr bool PERM = true, AFTER_DRAIN = false, PREFETCH = false;
    bf16_t* CV; bf16_t* CAB; bf16_t* QKV; size_t qkv_stride; float* BA; int pn_split, pn_add;
    __device__ __forceinline__ void operator()(const f32x4 (&acc)[2][2][4][2], const Unit& u, int wr, int wc, int fr, int fq) const {
        const int row0 = u.pm * BM + wr * 64 + fr, cl = wc * 32 + 8 * fq; const int pn = (u.pn < pn_split) ? u.pn : u.pn + pn_add;
        if (pn < 4) {
#pragma unroll
            for (int ai = 0; ai < 2; ++ai)
#pragma unroll
                for (int m = 0; m < 4; ++m) { bf16_t* rowp = CV + (size_t)(row0 + ai * HALF + m * 16) * 512 + pn * HALF + cl;
                    *(u32x4*)rowp = pack8(acc[ai][0][m][0] * acc[ai][1][m][0], acc[ai][0][m][1] * acc[ai][1][m][1]); }
        } else {
            bf16_t* base; int ld, colt;
            if (pn < 6) { base = CAB; ld = 512; colt = (pn - 4) * BM; } else { const int t = pn - 6; base = QKV + (size_t)(t >> 2) * qkv_stride; ld = 1024; colt = (t & 3) * BM; }
#pragma unroll
            for (int ai = 0; ai < 2; ++ai)
#pragma unroll
                for (int m = 0; m < 4; ++m) { bf16_t* rowp = base + (size_t)(row0 + ai * HALF + m * 16) * ld + colt + cl;
#pragma unroll
                    for (int bj = 0; bj < 2; ++bj) *(u32x4*)(rowp + bj * HALF) = pack8(acc[ai][bj][m][0], acc[ai][bj][m][1]); }
        }
    }
};
__device__ __forceinline__ unsigned q8x4(f32x4 v, float q) {
    const f32x4 t = v * q + 128.f; unsigned w = 0u;
    w = __builtin_amdgcn_cvt_pk_u8_f32(__builtin_rintf(t[0]), 0, w); w = __builtin_amdgcn_cvt_pk_u8_f32(__builtin_rintf(t[1]), 1, w);
    w = __builtin_amdgcn_cvt_pk_u8_f32(__builtin_rintf(t[2]), 2, w); w = __builtin_amdgcn_cvt_pk_u8_f32(__builtin_rintf(t[3]), 3, w); return w; }
constexpr size_t QKV8_SC_OFF = (size_t)32 << 20;
struct EpiIn1Q {
    static constexpr bool PERM = true, AFTER_DRAIN = false, PREFETCH = true;
    bf16_t* CV; bf16_t* CAB; bf16_t* QKV; size_t qkv_stride; const float* rs; const float* cf; PG8_LAS float* tbl; int pn_split, pn_add;
    __device__ __forceinline__ void prefetch(const Unit& u, int par, int wid, int lane) const {
        if (wid < 4) {
            __builtin_amdgcn_global_load_lds((const unsigned*)(rs + (size_t)u.pm * BM + 64 * wid + lane), (PG8_LAS unsigned*)(tbl + par * 768 + 64 * wid), 4, 0, 0);
            __builtin_amdgcn_global_load_lds((const unsigned*)(cf + (size_t)u.pn * BM + 64 * wid + lane), (PG8_LAS unsigned*)(tbl + par * 768 + 512 + 64 * wid), 4, 0, 0);
        }
    }
    __device__ __forceinline__ void run(const f32x4 (&acc)[2][2][4][2], const Unit& u, int par, int wr, int wc, int fr, int fq) const {
        const int row0 = u.pm * BM + wr * 64 + fr, cl = wc * 32 + 8 * fq; const int pn = (u.pn < pn_split) ? u.pn : u.pn + pn_add;
        const PG8_LAS float* tr = tbl + par * 768 + wr * 64 + fr; const PG8_LAS float* tc = tbl + par * 768 + 512 + cl;
        const f32x4 ca0 = *(const PG8_LAS f32x4*)tc, ca1 = *(const PG8_LAS f32x4*)(tc + 4), cb0 = *(const PG8_LAS f32x4*)(tc + HALF), cb1 = *(const PG8_LAS f32x4*)(tc + HALF + 4);
        if (pn < 4) {
#pragma unroll
            for (int ai = 0; ai < 2; ++ai)
#pragma unroll
                for (int m = 0; m < 4; ++m) { const float rr = tr[ai * HALF + m * 16]; bf16_t* rowp = CV + (size_t)(row0 + ai * HALF + m * 16) * 512 + pn * HALF + cl;
                    *(u32x4*)rowp = pack8((acc[ai][0][m][0] * (ca0 * rr)) * (acc[ai][1][m][0] * (cb0 * rr)), (acc[ai][0][m][1] * (ca1 * rr)) * (acc[ai][1][m][1] * (cb1 * rr))); }
        } else {
            if (pn < 6) { bf16_t* base = CAB; const int ld = 512, colt = (pn - 4) * BM;
#pragma unroll
            for (int ai = 0; ai < 2; ++ai)
#pragma unroll
                for (int m = 0; m < 4; ++m) { const float rr = tr[ai * HALF + m * 16]; bf16_t* rowp = base + (size_t)(row0 + ai * HALF + m * 16) * ld + colt + cl;
                    *(u32x4*)rowp = pack8(acc[ai][0][m][0] * (ca0 * rr), acc[ai][0][m][1] * (ca1 * rr));
                    *(u32x4*)(rowp + HALF) = pack8(acc[ai][1][m][0] * (cb0 * rr), acc[ai][1][m][1] * (cb1 * rr)); }
            } else {
                const int t = pn - 6, colt = (t & 3) * BM; unsigned char* base8 = (unsigned char*)(QKV + (size_t)(t >> 2) * qkv_stride); float* scb = (float*)(base8 + QKV8_SC_OFF);
                typedef unsigned u32x2_ __attribute__((ext_vector_type(2)));
#pragma unroll
            for (int ai = 0; ai < 2; ++ai)
#pragma unroll
                for (int m = 0; m < 4; ++m) { const float rr = tr[ai * HALF + m * 16]; const int row = row0 + ai * HALF + m * 16;
                    const f32x4 a0 = acc[ai][0][m][0] * (ca0 * rr), a1 = acc[ai][0][m][1] * (ca1 * rr), b0 = acc[ai][1][m][0] * (cb0 * rr), b1 = acc[ai][1][m][1] * (cb1 * rr);
                    float ma = __builtin_fmaxf(__builtin_fmaxf(__builtin_fmaxf(__builtin_fabsf(a0[0]), __builtin_fabsf(a0[1])), __builtin_fmaxf(__builtin_fabsf(a0[2]), __builtin_fabsf(a0[3]))), __builtin_fmaxf(__builtin_fmaxf(__builtin_fabsf(a1[0]), __builtin_fabsf(a1[1])), __builtin_fmaxf(__builtin_fabsf(a1[2]), __builtin_fabsf(a1[3]))));
                    float mb = __builtin_fmaxf(__builtin_fmaxf(__builtin_fmaxf(__builtin_fabsf(b0[0]), __builtin_fabsf(b0[1])), __builtin_fmaxf(__builtin_fabsf(b0[2]), __builtin_fabsf(b0[3]))), __builtin_fmaxf(__builtin_fmaxf(__builtin_fabsf(b1[0]), __builtin_fabsf(b1[1])), __builtin_fmaxf(__builtin_fabsf(b1[2]), __builtin_fabsf(b1[3]))));
                    ma = __builtin_fmaxf(ma, __shfl_xor(ma, 16)); mb = __builtin_fmaxf(mb, __shfl_xor(mb, 16)); ma = __builtin_fmaxf(ma, __shfl_xor(ma, 32)); mb = __builtin_fmaxf(mb, __shfl_xor(mb, 32));
                    ma = __builtin_fmaxf(ma, 1e-30f); mb = __builtin_fmaxf(mb, 1e-30f);
                    const float qa = 127.f * __builtin_amdgcn_rcpf(ma), qb = 127.f * __builtin_amdgcn_rcpf(mb);
                    unsigned char* rowp8 = base8 + (size_t)row * 1024 + colt + cl;
                    *(u32x2_*)rowp8 = (u32x2_){q8x4(a0, qa), q8x4(a1, qa)};
                    *(u32x2_*)(rowp8 + HALF) = (u32x2_){q8x4(b0, qb), q8x4(b1, qb)};
                    if (fq == 0) { float* sp = scb + (size_t)row * 32 + ((colt + wc * 32) >> 5); sp[0] = ma * (1.f / 127.f); sp[4] = mb * (1.f / 127.f); } }
            }
        }
    }
};
struct EpiIn1F {
    static constexpr bool PERM = true, AFTER_DRAIN = false, PREFETCH = true;
    bf16_t* CV; bf16_t* CAB; const float* rstd; const float* bw; int bw_bstride; PG8_LAS float* tbl;
    __device__ __forceinline__ void prefetch(const Unit& u, int par, int wid, int lane) const {
        if (wid < 4) {
            __builtin_amdgcn_global_load_lds((const unsigned*)(rstd + (size_t)u.pm * BM + 64 * wid + lane), (PG8_LAS unsigned*)(tbl + par * 768 + 64 * wid), 4, 0, 0);
            __builtin_amdgcn_global_load_lds((const unsigned*)(bw + (size_t)((u.pm * BM) >> 13) * bw_bstride + u.pn * BM + 64 * wid + lane), (PG8_LAS unsigned*)(tbl + par * 768 + 256 + 64 * wid), 4, 0, 0);
        }
    }
    __device__ __forceinline__ void run(const f32x4 (&acc)[2][2][4][2], const Unit& u, int par, int wr, int wc, int fr, int fq) const {
        const int row0 = u.pm * BM + wr * 64 + fr, cl = wc * 32 + 8 * fq; const int pn = u.pn;
        const PG8_LAS float* tr = tbl + par * 768 + wr * 64 + fr; const PG8_LAS float* tb = tbl + par * 768 + 256 + cl;
        const f32x4 ba0 = *(const PG8_LAS f32x4*)tb, ba1 = *(const PG8_LAS f32x4*)(tb + 4), bb0 = *(const PG8_LAS f32x4*)(tb + HALF), bb1 = *(const PG8_LAS f32x4*)(tb + HALF + 4);
        if (pn < 4) {
#pragma unroll
            for (int ai = 0; ai < 2; ++ai)
#pragma unroll
                for (int m = 0; m < 4; ++m) { const float rr = tr[ai * HALF + m * 16]; bf16_t* rowp = CV + (size_t)(row0 + ai * HALF + m * 16) * 512 + pn * HALF + cl;
                    *(u32x4*)rowp = pack8((acc[ai][0][m][0] * rr + ba0) * (acc[ai][1][m][0] * rr + bb0), (acc[ai][0][m][1] * rr + ba1) * (acc[ai][1][m][1] * rr + bb1)); }
        } else {
#pragma unroll
            for (int ai = 0; ai < 2; ++ai)
#pragma unroll
                for (int m = 0; m < 4; ++m) { const float rr = tr[ai * HALF + m * 16]; bf16_t* rowp = CAB + (size_t)(row0 + ai * HALF + m * 16) * 512 + (pn - 4) * BM + cl;
                    *(u32x4*)rowp = pack8(acc[ai][0][m][0] * rr + ba0, acc[ai][0][m][1] * rr + ba1); *(u32x4*)(rowp + HALF) = pack8(acc[ai][1][m][0] * rr + bb0, acc[ai][1][m][1] * rr + bb1); }
        }
    }
};
struct EpiIn2 {
    static constexpr bool PERM = true, AFTER_DRAIN = false, PREFETCH = false;
    bf16_t* YB; bf16_t* SGA; bf16_t* SGB;
    __device__ __forceinline__ void operator()(const f32x4 (&acc)[2][2][4][2], const Unit& u, int wr, int wc, int fr, int fq) const {
        const int row0 = u.pm * BM + wr * 64 + fr, cl = wc * 32 + 8 * fq; const int pn = u.pn;
        long doff = (long)(SGA - YB); if (pn >= 8) doff = (long)(SGB - YB); if (pn < 4) doff = 0; bf16_t* base = YB + doff; const int colt = (pn & 3) * BM;
#pragma unroll
        for (int ai = 0; ai < 2; ++ai)
#pragma unroll
            for (int m = 0; m < 4; ++m) { bf16_t* rowp = base + (size_t)(row0 + ai * HALF + m * 16) * 1024 + colt + cl;
#pragma unroll
                for (int bj = 0; bj < 2; ++bj) {
                    if (pn < 4) { f32x4 o0, o1; unpack8(*(const u32x4*)(rowp + bj * HALF), o0, o1);
                        *(u32x4*)(rowp + bj * HALF) = pack8(o0 * silu4(acc[ai][bj][m][0]), o1 * silu4(acc[ai][bj][m][1])); }
                    else *(u32x4*)(rowp + bj * HALF) = pack8(sigm4(acc[ai][bj][m][0]), sigm4(acc[ai][bj][m][1])); } }
    }
};
struct EpiIn2Q {
    static constexpr bool PERM = true, AFTER_DRAIN = false, PREFETCH = true;
    bf16_t* YB; bf16_t* SGA; bf16_t* SGB; const float* rs; const float* cf; PG8_LAS float* tbl;
    __device__ __forceinline__ void prefetch(const Unit& u, int par, int wid, int lane) const {
        if (wid < 4) {
            __builtin_amdgcn_global_load_lds((const unsigned*)(rs + (size_t)u.pm * BM + 64 * wid + lane), (PG8_LAS unsigned*)(tbl + par * 768 + 64 * wid), 4, 0, 0);
            __builtin_amdgcn_global_load_lds((const unsigned*)(cf + (size_t)u.pn * BM + 64 * wid + lane), (PG8_LAS unsigned*)(tbl + par * 768 + 512 + 64 * wid), 4, 0, 0);
        }
    }
    __device__ __forceinline__ void run(const f32x4 (&acc)[2][2][4][2], const Unit& u, int par, int wr, int wc, int fr, int fq) const {
        const int row0 = u.pm * BM + wr * 64 + fr, cl = wc * 32 + 8 * fq; const int pn = u.pn;
        long doff = (long)(SGA - YB); if (pn >= 8) doff = (long)(SGB - YB); if (pn < 4) doff = 0; bf16_t* base = YB + doff; const int colt = (pn & 3) * BM;
        const PG8_LAS float* tr = tbl + par * 768 + wr * 64 + fr; const PG8_LAS float* tc = tbl + par * 768 + 512 + cl;
        f32x4 cs[2][2]; cs[0][0] = *(const PG8_LAS f32x4*)tc; cs[0][1] = *(const PG8_LAS f32x4*)(tc + 4); cs[1][0] = *(const PG8_LAS f32x4*)(tc + HALF); cs[1][1] = *(const PG8_LAS f32x4*)(tc + HALF + 4);
        if (pn < 4) {
#pragma unroll
        for (int ai = 0; ai < 2; ++ai)
#pragma unroll
            for (int m = 0; m < 4; ++m) { const float rr = tr[ai * HALF + m * 16]; bf16_t* rowp = base + (size_t)(row0 + ai * HALF + m * 16) * 1024 + colt + cl;
#pragma unroll
                for (int bj = 0; bj < 2; ++bj) { const f32x4 z0 = acc[ai][bj][m][0] * (cs[bj][0] * rr), z1 = acc[ai][bj][m][1] * (cs[bj][1] * rr);
                    f32x4 o0, o1; unpack8(*(const u32x4*)(rowp + bj * HALF), o0, o1);
                    *(u32x4*)(rowp + bj * HALF) = pack8(o0 * silu4(z0), o1 * silu4(z1)); } }
        } else {
            const int colg = (pn - 4) * HALF + cl;
#pragma unroll
        for (int ai = 0; ai < 2; ++ai)
#pragma unroll
            for (int m = 0; m < 4; ++m) { const float rr = tr[ai * HALF + m * 16]; const size_t off = (size_t)(row0 + ai * HALF + m * 16) * 1024 + colg;
                f32x4 rq[2], gq[2];
#pragma unroll
                for (int n = 0; n < 2; ++n) { const f32x4 za = acc[ai][0][m][n] * (cs[0][n] * rr), zb = acc[ai][1][m][n] * (cs[1][n] * rr);
#pragma unroll
                    for (int e = 0; e < 4; ++e) { const float ea = __builtin_amdgcn_exp2f(-1.4426950408889634f * za[e]), eb = __builtin_amdgcn_exp2f(-1.4426950408889634f * __builtin_fmaxf(zb[e], -60.f));
                        rq[n][e] = (1.0f + eb) * __builtin_amdgcn_rcpf(1.0f + ea); gq[n][e] = __builtin_amdgcn_rcpf(1.0f + eb); } }
                *(u32x4*)(SGA + off) = pack8(rq[0], rq[1]); *(u32x4*)(SGB + off) = pack8(gq[0], gq[1]); }
        }
    }
};
struct EpiMul {
    static constexpr bool PERM = true, AFTER_DRAIN = false, PREFETCH = false;
    bf16_t* T;
    __device__ __forceinline__ void operator()(const f32x4 (&acc)[2][2][4][2], const Unit& u, int wr, int wc, int fr, int fq) const {
        const int row0 = u.pm * BM + wr * 64 + fr, col0 = u.pn * BM + wc * 32 + 8 * fq;
        u32x4 tv[4][2];
#define EPIMUL_LOAD(slot, grp) do { _Pragma("unroll") for (int bj = 0; bj < 2; ++bj) tv[slot][bj] = *(const u32x4*)(T + (size_t)(row0 + ((grp) >> 2) * HALF + ((grp) & 3) * 16) * 1024 + col0 + bj * HALF); } while (0)
#pragma unroll
        for (int grp = 0; grp < 4; ++grp) EPIMUL_LOAD(grp, grp);
#pragma unroll
        for (int grp = 0; grp < 8; ++grp) { const int ai = grp >> 2, m = grp & 3, slot = grp & 3; bf16_t* rowp = T + (size_t)(row0 + ai * HALF + m * 16) * 1024 + col0;
#pragma unroll
            for (int bj = 0; bj < 2; ++bj) { f32x4 o0, o1; unpack8(tv[slot][bj], o0, o1);
                *(u32x4*)(rowp + bj * HALF) = pack8(o0 * acc[ai][bj][m][0], o1 * acc[ai][bj][m][1]); }
            if (grp + 4 < 8) { asm volatile("" ::: "memory"); EPIMUL_LOAD(slot, grp + 4); } }
#undef EPIMUL_LOAD
    }
};
struct EpiMerge {
    static constexpr bool PERM = true, AFTER_DRAIN = false, PREFETCH = false;
    const bf16_t* T; bf16_t* G;
    __device__ __forceinline__ void operator()(const f32x4 (&acc)[2][2][4][2], const Unit& u, int wr, int wc, int fr, int fq) const {
        const int row0 = u.pm * BM + wr * 64 + fr, col0 = u.pn * BM + wc * 32 + 8 * fq;
        u32x4 tv[4][2], gvv[4][2];
#define EPIMERGE_LOAD(slot, grp) do { const size_t off_ = (size_t)(row0 + ((grp) >> 2) * HALF + ((grp) & 3) * 16) * 1024 + col0; \
            _Pragma("unroll") for (int bj = 0; bj < 2; ++bj) { tv[slot][bj] = *(const u32x4*)(T + off_ + bj * HALF); gvv[slot][bj] = *(const u32x4*)(G + off_ + bj * HALF); } } while (0)
#pragma unroll
        for (int grp = 0; grp < 4; ++grp) EPIMERGE_LOAD(grp, grp);
#pragma unroll
        for (int grp = 0; grp < 8; ++grp) { const int ai = grp >> 2, m = grp & 3, slot = grp & 3; const size_t off = (size_t)(row0 + ai * HALF + m * 16) * 1024 + col0;
#pragma unroll
            for (int bj = 0; bj < 2; ++bj) { f32x4 t0, t1, g0, g1; unpack8(tv[slot][bj], t0, t1); unpack8(gvv[slot][bj], g0, g1);
                *(u32x4*)(G + off + bj * HALF) = pack8(t0 + g0 * acc[ai][bj][m][0], t1 + g1 * acc[ai][bj][m][1]); }
            if (grp + 4 < 8) { asm volatile("" ::: "memory"); EPIMERGE_LOAD(slot, grp + 4); } }
#undef EPIMERGE_LOAD
    }
};
struct EpiPairMerge {
    static constexpr bool PERM = true;
    const bf16_t* R; bf16_t* G;
    __device__ __forceinline__ void mid(f32x4 (&acc)[2][2][4][2], const Unit& u, int wr, int wc, int fr, int fq) const {
        const int row0 = u.pm * BM + wr * 64 + fr, col0 = u.pn * BM + wc * 32 + 8 * fq;
        u32x4 tv[4][2];
#define EPIPM_LOAD(slot, grp) do { _Pragma("unroll") for (int bj = 0; bj < 2; ++bj) tv[slot][bj] = *(const u32x4*)(R + (size_t)(row0 + ((grp) >> 2) * HALF + ((grp) & 3) * 16) * 1024 + col0 + bj * HALF); } while (0)
#pragma unroll
        for (int grp = 0; grp < 4; ++grp) EPIPM_LOAD(grp, grp);
#pragma unroll
        for (int grp = 0; grp < 8; ++grp) { const int ai = grp >> 2, m = grp & 3, slot = grp & 3;
#pragma unroll
            for (int bj = 0; bj < 2; ++bj) { f32x4 o0, o1; unpack8(tv[slot][bj], o0, o1); acc[ai][bj][m][0] *= o0; acc[ai][bj][m][1] *= o1; }
            if (grp + 4 < 8) { asm volatile("" ::: "memory"); EPIPM_LOAD(slot, grp + 4); } }
#undef EPIPM_LOAD
    }
    __device__ __forceinline__ void fin(const f32x4 (&acc)[2][2][4][2], const Unit& u, int wr, int wc, int fr, int fq) const { EpiMul{G}(acc, u, wr, wc, fr, fq); }
};
typedef int i32x8 __attribute__((ext_vector_type(8)));
typedef int i32x4 __attribute__((ext_vector_type(4)));
template <class Epi, class Sched, bool ALIGN_EPI = false, bool SP2 = false, int QMODE = 0>
__device__ __forceinline__ void gemm_phase(PG8_LAS unsigned char* lds, const Gemm g, const Sched& S, const Epi& E) {
    const int tid = threadIdx.x, wid = __builtin_amdgcn_readfirstlane(tid >> 6), lane = tid & 63, wr = wid >> 2, wc = wid & 3, fr = lane & 15, fq = lane >> 4;
    const int K = g.K, nt = K / BK;
    constexpr bool FP8 = (QMODE == 1), I8 = (QMODE == 2);
    int f8sc = 0x7f7f7f7f; asm volatile("" : "+v"(f8sc)); (void)f8sc;
    unsigned voffA[2], voffB[2];
#pragma unroll
    for (int i = 0; i < 2; ++i) { int R, C; stage_rc(tid * 16 + i * 8192, R, C); const int Rb = Epi::PERM ? ((R & ~31) + perm32(R & 31)) : R;
        voffA[i] = (unsigned)(R * K + C) * 2u; voffB[i] = (unsigned)(Rb * K + C) * 2u; }
    const size_t kstep = (size_t)(BK * 2);
    const size_t hstep = (size_t)HALF * K * 2;
    const size_t tstep = 2 * hstep;
    const unsigned ldsw = (unsigned)wid * 1024u;
    const int aoff = lds_byte(wr * 64 + fr, fq * 8), boff = lds_byte(wc * 32 + fr, fq * 8);
#define PG8_SA(b, h) (((b) * 2 + (h)) * HTB)
#define PG8_SB(b, h) ((4 + (b) * 2 + (h)) * HTB)
#define PG8_STAGE(bufoff, gbase, voff) do { _Pragma("unroll") for (int _i = 0; _i < 2; ++_i) \
        __builtin_amdgcn_global_load_lds((const unsigned*)((const char*)(gbase) + (voff)[_i]), (PG8_LAS unsigned*)(lds + (bufoff) + ldsw + _i * 8192), 16, 0, 0); } while (0)
#define PG8_LDA(dst, b, h) do { _Pragma("unroll") for (int m = 0; m < 4; ++m) { dst[m].lo = *(const PG8_LAS i32x4*)(lds + PG8_SA(b, h) + aoff + m * 2048); dst[m].hi = *(const PG8_LAS i32x4*)(lds + PG8_SA(b, h) + aoff + m * 2048 + 1024); } } while (0)
#define PG8_LDB(dst, b, h) do { _Pragma("unroll") for (int n = 0; n < 2; ++n) { dst[n].lo = *(const PG8_LAS i32x4*)(lds + PG8_SB(b, h) + boff + n * 2048); dst[n].hi = *(const PG8_LAS i32x4*)(lds + PG8_SB(b, h) + boff + n * 2048 + 1024); } } while (0)
#define PG8_MMA(ai, bj, At, Bt) do { __builtin_amdgcn_s_setprio(1); _Pragma("unroll") for (int m = 0; m < 4; ++m) _Pragma("unroll") for (int n = 0; n < 2; ++n) { \
        if constexpr (FP8) asm volatile("v_mfma_scale_f32_16x16x128_f8f6f4 %0, %1, %2, %0, %3, %3 op_sel_hi:[0,0,0]" : "+v"(acc[ai][bj][m][n]) : "v"(Bt[n]), "v"(At[m]), "v"(f8sc));   \
        else if constexpr (I8) { const i32x4 bl_ = Bt[n].lo, bh_ = Bt[n].hi, al_ = At[m].lo, ah_ = At[m].hi; i32x4 c_ = __builtin_bit_cast(i32x4, acc[ai][bj][m][n]); \
               c_ = __builtin_amdgcn_mfma_i32_16x16x64_i8(bl_, al_, c_, 0, 0, 0); c_ = __builtin_amdgcn_mfma_i32_16x16x64_i8(bh_, ah_, c_, 0, 0, 0); acc[ai][bj][m][n] = __builtin_bit_cast(f32x4, c_); } \
        else { const i32x4 bl_ = Bt[n].lo, bh_ = Bt[n].hi, al_ = At[m].lo, ah_ = At[m].hi;        \
               acc[ai][bj][m][n] = __builtin_amdgcn_mfma_f32_16x16x32_bf16(__builtin_bit_cast(bf16x8, bl_), __builtin_bit_cast(bf16x8, al_), acc[ai][bj][m][n], 0, 0, 0); \
               acc[ai][bj][m][n] = __builtin_amdgcn_mfma_f32_16x16x32_bf16(__builtin_bit_cast(bf16x8, bh_), __builtin_bit_cast(bf16x8, ah_), acc[ai][bj][m][n], 0, 0, 0); } } \
        __builtin_amdgcn_s_setprio(0); } while (0)
#define PG8_WAIT_V(n) asm volatile("s_waitcnt vmcnt(" #n ")" ::: "memory")
#define PG8_WAIT_L(n) asm volatile("s_waitcnt lgkmcnt(" #n ")" ::: "memory")
#define PG8_BAR __builtin_amdgcn_s_barrier()
#define PG8_SCHED __builtin_amdgcn_sched_barrier(0)
    Unit cur, nxt; int ui = 0;
    if (!S.next(0, cur)) return;
    if constexpr (Epi::PREFETCH) E.prefetch(cur, 0, wid, lane);
    f32x4 acc[2][2][4][2];
#pragma unroll
    for (int a = 0; a < 2; ++a)
#pragma unroll
        for (int b = 0; b < 2; ++b)
#pragma unroll
            for (int m = 0; m < 4; ++m)
#pragma unroll
                for (int n = 0; n < 2; ++n) acc[a][b][m][n] = (f32x4){0.f, 0.f, 0.f, 0.f};
    i32x8 At[4], B0[2], B1[2];
    const char* cA = (const char*)g.A + (size_t)cur.pm * tstep; const char* cB = (const char*)g.Bt + (size_t)cur.pn * tstep + (size_t)(cur.pm >> 5) * g.bstride;
    S.a_ready(cur);
    if constexpr (SP2) {
        PG8_STAGE(PG8_SB(0, 0), cB, voffB); PG8_STAGE(PG8_SB(0, 1), cB + hstep, voffB); PG8_STAGE(PG8_SA(0, 0), cA, voffA); PG8_STAGE(PG8_SA(0, 1), cA + hstep, voffA);
        if (wr == 1) PG8_BAR;
        PG8_WAIT_V(2); PG8_BAR;
        PG8_STAGE(PG8_SB(1, 0), cB + kstep, voffB); PG8_STAGE(PG8_SA(1, 0), cA + kstep, voffA); PG8_STAGE(PG8_SB(1, 1), cB + hstep + kstep, voffB);
        PG8_WAIT_V(6); PG8_BAR;
    } else {
        PG8_STAGE(PG8_SB(0, 0), cB, voffB); PG8_STAGE(PG8_SA(0, 0), cA, voffA); PG8_STAGE(PG8_SB(0, 1), cB + hstep, voffB); PG8_STAGE(PG8_SA(0, 1), cA + hstep, voffA);
        if (wr == 1) PG8_BAR;
        PG8_WAIT_V(4); PG8_BAR;
        PG8_STAGE(PG8_SB(1, 0), cB + kstep, voffB); PG8_STAGE(PG8_SA(1, 0), cA + kstep, voffA); PG8_STAGE(PG8_SB(1, 1), cB + hstep + kstep, voffB);
        PG8_WAIT_V(6); PG8_BAR;
    }
    for (;;) {
        const bool has_next = S.next(ui + 1, nxt);
        const char* nA = has_next ? (const char*)g.A + (size_t)nxt.pm * tstep : cA; const char* nB = has_next ? (const char*)g.Bt + (size_t)nxt.pn * tstep + (size_t)(nxt.pm >> 5) * g.bstride : cB;
#pragma unroll 1
        for (int t = 0; t < nt; t += 2) {
            const bool last = (t == nt - 2);
            const char* a1 = cA + (size_t)(t + 1) * kstep;
            const char* a2 = last ? nA : cA + (size_t)(t + 2) * kstep; const char* b2 = last ? nB : cB + (size_t)(t + 2) * kstep;
            const char* a3 = a2 + kstep; const char* b3 = b2 + kstep;
            if (last && has_next) S.a_ready(nxt);
            if constexpr (SP2) {
            PG8_LDB(B0, 0, 0); PG8_LDB(B1, 0, 1); PG8_SCHED; PG8_LDA(At, 0, 0); PG8_STAGE(PG8_SA(1, 1), a1 + hstep, voffA);
            PG8_WAIT_V(8); PG8_WAIT_L(0); PG8_BAR; PG8_MMA(0, 0, At, B0); PG8_MMA(0, 1, At, B1); PG8_BAR; PG8_SCHED;
            PG8_LDA(At, 0, 1); PG8_STAGE(PG8_SB(0, 0), b2, voffB); PG8_STAGE(PG8_SB(0, 1), b2 + hstep, voffB); PG8_STAGE(PG8_SA(0, 0), a2, voffA);
            PG8_WAIT_V(8); PG8_WAIT_L(0); PG8_BAR; PG8_MMA(1, 0, At, B0); PG8_MMA(1, 1, At, B1); PG8_BAR; PG8_SCHED;
            PG8_LDB(B0, 1, 0); PG8_LDB(B1, 1, 1); PG8_SCHED; PG8_LDA(At, 1, 0); PG8_STAGE(PG8_SA(0, 1), a2 + hstep, voffA);
            PG8_WAIT_V(8); PG8_WAIT_L(0); PG8_BAR; PG8_MMA(0, 0, At, B0); PG8_MMA(0, 1, At, B1); PG8_BAR; PG8_SCHED;
            PG8_LDA(At, 1, 1); PG8_STAGE(PG8_SB(1, 0), b3, voffB); PG8_STAGE(PG8_SB(1, 1), b3 + hstep, voffB); PG8_STAGE(PG8_SA(1, 0), a3, voffA);
            PG8_WAIT_V(8); PG8_WAIT_L(0); PG8_BAR; PG8_MMA(1, 0, At, B0); PG8_MMA(1, 1, At, B1); PG8_BAR; PG8_SCHED;
            } else {
            PG8_LDB(B0, 0, 0); PG8_SCHED; PG8_LDA(At, 0, 0); PG8_STAGE(PG8_SA(1, 1), a1 + hstep, voffA);
            PG8_WAIT_L(8); PG8_BAR; PG8_WAIT_L(0); PG8_MMA(0, 0, At, B0); PG8_BAR; PG8_SCHED;
            PG8_LDB(B1, 0, 1); PG8_STAGE(PG8_SB(0, 0), b2, voffB);
            PG8_BAR; PG8_WAIT_L(0); PG8_MMA(0, 1, At, B1); PG8_BAR;
            PG8_LDA(At, 0, 1); PG8_STAGE(PG8_SA(0, 0), a2, voffA);
            PG8_BAR; PG8_WAIT_L(0); PG8_MMA(1, 0, At, B0); PG8_BAR; PG8_SCHED;
            PG8_STAGE(PG8_SB(0, 1), b2 + hstep, voffB);
            PG8_WAIT_V(6); PG8_BAR; PG8_MMA(1, 1, At, B1); PG8_BAR;
            PG8_LDB(B0, 1, 0); PG8_SCHED; PG8_LDA(At, 1, 0); PG8_STAGE(PG8_SA(0, 1), a2 + hstep, voffA);
            PG8_WAIT_L(8); PG8_BAR; PG8_WAIT_L(0); PG8_MMA(0, 0, At, B0); PG8_BAR; PG8_SCHED;
            PG8_LDB(B1, 1, 1); PG8_STAGE(PG8_SB(1, 0), b3, voffB);
            PG8_BAR; PG8_WAIT_L(0); PG8_MMA(0, 1, At, B1); PG8_BAR;
            PG8_LDA(At, 1, 1); PG8_STAGE(PG8_SA(1, 0), a3, voffA);
            PG8_BAR; PG8_WAIT_L(0); PG8_MMA(1, 0, At, B0); PG8_BAR; PG8_SCHED;
            PG8_STAGE(PG8_SB(1, 1), b3 + hstep, voffB);
            PG8_WAIT_V(6); PG8_BAR; PG8_MMA(1, 1, At, B1); PG8_BAR;
            }
        }
        if constexpr (ALIGN_EPI) { if (wr == 0) PG8_BAR; }
        if constexpr (I8) {
_Pragma("unroll") for (int a_ = 0; a_ < 2; ++a_) _Pragma("unroll") for (int b_ = 0; b_ < 2; ++b_) _Pragma("unroll") for (int m_ = 0; m_ < 4; ++m_) _Pragma("unroll") for (int n_ = 0; n_ < 2; ++n_)
                acc[a_][b_][m_][n_] = __builtin_convertvector(__builtin_bit_cast(i32x4, acc[a_][b_][m_][n_]), f32x4); }
        if constexpr (FP8) asm volatile("s_nop 15\n\ts_nop 15" ::: "memory");
        if constexpr (Epi::PREFETCH) { int le = (int)threadIdx.x; asm volatile("" : "+v"(le)); le &= 63;
            E.run(acc, cur, ui & 1, wr, wc, le & 15, le >> 4); S.done(cur); }
        else if constexpr (!Epi::AFTER_DRAIN) { E(acc, cur, wr, wc, fr, fq); S.done(cur); }
        if (!has_next) break;
#pragma unroll
        for (int a = 0; a < 2; ++a)
#pragma unroll
            for (int b = 0; b < 2; ++b)
#pragma unroll
                for (int m = 0; m < 4; ++m)
#pragma unroll
                    for (int n = 0; n < 2; ++n) acc[a][b][m][n] = (f32x4){0.f, 0.f, 0.f, 0.f};
        cur = nxt; cA = nA; cB = nB; ++ui;
        if constexpr (Epi::PREFETCH) { int lp = (int)threadIdx.x; asm volatile("" : "+v"(lp)); E.prefetch(cur, ui & 1, wid, lp & 63); }
        if constexpr (ALIGN_EPI) { if (wr == 1) PG8_BAR; }
    }
    PG8_WAIT_V(0);
    if constexpr (!ALIGN_EPI) { if (wr == 0) PG8_BAR; }
    PG8_BAR;
    if constexpr (Epi::AFTER_DRAIN) { E.fused(acc, cur, wr, wc, fr, fq, lds, wid, lane); S.done(cur); }
#undef PG8_SA
#undef PG8_SB
#undef PG8_STAGE
#undef PG8_LDA
#undef PG8_LDB
#undef PG8_MMA
#undef PG8_WAIT_V
#undef PG8_WAIT_L
#undef PG8_BAR
#undef PG8_SCHED
}
struct GemmPair { const bf16_t* A0; const bf16_t* B0; int K0; const bf16_t* A1; const bf16_t* B1; int K1; };
template <class Epi, class Sched>
__device__ __forceinline__ void gemm_phase_pair(PG8_LAS unsigned char* lds, const GemmPair g, const Sched& S, const Epi& E) {
    const int tid = threadIdx.x, wid = __builtin_amdgcn_readfirstlane(tid >> 6), lane = tid & 63, wr = wid >> 2, wc = wid & 3, fr = lane & 15, fq = lane >> 4;
    int R0, C0; stage_rc(tid * 16, R0, C0); const int Rb0 = Epi::PERM ? ((R0 & ~31) + perm32(R0 & 31)) : R0;
    const unsigned ra2 = (unsigned)R0 * 2u, rb2 = (unsigned)Rb0 * 2u, c2 = (unsigned)C0 * 2u;
    const size_t kstep = (size_t)(BK * 2);
    const unsigned ldsw = (unsigned)wid * 1024u;
    const int aoff = lds_byte(wr * 64 + fr, fq * 8), boff = lds_byte(wc * 32 + fr, fq * 8);
#define PG8_SA(b, h) (((b) * 2 + (h)) * HTB)
#define PG8_SB(b, h) ((4 + (b) * 2 + (h)) * HTB)
#define PGP_STAGE(bufoff, gbase, rr2, Kx) do { const unsigned v_ = (rr2) * (unsigned)(Kx) + c2; const char* g0_ = (const char*)(gbase); const char* g1_ = g0_ + (size_t)128 * (size_t)(Kx); \
        __builtin_amdgcn_global_load_lds((const unsigned*)(g0_ + v_), (PG8_LAS unsigned*)(lds + (bufoff) + ldsw), 16, 0, 0); \
        __builtin_amdgcn_global_load_lds((const unsigned*)(g1_ + v_), (PG8_LAS unsigned*)(lds + (bufoff) + ldsw + 8192), 16, 0, 0); } while (0)
#define PG8_LDA(dst, b, h) do { _Pragma("unroll") for (int m = 0; m < 4; ++m) { dst[m].lo = *(const PG8_LAS i32x4*)(lds + PG8_SA(b, h) + aoff + m * 2048); dst[m].hi = *(const PG8_LAS i32x4*)(lds + PG8_SA(b, h) + aoff + m * 2048 + 1024); } } while (0)
#define PG8_LDB(dst, b, h) do { _Pragma("unroll") for (int n = 0; n < 2; ++n) { dst[n].lo = *(const PG8_LAS i32x4*)(lds + PG8_SB(b, h) + boff + n * 2048); dst[n].hi = *(const PG8_LAS i32x4*)(lds + PG8_SB(b, h) + boff + n * 2048 + 1024); } } while (0)
#define PG8_MMA(ai, bj, At, Bt) do { __builtin_amdgcn_s_setprio(1); _Pragma("unroll") for (int m = 0; m < 4; ++m) _Pragma("unroll") for (int n = 0; n < 2; ++n) { \
        const i32x4 bl_ = Bt[n].lo, bh_ = Bt[n].hi, al_ = At[m].lo, ah_ = At[m].hi; \
        acc[ai][bj][m][n] = __builtin_amdgcn_mfma_f32_16x16x32_bf16(__builtin_bit_cast(bf16x8, bl_), __builtin_bit_cast(bf16x8, al_), acc[ai][bj][m][n], 0, 0, 0); \
        acc[ai][bj][m][n] = __builtin_amdgcn_mfma_f32_16x16x32_bf16(__builtin_bit_cast(bf16x8, bh_), __builtin_bit_cast(bf16x8, ah_), acc[ai][bj][m][n], 0, 0, 0); } \
        __builtin_amdgcn_s_setprio(0); } while (0)
#define PG8_WAIT_V(n) asm volatile("s_waitcnt vmcnt(" #n ")" ::: "memory")
#define PG8_WAIT_L(n) asm volatile("s_waitcnt lgkmcnt(" #n ")" ::: "memory")
#define PG8_BAR __builtin_amdgcn_s_barrier()
#define PG8_SCHED __builtin_amdgcn_sched_barrier(0)
#define PGP_ZERO do { _Pragma("unroll") for (int a = 0; a < 2; ++a) _Pragma("unroll") for (int b = 0; b < 2; ++b) _Pragma("unroll") for (int m = 0; m < 4; ++m) _Pragma("unroll") for (int n = 0; n < 2; ++n) acc[a][b][m][n] = (f32x4){0.f, 0.f, 0.f, 0.f}; } while (0)
    Unit cur, nu; int j = 0;
    if (!S.next(0, cur)) return;
    f32x4 acc[2][2][4][2];
    PGP_ZERO;
    i32x8 At[4], Bf0[2], Bf1[2];
    int cK = g.K0; size_t hs = (size_t)256 * (size_t)cK;
    const char* cA = (const char*)g.A0 + (size_t)cur.pm * 2 * hs; const char* cB = (const char*)g.B0 + (size_t)cur.pn * 2 * hs;
    PGP_STAGE(PG8_SB(0, 0), cB, rb2, cK); PGP_STAGE(PG8_SB(0, 1), cB + hs, rb2, cK); PGP_STAGE(PG8_SA(0, 0), cA, ra2, cK); PGP_STAGE(PG8_SA(0, 1), cA + hs, ra2, cK);
    if (wr == 1) PG8_BAR;
    PG8_WAIT_V(2); PG8_BAR;
    PGP_STAGE(PG8_SB(1, 0), cB + kstep, rb2, cK); PGP_STAGE(PG8_SA(1, 0), cA + kstep, ra2, cK); PGP_STAGE(PG8_SB(1, 1), cB + hs + kstep, rb2, cK);
    PG8_WAIT_V(6); PG8_BAR;
    for (;;) {
        const int part = j & 1;
        bool has_next = true; int nK; const char* nA; const char* nB;
        if (part == 0) { nu = cur; nK = g.K1; nA = (const char*)g.A1 + (size_t)cur.pm * 512 * (size_t)nK; nB = (const char*)g.B1 + (size_t)cur.pn * 512 * (size_t)nK; }
        else { has_next = S.next((j + 1) >> 1, nu); nK = has_next ? g.K0 : cK;
            nA = has_next ? (const char*)g.A0 + (size_t)nu.pm * 512 * (size_t)nK : cA; nB = has_next ? (const char*)g.B0 + (size_t)nu.pn * 512 * (size_t)nK : cB; }
        const int nt = cK / BK; const size_t nhs = (size_t)256 * (size_t)nK;
#pragma unroll 1
        for (int t = 0; t < nt; t += 2) {
            const bool last = (t == nt - 2);
            const char* a1 = cA + (size_t)(t + 1) * kstep;
            const char* a2 = last ? nA : cA + (size_t)(t + 2) * kstep; const char* b2 = last ? nB : cB + (size_t)(t + 2) * kstep;
            const int K2 = last ? nK : cK; const size_t hs2 = last ? nhs : hs;
            const char* a3 = a2 + kstep; const char* b3 = b2 + kstep;
            PG8_LDB(Bf0, 0, 0); PG8_LDB(Bf1, 0, 1); PG8_SCHED; PG8_LDA(At, 0, 0); PGP_STAGE(PG8_SA(1, 1), a1 + hs, ra2, cK);
            PG8_WAIT_V(8); PG8_WAIT_L(0); PG8_BAR; PG8_MMA(0, 0, At, Bf0); PG8_MMA(0, 1, At, Bf1); PG8_BAR; PG8_SCHED;
            PG8_LDA(At, 0, 1); PGP_STAGE(PG8_SB(0, 0), b2, rb2, K2); PGP_STAGE(PG8_SB(0, 1), b2 + hs2, rb2, K2); PGP_STAGE(PG8_SA(0, 0), a2, ra2, K2);
            PG8_WAIT_V(8); PG8_WAIT_L(0); PG8_BAR; PG8_MMA(1, 0, At, Bf0); PG8_MMA(1, 1, At, Bf1); PG8_BAR; PG8_SCHED;
            PG8_LDB(Bf0, 1, 0); PG8_LDB(Bf1, 1, 1); PG8_SCHED; PG8_LDA(At, 1, 0); PGP_STAGE(PG8_SA(0, 1), a2 + hs2, ra2, K2);
            PG8_WAIT_V(8); PG8_WAIT_L(0); PG8_BAR; PG8_MMA(0, 0, At, Bf0); PG8_MMA(0, 1, At, Bf1); PG8_BAR; PG8_SCHED;
            PG8_LDA(At, 1, 1); PGP_STAGE(PG8_SB(1, 0), b3, rb2, K2); PGP_STAGE(PG8_SB(1, 1), b3 + hs2, rb2, K2); PGP_STAGE(PG8_SA(1, 0), a3, ra2, K2);
            PG8_WAIT_V(8); PG8_WAIT_L(0); PG8_BAR; PG8_MMA(1, 0, At, Bf0); PG8_MMA(1, 1, At, Bf1); PG8_BAR; PG8_SCHED;
        }
        if (wr == 0) PG8_BAR;
        if (part == 0) E.mid(acc, cur, wr, wc, fr, fq); else E.fin(acc, cur, wr, wc, fr, fq);
        if (!has_next) break;
        if (part == 1) PGP_ZERO;
        cur = nu; cA = nA; cB = nB; cK = nK; hs = nhs; ++j;
        if (wr == 1) PG8_BAR;
    }
    PG8_WAIT_V(0);
    PG8_BAR;
#undef PG8_SA
#undef PG8_SB
#undef PGP_STAGE
#undef PG8_LDA
#undef PG8_LDB
#undef PG8_MMA
#undef PG8_WAIT_V
#undef PG8_WAIT_L
#undef PG8_BAR
#undef PG8_SCHED
#undef PGP_ZERO
}
}
#define PG8_SP2 true
#define PG8_ALIGN true
#define GAS __attribute__((address_space(1)))
#define LAS __attribute__((address_space(3)))
typedef unsigned short bf16;
typedef unsigned v4u __attribute__((ext_vector_type(4)));
typedef float f32x4 __attribute__((ext_vector_type(4)));
typedef short bf16x8 __attribute__((ext_vector_type(8)));
typedef GAS unsigned gu32;
typedef GAS unsigned long long gu64;
#define RLX_AGENT __ATOMIC_RELAXED, __HIP_MEMORY_SCOPE_AGENT
#define LDS_WAIT() asm volatile("s_waitcnt lgkmcnt(0)" ::: "memory")
#define VM_WAIT() asm volatile("s_waitcnt vmcnt(0)" ::: "memory")
__device__ __forceinline__ unsigned long long rt() { return __builtin_amdgcn_s_memrealtime(); }
__device__ __forceinline__ unsigned pk2(float lo, float hi) { typedef float f32x2_ __attribute__((ext_vector_type(2))); typedef __bf16 bf16x2_ __attribute__((ext_vector_type(2)));
    const f32x2_ v = {lo, hi}; return __builtin_bit_cast(unsigned, __builtin_convertvector(v, bf16x2_)); }
__device__ __forceinline__ unsigned f2bf(float f) { return pk2(f, 0.f) & 0xffffu; }
#define XB_TMO      128
#define XB_XCNT(j)  (256  + 64 * (j))
#define XB_XSUB(j)  (1280 + 64 * (j))
#define XB_XGEN(j)  (2304 + 64 * (j))
#define XB_TOP      3328
#define XB_TOPGEN   3392
#define XB_LSUB(j)  (3520 + 64 * (j))
#define XB_LGEN(j)  (4544 + 64 * (j))
#define XCD_BAR_WORDS 5568
#define XB_SPIN_CAP (1u << 18)

__device__ __forceinline__ unsigned xb_ld(unsigned* p)              { return __hip_atomic_load(p, __ATOMIC_RELAXED, __HIP_MEMORY_SCOPE_AGENT); }
__device__ __forceinline__ unsigned xb_add(unsigned* p, unsigned v) { return __hip_atomic_fetch_add(p, v, __ATOMIC_RELAXED, __HIP_MEMORY_SCOPE_AGENT); }
__device__ __forceinline__ unsigned xb_xcc_id() { return (unsigned)__builtin_amdgcn_s_getreg((3 << 11) | 20) & 0xFu; }
#define XB_SPIN(cond, bar) do { unsigned _sp = 0; while (cond) { __builtin_amdgcn_s_sleep(1); \
    if ((++_sp & 255u) == 0u) { if (xb_ld(&(bar)[XB_TMO])) break; if (_sp > XB_SPIN_CAP) { atomicAdd(&(bar)[XB_TMO], 1u); break; } } } } while (0)

struct XcdBarrier {
    unsigned* bar; unsigned x;
    volatile LAS unsigned* st;
};

__device__ __forceinline__ XcdBarrier xcd_barrier_post(unsigned* bar, volatile LAS unsigned* st) {
    XcdBarrier b; b.bar = bar; b.x = xb_xcc_id(); b.st = st;
    if (threadIdx.x == 0) st[2] = xb_add(&bar[XB_XCNT(b.x)], 1u);
    return b;
}
__device__ __forceinline__ void xcd_barrier_complete(unsigned* bar, unsigned x, unsigned& nloc, unsigned& nx, unsigned& slotw) {
    const unsigned G = gridDim.x * gridDim.y * gridDim.z;
    unsigned sum, cnt, mine, bad, slot, sp = 0u; bool done = false;
    for (;;) {
        sum = 0u; cnt = 0u; mine = 0u; bad = 0u; slot = 0u;
#pragma unroll
        for (unsigned j = 0; j < 16; ++j) { const unsigned c = xb_ld(&bar[XB_XCNT(j)]); sum += c; cnt += (c > 0u) ? 1u : 0u; mine = (j == x) ? c : mine; bad |= (c != 0u && c != 32u) ? 1u : 0u; slot += (c > 0u && j < x) ? 1u : 0u; }
        if (sum == G) { done = true; break; }
        __builtin_amdgcn_s_sleep(1);
        if ((++sp & 255u) == 0u) { if (xb_ld(&bar[XB_TMO])) break; if (sp > XB_SPIN_CAP) { atomicAdd(&bar[XB_TMO], 1u); break; } }
    }
    nloc = mine > 0u ? mine : 1u; nx = cnt > 0u ? cnt : 1u;
    slotw = (done && G == 256u && cnt == 8u && bad == 0u) ? (0x10000u | slot) : 0u;
}

template <bool WB = true> __device__ __forceinline__ void xcd_barrier(const XcdBarrier& b) {
    asm volatile("s_waitcnt vmcnt(0)" ::: "memory");
    __syncthreads();
    if (threadIdx.x == 0) {
        unsigned* bar = b.bar;
        __builtin_amdgcn_s_waitcnt(0);
        unsigned nloc = b.st[0], nx = b.st[1];
        if (nloc == 0u) { unsigned slotw; xcd_barrier_complete(bar, b.x, nloc, nx, slotw); b.st[0] = nloc; b.st[1] = nx;
            b.st[3] = slotw ? (0x10000u | (b.st[2] * 8u + (slotw & 0xffffu))) : 0u; }
        const unsigned old = xb_add(&bar[XB_XSUB(b.x)], 1u);
        const unsigned gen = old / nloc;
        if (old + 1u == (gen + 1u) * nloc) {
            if constexpr (WB) __builtin_amdgcn_fence(__ATOMIC_RELEASE, "agent");
            asm volatile("s_waitcnt vmcnt(0)" ::: "memory");
            const unsigned og = xb_add(&bar[XB_TOP], 1u);
            const unsigned tg = og / nx;
            asm volatile("buffer_inv sc1" ::: "memory");
            if (og + 1u == (tg + 1u) * nx) xb_add(&bar[XB_TOPGEN], 1u);
            else XB_SPIN(xb_ld(&bar[XB_TOPGEN]) == tg, bar);
            xb_add(&bar[XB_XGEN(b.x)], 1u);
            asm volatile("s_waitcnt vmcnt(0)" ::: "memory");
        } else {
            asm volatile("buffer_inv sc1" ::: "memory");
            XB_SPIN(xb_ld(&bar[XB_XGEN(b.x)]) == gen, bar);
            asm volatile("s_waitcnt vmcnt(0)" ::: "memory");
        }
    }
    __syncthreads();
}

__device__ __forceinline__ void xcd_local_barrier(const XcdBarrier& b) {
    asm volatile("s_waitcnt vmcnt(0)" ::: "memory");
    __syncthreads();
    if (threadIdx.x == 0) {
        unsigned* bar = b.bar;
        __builtin_amdgcn_s_waitcnt(0);
        const unsigned nloc = b.st[0];
        const unsigned old = xb_add(&bar[XB_LSUB(b.x)], 1u);
        const unsigned gen = old / nloc;
        asm volatile("buffer_inv sc1" ::: "memory");
        if (old + 1u == (gen + 1u) * nloc) xb_add(&bar[XB_LGEN(b.x)], 1u);
        else XB_SPIN(xb_ld(&bar[XB_LGEN(b.x)]) == gen, bar);
        asm volatile("s_waitcnt vmcnt(0)" ::: "memory");
    }
    __syncthreads();
}

constexpr int NWAVES = 8;
constexpr int BATCH = 4, SEQ = 8192, D = 1024, M = BATCH * SEQ, FF = 2816, NH = 8, DK = 128, DV = 128;
constexpr int IN_COLS = 7712, NMOD = 9;
constexpr int N_IN1 = 18 * 256, N_IN2 = 12 * 256;
constexpr float EPS = 1e-6f;
#ifndef MK_SPLIT
#define MK_SPLIT 0
#endif
constexpr int NPHASE = 19;

constexpr size_t MiB = 1u << 20;
constexpr size_t WS_CTL = 0, CTL_ZERO_BYTES = 64 * 1024;
constexpr size_t WS_MOD = 256 * 1024;
constexpr size_t WS_WUP1 = 1 * MiB, WS_WDN1 = 12 * MiB, WS_WUP2 = 18 * MiB, WS_WDN2 = 29 * MiB, WS_WIN1 = 35 * MiB, WS_WIN2 = 45 * MiB, WS_WA = 51 * MiB, WS_WB = 52 * MiB, WS_WO = 54 * MiB;
constexpr size_t WS_XN = 64 * MiB;
constexpr size_t WS_HID = 128 * MiB;
constexpr size_t WS_QRAW = 128 * MiB, WS_KRAW = 192 * MiB, WS_VRAW = 256 * MiB;
constexpr size_t WS_CAB = 320 * MiB, WS_CV = 352 * MiB;
constexpr size_t WS_QF = 384 * MiB;
constexpr size_t WS_YA = 448 * MiB;
constexpr size_t WS_BA = 480 * MiB;
constexpr size_t WS_GB = 484 * MiB;
constexpr size_t WS_SSQ = 56 * MiB;
constexpr size_t WS_BW = 17 * MiB + 512 * 1024;
constexpr size_t BW_UP1 = 0, BW_IN1 = 96 * 1024, BW_IN2 = 176 * 1024, BW_UP2 = 224 * 1024;
constexpr size_t WS_CW = 34 * MiB + 512 * 1024;
constexpr size_t WS_HB2 = 304 * MiB, WS_HB3 = 384 * MiB;
constexpr size_t WS_WDN1F8 = 488 * MiB;
constexpr size_t WS_WUP1I8 = 491 * MiB, WS_WUP2I8 = 497 * MiB;
constexpr size_t WS_CF = 503 * MiB;
constexpr size_t WS_WIN2I8 = 504 * MiB;
constexpr size_t WS_CF3 = 507 * MiB, WS_RSX = 507 * MiB + 512 * 1024;
constexpr size_t WS_WIN1I8 = 508 * MiB, WS_CF2 = 507 * MiB + 64 * 1024;
constexpr size_t WS_RSTD2 = 507 * MiB + 640 * 1024, WS_BWF = 507 * MiB + 768 * 1024;
constexpr size_t WS_WIN1F = 96 * MiB;
constexpr size_t WS_END = 511 * MiB;
constexpr size_t WS_KF = WS_QRAW, WS_VF = WS_KRAW;
constexpr size_t WS_OF = WS_VRAW, WS_OB = WS_KRAW;
constexpr size_t WS_SGA = WS_QF, WS_SGB = WS_QRAW;
static_assert(WS_WUP1 + (size_t)2 * FF * D * 2 <= WS_WDN1 && WS_WDN1 + (size_t)D * FF * 2 <= WS_WUP2 && WS_WIN1 + (size_t)N_IN1 * D * 2 <= WS_WIN2 && WS_WIN2 + (size_t)N_IN2 * D * 2 <= WS_WA && WS_WO + 2 * MiB <= WS_XN, "weights map");
static_assert(WS_HID + (size_t)M * FF * 2 <= WS_CAB + 64 * MiB && WS_GB + (size_t)4 * M * 8 * 4 <= WS_END, "activation map");

constexpr int RING_OFF = 0, RING_BYTES = 131072;
constexpr int LDS_BYTES = 163840;
constexpr int LDSCTL_OFF = LDS_BYTES - 512, MISC_OFF = LDSCTL_OFF + 320;
__device__ __forceinline__ unsigned vword() { extern __shared__ __attribute__((aligned(16))) unsigned char lds_raw[]; return (unsigned)__builtin_amdgcn_readfirstlane((int)*(volatile LAS unsigned*)((LAS unsigned char*)lds_raw + MISC_OFF + 44)); }
__device__ __forceinline__ int vblk() { const unsigned w = vword(); return (w >> 16) ? (int)(w & 0xffffu) : (int)blockIdx.x; }
__device__ __forceinline__ int rowmap(int ml) { return (gridDim.x == 256) ? ((((ml >> 3) & 7) << 12) | (((ml >> 11) & 15) << 8) | (((ml >> 6) & 31) << 3) | (ml & 7)) : ml; }
__device__ __forceinline__ int itemmap(int il) { return (gridDim.x == 256) ? ((((il >> 3) & 7) << 13) | (((il >> 11) & 31) << 8) | (((il >> 6) & 31) << 3) | (il & 7)) : il; }

struct Args { const float* in[23]; float* out; unsigned char* ws; int ph_lo, ph_hi; };
enum { I_X = 0, I_C, I_WADA, I_BADA, I_NF1, I_WUP1, I_WDN1, I_NMIX, I_WIN, I_CONVA, I_CONVDN, I_ALF, I_DTF, I_ALB, I_DTB, I_DNNORM, I_WAO, I_WBO, I_WOUT, I_NF2, I_WUP2, I_WDN2, I_NFIN };

template <int CTRL, int ROW_MASK = 0xf> __device__ __forceinline__ float dpp_add(float v) {
    return v + __builtin_bit_cast(float, __builtin_amdgcn_update_dpp(0, __builtin_bit_cast(int, v), CTRL, ROW_MASK, 0xf, false)); }
__device__ __forceinline__ float sum16(float v) {
    v = dpp_add<0x128>(v); v = dpp_add<0x124>(v); v = dpp_add<0x122>(v); v = dpp_add<0x121>(v);
    return v;
}
__device__ __forceinline__ float wave_sum(float v) {
    v = sum16(v);
    return (__builtin_bit_cast(float, __builtin_amdgcn_readlane(__builtin_bit_cast(int, v), 0)) + __builtin_bit_cast(float, __builtin_amdgcn_readlane(__builtin_bit_cast(int, v), 16)))
      + (__builtin_bit_cast(float, __builtin_amdgcn_readlane(__builtin_bit_cast(int, v), 32)) + __builtin_bit_cast(float, __builtin_amdgcn_readlane(__builtin_bit_cast(int, v), 48)));
}
template <int CTRL> __device__ __forceinline__ float dpp_max(float v) { return __builtin_fmaxf(v, __builtin_bit_cast(float, __builtin_amdgcn_update_dpp(__builtin_bit_cast(int, v), __builtin_bit_cast(int, v), CTRL, 0xf, 0xf, false))); }
__device__ __forceinline__ float wave_max(float v) {
    v = dpp_max<0x128>(v); v = dpp_max<0x124>(v); v = dpp_max<0x122>(v); v = dpp_max<0x121>(v);
    return __builtin_fmaxf(__builtin_fmaxf(__builtin_bit_cast(float, __builtin_amdgcn_readlane(__builtin_bit_cast(int, v), 0)), __builtin_bit_cast(float, __builtin_amdgcn_readlane(__builtin_bit_cast(int, v), 16))),
                           __builtin_fmaxf(__builtin_bit_cast(float, __builtin_amdgcn_readlane(__builtin_bit_cast(int, v), 32)), __builtin_bit_cast(float, __builtin_amdgcn_readlane(__builtin_bit_cast(int, v), 48))));
}
__device__ __forceinline__ unsigned i8x4(float a, float b, float c, float d) {
    const int qa = (int)__builtin_rintf(a), qb = (int)__builtin_rintf(b), qc = (int)__builtin_rintf(c), qd = (int)__builtin_rintf(d);
    return ((unsigned)qa & 0xffu) | (((unsigned)qb & 0xffu) << 8) | (((unsigned)qc & 0xffu) << 16) | ((unsigned)qd << 24); }
__device__ __forceinline__ float bf2f(unsigned short b) { return __uint_as_float((unsigned)b << 16); }
__device__ __forceinline__ void unpack8f(v4u w, float* f) {
    f[0] = __uint_as_float(w.x << 16); f[1] = __uint_as_float(w.x & 0xffff0000u); f[2] = __uint_as_float(w.y << 16); f[3] = __uint_as_float(w.y & 0xffff0000u);
    f[4] = __uint_as_float(w.z << 16); f[5] = __uint_as_float(w.z & 0xffff0000u); f[6] = __uint_as_float(w.w << 16); f[7] = __uint_as_float(w.w & 0xffff0000u); }
__device__ __forceinline__ v4u pack8f(const float* f) { v4u w; w.x = pk2(f[0], f[1]); w.y = pk2(f[2], f[3]); w.z = pk2(f[4], f[5]); w.w = pk2(f[6], f[7]); return w; }
__device__ __forceinline__ float sigmoidf_(float x) { return __builtin_amdgcn_rcpf(1.0f + __expf(-x)); }
__device__ __forceinline__ float siluf_(float x) { return x * __builtin_amdgcn_rcpf(1.0f + __expf(-x)); }

using pg8::f8x4; using pg8::W8_SCALE; using pg8::H8_SCALE;
__device__ __forceinline__ void transpose_item(const float* W, int N, int K, bf16* dst0  , int k0, int n0, LAS float* scr, int lane, unsigned char* dst8 = nullptr  ) {
#pragma unroll 8
    for (int i = 0; i < 32; ++i) { const int kk = 2 * i + (lane >> 5); scr[kk * 33 + (lane & 31)] = W[(size_t)(k0 + kk) * N + n0 + (lane & 31)]; }
    LDS_WAIT(); asm volatile("" ::: "memory");
    const int c = lane & 7;
#pragma unroll
    for (int j = 0; j < 4; ++j) { const int n = (lane >> 3) + 8 * j; const LAS float* s = scr + (8 * c) * 33 + n;
        v4u o; o.x = pk2(s[0 * 33], s[1 * 33]); o.y = pk2(s[2 * 33], s[3 * 33]); o.z = pk2(s[4 * 33], s[5 * 33]); o.w = pk2(s[6 * 33], s[7 * 33]);
        *(GAS v4u*)(dst0 + (size_t)n * K + k0 + 8 * c) = o;
        if (dst8) { typedef unsigned u32x2_ __attribute__((ext_vector_type(2)));
            *(GAS u32x2_*)(dst8 + (size_t)n * K + k0 + 8 * c) = (u32x2_){f8x4(W8_SCALE * s[0 * 33], W8_SCALE * s[1 * 33], W8_SCALE * s[2 * 33], W8_SCALE * s[3 * 33]), f8x4(W8_SCALE * s[4 * 33], W8_SCALE * s[5 * 33], W8_SCALE * s[6 * 33], W8_SCALE * s[7 * 33])}; } }
    LDS_WAIT(); asm volatile("" ::: "memory");
}
__device__ __forceinline__ int up_row(int n0) { const int part = n0 / FF, j = n0 % FF; return 256 * (j / 128) + 128 * part + (j % 128); }

__device__ __forceinline__ void phase_prologue(const Args& a, LAS unsigned char* lds, int tid, int lane, int wave) {
    unsigned char* ws = a.ws;
    LAS float* cact = (LAS float*)lds;
    LAS float* red = (LAS float*)(lds + 16384);
    for (int i = tid; i < 4096; i += 512) cact[i] = siluf_(a.in[I_C][i]);
    __syncthreads();
    float* mod = (float*)(ws + WS_MOD);
    for (int it = blockIdx.x; it < (NMOD * D) / 32; it += gridDim.x) {
        const int n0 = it * 32, col = tid & 31, kg = tid >> 5;
        float a0 = 0.f, a1 = 0.f, a2 = 0.f, a3 = 0.f;
        const float* wp = a.in[I_WADA] + (size_t)(kg * 64) * (NMOD * D) + n0 + col;
        float wv[64];
#pragma unroll
        for (int kk = 0; kk < 64; ++kk) wv[kk] = wp[(size_t)kk * (NMOD * D)];
#pragma unroll
        for (int kk = 0; kk < 64; ++kk) { const float w = wv[kk]; const int k = kg * 64 + kk;
            a0 += cact[k] * w; a1 += cact[1024 + k] * w; a2 += cact[2048 + k] * w; a3 += cact[3072 + k] * w; }
        red[(kg * 4 + 0) * 32 + col] = a0; red[(kg * 4 + 1) * 32 + col] = a1; red[(kg * 4 + 2) * 32 + col] = a2; red[(kg * 4 + 3) * 32 + col] = a3;
        __syncthreads();
        if (tid < 128) { const int b = tid >> 5, c2 = tid & 31; float s = 0.f;
#pragma unroll
            for (int g = 0; g < 16; ++g) s += red[(g * 4 + b) * 32 + c2];
            mod[b * (NMOD * D) + n0 + c2] = s + a.in[I_BADA][n0 + c2]; }
        __syncthreads();
    }
    __syncthreads();
    LAS float* scr = (LAS float*)(lds + wave * 16384);
    const int gw = blockIdx.x * NWAVES + wave, NGW = gridDim.x * NWAVES;
    constexpr int I_UP = (D / 64) * (2 * FF / 32), I_DN = (FF / 64) * (D / 32), I_IN = (D / 64) * (IN_COLS / 32), I_A = (512 / 64) * (D / 32), I_B = (D / 64) * (D / 32);
    constexpr int NITEMS = 2 * I_UP + 2 * I_DN + I_IN + I_A + 2 * I_B;
    for (int it = gw; it < NITEMS; it += NGW) {
        int r = it;
        if (r < 2 * I_UP) { const int wsel = r / I_UP; r %= I_UP; const int nblk = 2 * FF / 32, kb = r / nblk, nb = r % nblk;
            const float* W = a.in[wsel ? I_WUP2 : I_WUP1]; bf16* dst = (bf16*)(ws + (wsel ? WS_WUP2 : WS_WUP1));
            transpose_item(W, 2 * FF, D, dst + (size_t)up_row(32 * nb) * D, 64 * kb, 32 * nb, scr, lane); continue; }
        r -= 2 * I_UP;
        if (r < 2 * I_DN) { const int wsel = r / I_DN; r %= I_DN; const int nblk = D / 32, kb = r / nblk, nb = r % nblk;
            const float* W = a.in[wsel ? I_WDN2 : I_WDN1]; bf16* dst = (bf16*)(ws + (wsel ? WS_WDN2 : WS_WDN1));
            transpose_item(W, D, FF, dst + (size_t)(32 * nb) * FF, 64 * kb, 32 * nb, scr, lane); continue; }
        r -= 2 * I_DN;
        if (r < I_IN) { const int nblk = IN_COLS / 32, kb = r / nblk, nb = r % nblk, n0 = 32 * nb;
            bf16* dst;
            if (n0 < 512) dst = (bf16*)(ws + WS_WIN1) + (size_t)(1024 + n0) * D;
            else if (n0 < 1024) { const int j = n0 - 512; dst = (bf16*)(ws + WS_WIN1) + (size_t)(256 * (j / 128) + (j % 128)) * D; }
            else if (n0 < 1536) { const int j = n0 - 1024; dst = (bf16*)(ws + WS_WIN1) + (size_t)(256 * (j / 128) + 128 + (j % 128)) * D; }
            else if (n0 < 4608) dst = (bf16*)(ws + WS_WIN1) + (size_t)n0 * D;
            else if (n0 < 5632) dst = (bf16*)(ws + WS_WIN2) + (size_t)(n0 - 4608) * D;
            else if (n0 < 5664) dst = (bf16*)(ws + WS_WIN1) + (size_t)(4608 + n0 - 5632) * D;
            else dst = (bf16*)(ws + WS_WIN2) + (size_t)(1024 + n0 - 5664) * D;
            transpose_item(a.in[I_WIN], IN_COLS, D, dst, 64 * kb, n0, scr, lane); continue; }
        r -= I_IN;
        if (r < I_A) { const int nblk = D / 32, kb = r / nblk, nb = r % nblk; transpose_item(a.in[I_WAO], D, 512, (bf16*)(ws + WS_WA) + (size_t)(32 * nb) * 512, 64 * kb, 32 * nb, scr, lane); continue; }
        r -= I_A;
        { const int wsel = r / I_B; r %= I_B; const int nblk = D / 32, kb = r / nblk, nb = r % nblk;
          transpose_item(a.in[wsel ? I_WOUT : I_WBO], D, D, (bf16*)(ws + (wsel ? WS_WO : WS_WB)) + (size_t)(32 * nb) * D, 64 * kb, 32 * nb, scr, lane); }
    }
}

__device__ __forceinline__ void phase_first(const Args& a, const float* mod, bf16* dst, int tid, int lane, int wave) {
    unsigned char* ws = a.ws;
    const int gw = blockIdx.x * NWAVES + wave, NGW = gridDim.x * NWAVES;
    float* ssq0 = (float*)(ws + WS_SSQ);
    const float* nw = a.in[I_NF1];
    for (int m0 = gw; m0 < M; m0 += 4 * NGW) {
        f32x4 v[4][4];
#pragma unroll
        for (int q = 0; q < 4; ++q) { const int mq = (m0 + q * NGW < M) ? m0 + q * NGW : m0; const GAS f32x4* xr = (const GAS f32x4*)(a.in[I_X] + (size_t)mq * D) + lane;
#pragma unroll
            for (int j = 0; j < 4; ++j) v[q][j] = xr[64 * j]; }
#pragma unroll
        for (int q = 0; q < 4; ++q) { const int m = m0 + q * NGW; if (m >= M) break; const int b = m / SEQ; const float* sc = mod + b * (NMOD * D) + 1 * D; float s = 0.f;
#pragma unroll
            for (int j = 0; j < 4; ++j) s += (v[q][j].x * v[q][j].x + v[q][j].y * v[q][j].y) + (v[q][j].z * v[q][j].z + v[q][j].w * v[q][j].w);
            s = wave_sum(s);
            f32x4 y[4]; float amax = 1e-30f;
#pragma unroll
            for (int j = 0; j < 4; ++j) { const int c = 4 * lane + 256 * j; const f32x4 w = *(const f32x4*)(nw + c), s1 = *(const f32x4*)(sc + c);
                y[j] = v[q][j] * w * (s1 + 1.0f);
                amax = __builtin_fmaxf(__builtin_fmaxf(amax, __builtin_fmaxf(__builtin_fabsf(y[j].x), __builtin_fabsf(y[j].y))), __builtin_fmaxf(__builtin_fabsf(y[j].z), __builtin_fabsf(y[j].w))); }
            amax = wave_max(amax);
            const float qs = 127.f * __builtin_amdgcn_rcpf(amax);
            if (lane == 0) ssq0[m] = __builtin_amdgcn_rsqf(s * (1.f / D) + EPS) * amax * (1.f / 127.f);
            GAS unsigned* o4 = (GAS unsigned*)((unsigned char*)dst + (size_t)m * D) + lane;
#pragma unroll
            for (int j = 0; j < 4; ++j) o4[64 * j] = i8x4(y[j].x * qs, y[j].y * qs, y[j].z * qs, y[j].w * qs); }
    }
    for (int it = gw; it < 2 * (2 * FF / 4); it += NGW) {
        const int sel = it >= 2 * FF / 4, r0 = 4 * (sel ? it - 2 * FF / 4 : it);
        const bf16* W = (const bf16*)(ws + (sel ? WS_WUP2 : WS_WUP1)); float* out = (float*)(ws + WS_BW + (sel ? BW_UP2 : BW_UP1)); const int shi = sel ? 6 : 0;
        v4u wr_[4][2];
#pragma unroll
        for (int q = 0; q < 4; ++q) { wr_[q][0] = *(const GAS v4u*)(W + (size_t)(r0 + q) * D + 16 * lane); wr_[q][1] = *(const GAS v4u*)(W + (size_t)(r0 + q) * D + 16 * lane + 8); }
        f32x4 shv[4][4];
#pragma unroll
        for (int b = 0; b < 4; ++b)
#pragma unroll
            for (int e = 0; e < 4; ++e) shv[b][e] = *(const f32x4*)(mod + b * (NMOD * D) + shi * D + 16 * lane + 4 * e);
#pragma unroll
        for (int q = 0; q < 4; ++q) { float wv[16]; unpack8f(wr_[q][0], wv); unpack8f(wr_[q][1], wv + 8); float acc[4];
#pragma unroll
            for (int b = 0; b < 4; ++b) { float s = 0.f;
#pragma unroll
                for (int e = 0; e < 4; ++e) s += (wv[4 * e] * shv[b][e].x + wv[4 * e + 1] * shv[b][e].y) + (wv[4 * e + 2] * shv[b][e].z + wv[4 * e + 3] * shv[b][e].w);
                acc[b] = wave_sum(s); }
            if (lane < 4) out[(size_t)lane * (2 * FF) + r0 + q] = (lane == 0) ? acc[0] : (lane == 1) ? acc[1] : (lane == 2) ? acc[2] : acc[3];
            float amax = 1e-30f;
#pragma unroll
            for (int e = 0; e < 16; ++e) amax = __builtin_fmaxf(amax, __builtin_fabsf(wv[e]));
            amax = wave_max(amax);
            const float qs = 127.f * __builtin_amdgcn_rcpf(amax);
            v4u o; o.x = i8x4(wv[0] * qs, wv[1] * qs, wv[2] * qs, wv[3] * qs); o.y = i8x4(wv[4] * qs, wv[5] * qs, wv[6] * qs, wv[7] * qs);
            o.z = i8x4(wv[8] * qs, wv[9] * qs, wv[10] * qs, wv[11] * qs); o.w = i8x4(wv[12] * qs, wv[13] * qs, wv[14] * qs, wv[15] * qs);
            *(GAS v4u*)(ws + (sel ? WS_WUP2I8 : WS_WUP1I8) + (size_t)(r0 + q) * D + 16 * lane) = o;
            if (lane == 0) ((float*)(ws + WS_CF))[sel * (2 * FF) + r0 + q] = amax * (1.f / 127.f); }
    }
    for (int r = gw; r < 3072; r += NGW) {
        const bf16* W = (const bf16*)(ws + WS_WIN1) + (size_t)(r + 1536) * D + 16 * lane;
        const v4u w0 = *(const GAS v4u*)W, w1 = *(const GAS v4u*)(W + 8);
        float wv[16]; unpack8f(w0, wv); unpack8f(w1, wv + 8);
        float amax = 1e-30f;
#pragma unroll
        for (int e = 0; e < 16; ++e) amax = __builtin_fmaxf(amax, __builtin_fabsf(wv[e]));
        amax = wave_max(amax);
        const float qs = 127.f * __builtin_amdgcn_rcpf(amax);
        v4u o; o.x = i8x4(wv[0] * qs, wv[1] * qs, wv[2] * qs, wv[3] * qs); o.y = i8x4(wv[4] * qs, wv[5] * qs, wv[6] * qs, wv[7] * qs);
        o.z = i8x4(wv[8] * qs, wv[9] * qs, wv[10] * qs, wv[11] * qs); o.w = i8x4(wv[12] * qs, wv[13] * qs, wv[14] * qs, wv[15] * qs);
        *(GAS v4u*)(ws + WS_WIN1I8 + (size_t)r * D + 16 * lane) = o;
        if (lane == 0) ((float*)(ws + WS_CF2))[r] = amax * (1.f / 127.f);
    }
    for (int r = gw; r < N_IN2; r += NGW) {
        const int gt = (r - 1024) >> 8, gw_ = (r - 1024) & 255; const int src = (r < 1024) ? r : (gw_ < 128 ? 1024 + 128 * gt + gw_ : 2048 + 128 * gt + (gw_ - 128));
        const bf16* W = (const bf16*)(ws + WS_WIN2) + (size_t)src * D + 16 * lane;
        const v4u w0 = *(const GAS v4u*)W, w1 = *(const GAS v4u*)(W + 8);
        float wv[16]; unpack8f(w0, wv); unpack8f(w1, wv + 8);
        float amax = 1e-30f;
#pragma unroll
        for (int e = 0; e < 16; ++e) amax = __builtin_fmaxf(amax, __builtin_fabsf(wv[e]));
        amax = wave_max(amax);
        const float qs = 127.f * __builtin_amdgcn_rcpf(amax);
        v4u o; o.x = i8x4(wv[0] * qs, wv[1] * qs, wv[2] * qs, wv[3] * qs); o.y = i8x4(wv[4] * qs, wv[5] * qs, wv[6] * qs, wv[7] * qs);
        o.z = i8x4(wv[8] * qs, wv[9] * qs, wv[10] * qs, wv[11] * qs); o.w = i8x4(wv[12] * qs, wv[13] * qs, wv[14] * qs, wv[15] * qs);
        *(GAS v4u*)(ws + WS_WIN2I8 + (size_t)r * D + 16 * lane) = o;
        if (lane == 0) ((float*)(ws + WS_CF3))[r] = amax * (1.f / 127.f);
    }
    for (int r = gw; r < 1568; r += NGW) {
        const int sr = (r < 1536) ? r : r + 3072;
        const bf16* W = (const bf16*)(ws + WS_WIN1) + (size_t)sr * D + 16 * lane;
        const v4u w0 = *(const GAS v4u*)W, w1 = *(const GAS v4u*)(W + 8);
        float wv[16]; unpack8f(w0, wv); unpack8f(w1, wv + 8);
        float bs[4];
#pragma unroll
        for (int b = 0; b < 4; ++b) { float f[16]; float sacc = 0.f;
#pragma unroll
            for (int e4 = 0; e4 < 4; ++e4) { const int c = 16 * lane + 4 * e4;
                const f32x4 nwv = *(const f32x4*)(a.in[I_NMIX] + c), scv = *(const f32x4*)(mod + b * (NMOD * D) + 4 * D + c), shv = *(const f32x4*)(mod + b * (NMOD * D) + 3 * D + c);
#pragma unroll
                for (int j = 0; j < 4; ++j) { f[4 * e4 + j] = wv[4 * e4 + j] * (nwv[j] * (1.0f + scv[j])); sacc += wv[4 * e4 + j] * shv[j]; } }
            bs[b] = wave_sum(sacc);
            GAS v4u* o = (GAS v4u*)(ws + WS_WIN1F + ((size_t)(b * 1568 + r) * D + 16 * lane) * 2); o[0] = pack8f(f); o[1] = pack8f(f + 8); }
        if (lane < 4) ((float*)(ws + WS_BWF))[lane * 1568 + r] = (lane == 0) ? bs[0] : (lane == 1) ? bs[1] : (lane == 2) ? bs[2] : bs[3];
    }
    float* cwp = (float*)(ws + WS_CW);
    for (int i = blockIdx.x * 512 + tid; i < 2 * 4 * D; i += gridDim.x * 512) { const int k = i >> 12, b = (i >> 10) & 3, c = i & 1023;
        cwp[i] = a.in[k ? I_NF2 : I_NMIX][c] * (1.0f + mod[b * (NMOD * D) + (k ? 7 : 4) * D + c]); }
}
__device__ __forceinline__ void phase_mix_norm(const bf16* h, const float* ssq, const float* cw, const float* sh, float* rstd_out, unsigned char* dst8, float* rsx, int lane, int wave) {
    const int gw = vblk() * NWAVES + wave, NGW = gridDim.x * NWAVES;
    for (int m0 = gw + ((M - 1 - gw) / (4 * NGW)) * (4 * NGW); m0 >= 0; m0 -= 4 * NGW) {
        v4u hv[4][2];
#pragma unroll
        for (int q = 0; q < 4; ++q) { const int mq = rowmap((m0 + q * NGW < M) ? m0 + q * NGW : m0); const GAS v4u* hr = (const GAS v4u*)(h + (size_t)mq * D) + lane; hv[q][0] = hr[0]; hv[q][1] = hr[64]; }
#pragma unroll
        for (int q = 0; q < 4; ++q) { if (m0 + q * NGW >= M) break; const int m = rowmap(m0 + q * NGW); const int b = m / SEQ; const float rstd = pg8::row_rstd(ssq, m);
            float yy[2][8]; float amax = 1e-30f;
#pragma unroll
            for (int j = 0; j < 2; ++j) { float x[8]; unpack8f(hv[q][j], x); const int c = 8 * lane + 512 * j;
                const f32x4 w0 = *(const f32x4*)(cw + b * 1024 + c), w1 = *(const f32x4*)(cw + b * 1024 + c + 4), s0 = *(const f32x4*)(sh + (size_t)b * (NMOD * D) + c), s1 = *(const f32x4*)(sh + (size_t)b * (NMOD * D) + c + 4);
                float y[8] = {x[0] * rstd * w0.x + s0.x, x[1] * rstd * w0.y + s0.y, x[2] * rstd * w0.z + s0.z, x[3] * rstd * w0.w + s0.w, x[4] * rstd * w1.x + s1.x, x[5] * rstd * w1.y + s1.y, x[6] * rstd * w1.z + s1.z, x[7] * rstd * w1.w + s1.w};
#pragma unroll
                for (int e = 0; e < 8; ++e) { yy[j][e] = y[e]; amax = __builtin_fmaxf(amax, __builtin_fabsf(y[e])); } }
            amax = wave_max(amax);
            const float qs = 127.f * __builtin_amdgcn_rcpf(amax);
            typedef unsigned u32x2_ __attribute__((ext_vector_type(2)));
#pragma unroll
            for (int j = 0; j < 2; ++j) *(GAS u32x2_*)(dst8 + (size_t)m * D + 8 * lane + 512 * j) = (u32x2_){i8x4(yy[j][0] * qs, yy[j][1] * qs, yy[j][2] * qs, yy[j][3] * qs), i8x4(yy[j][4] * qs, yy[j][5] * qs, yy[j][6] * qs, yy[j][7] * qs)};
            if (lane == 0) { rsx[m] = amax * (1.f / 127.f); rstd_out[m] = rstd; } }
    }
}
__device__ __forceinline__ void phase_final_norm(const bf16* h3, const float* ssq, float* out, const float* nw, int lane, int wave) {
    const int gw = vblk() * NWAVES + wave, NGW = gridDim.x * NWAVES;
    for (int m0 = gw + ((M - 1 - gw) / (4 * NGW)) * (4 * NGW); m0 >= 0; m0 -= 4 * NGW) {
        v4u hv[4][2];
#pragma unroll
        for (int q = 0; q < 4; ++q) { const int mq = rowmap((m0 + q * NGW < M) ? m0 + q * NGW : m0); const GAS v4u* hr = (const GAS v4u*)(h3 + (size_t)mq * D) + lane; hv[q][0] = hr[0]; hv[q][1] = hr[64]; }
#pragma unroll
        for (int q = 0; q < 4; ++q) { if (m0 + q * NGW >= M) break; const int m = rowmap(m0 + q * NGW); const float rstd = pg8::row_rstd(ssq, m); GAS f32x4* orow = (GAS f32x4*)(out + (size_t)m * D);
#pragma unroll
            for (int j = 0; j < 2; ++j) { float x[8]; unpack8f(hv[q][j], x); const int c = 8 * lane + 512 * j;
                const f32x4 w0 = *(const f32x4*)(nw + c), w1 = *(const f32x4*)(nw + c + 4);
                orow[(c >> 2)] = (f32x4){x[0] * rstd * w0.x, x[1] * rstd * w0.y, x[2] * rstd * w0.z, x[3] * rstd * w0.w};
                orow[(c >> 2) + 1] = (f32x4){x[4] * rstd * w1.x, x[5] * rstd * w1.y, x[6] * rstd * w1.z, x[7] * rstd * w1.w}; } }
    }
}
__device__ __forceinline__ void phase_rstd_q(const float* ssq16, float* rstd, const bf16* a16, const float* cw, unsigned char* a8, int lane, int wave) {
    const int gw = vblk() * NWAVES + wave, NGW = gridDim.x * NWAVES;
    for (int m0 = gw + ((M - 1 - gw) / (4 * NGW)) * (4 * NGW); m0 >= 0; m0 -= 4 * NGW) {
        v4u hv[4][2];
#pragma unroll
        for (int q = 0; q < 4; ++q) { const int mq = rowmap((m0 + q * NGW < M) ? m0 + q * NGW : m0); const GAS v4u* hr = (const GAS v4u*)(a16 + (size_t)mq * D) + 2 * lane; hv[q][0] = hr[0]; hv[q][1] = hr[1]; }
        float c[16];
        { const float* cb = cw + (size_t)(rowmap(m0) >> 13) * 1024 + 16 * lane;
#pragma unroll
          for (int e4 = 0; e4 < 4; ++e4) { const f32x4 cv_ = *(const f32x4*)(cb + 4 * e4); c[4 * e4] = cv_[0]; c[4 * e4 + 1] = cv_[1]; c[4 * e4 + 2] = cv_[2]; c[4 * e4 + 3] = cv_[3]; } }
#pragma unroll
        for (int q = 0; q < 4; ++q) { if (m0 + q * NGW >= M) break; const int m = rowmap(m0 + q * NGW);
            float x[16]; unpack8f(hv[q][0], x); unpack8f(hv[q][1], x + 8);
            float amax = 1e-30f;
#pragma unroll
            for (int e = 0; e < 16; ++e) { x[e] *= c[e]; amax = __builtin_fmaxf(amax, __builtin_fabsf(x[e])); }
            amax = wave_max(amax);
            const float qs = 127.f * __builtin_amdgcn_rcpf(amax);
            v4u o; o.x = i8x4(x[0] * qs, x[1] * qs, x[2] * qs, x[3] * qs); o.y = i8x4(x[4] * qs, x[5] * qs, x[6] * qs, x[7] * qs);
            o.z = i8x4(x[8] * qs, x[9] * qs, x[10] * qs, x[11] * qs); o.w = i8x4(x[12] * qs, x[13] * qs, x[14] * qs, x[15] * qs);
            *((GAS v4u*)(a8 + (size_t)m * D) + lane) = o;
            if (lane == 0) rstd[m] = pg8::row_rstd(ssq16, m) * amax * (1.f / 127.f); }
    }
}
__device__ __forceinline__ void phase_rstd(const float* ssq16, float* rstd, int tid) {
    for (int m = blockIdx.x * 512 + tid; m < M; m += gridDim.x * 512) rstd[m] = pg8::row_rstd(ssq16, m);
}
__device__ __forceinline__ void phase_conv_qkv(const unsigned char* src, bf16* dst, const float* cw  , bool do_norm, float scale, int lane, int wave) {
    typedef unsigned u32x2_ __attribute__((ext_vector_type(2)));
    const float* scp = (const float*)(src + pg8::QKV8_SC_OFF);
    const int gw = blockIdx.x * NWAVES + wave, NGW = gridDim.x * NWAVES;
    const int c0 = (gw & 1) * 512 + 8 * lane;
    float w[5][8];
#pragma unroll
    for (int i = 0; i < 5; ++i)
#pragma unroll
        for (int e = 0; e < 8; ++e) w[i][e] = cw[i * 3072 + c0 + e];
    for (int it = gw; it < 2 * (M / 32); it += NGW) {
        const int r0 = (it >> 1) * 32, s0 = r0 & (SEQ - 1);
        u32x2_ raw[12]; float rsc[12];
#define CONV_LOAD(ch_) do { _Pragma("unroll") for (int k = 0; k < 12; ++k) { const int ss = s0 + 8 * (ch_) - 2 + k; raw[k] = (u32x2_){0u, 0u}; rsc[k] = 0.f; \
            if (ss >= 0 && ss < SEQ) { raw[k] = *(const GAS u32x2_*)(src + (size_t)(r0 + 8 * (ch_) - 2 + k) * D + c0); rsc[k] = scp[(size_t)(r0 + 8 * (ch_) - 2 + k) * 32 + (c0 >> 5)]; } } } while (0)
        CONV_LOAD(0);
#pragma unroll 1
        for (int ch = 0; ch < 4; ++ch) {
            float x[12][8];
#pragma unroll
            for (int k = 0; k < 12; ++k) { const unsigned w0 = raw[k].x, w1 = raw[k].y; const float sk = rsc[k], ok = -128.f * sk;
                x[k][0] = (float)(w0 & 0xffu) * sk + ok; x[k][1] = (float)((w0 >> 8) & 0xffu) * sk + ok; x[k][2] = (float)((w0 >> 16) & 0xffu) * sk + ok; x[k][3] = (float)(w0 >> 24) * sk + ok;
                x[k][4] = (float)(w1 & 0xffu) * sk + ok; x[k][5] = (float)((w1 >> 8) & 0xffu) * sk + ok; x[k][6] = (float)((w1 >> 16) & 0xffu) * sk + ok; x[k][7] = (float)(w1 >> 24) * sk + ok; }
            if (ch < 3) CONV_LOAD(ch + 1);
#pragma unroll
            for (int o = 0; o < 8; ++o) { float acc[8]; float ssq = 0.f;
#pragma unroll
                for (int e = 0; e < 8; ++e) { float t = x[o][e] * w[0][e];
#pragma unroll
                    for (int i = 1; i < 5; ++i) t += x[o + i][e] * w[i][e];
                    t = siluf_(t); acc[e] = t; ssq += t * t; }
                if (do_norm) { const float r = scale * __builtin_amdgcn_rsqf(sum16(ssq) + EPS);
#pragma unroll
                    for (int e = 0; e < 8; ++e) acc[e] *= r; }
                *(GAS v4u*)(dst + (size_t)(r0 + 8 * ch + o) * D + c0) = pack8f(acc); }
        }
#undef CONV_LOAD
    }
}
__device__ __forceinline__ void phase_ya(const bf16* cab, const bf16* cv, const float* cw  , bf16* ya, int lane, int wave) {
    const int gw = blockIdx.x * NWAVES + wave, NGW = gridDim.x * NWAVES, c0 = 8 * lane;
    float w[3][8];
#pragma unroll
    for (int i = 0; i < 3; ++i)
#pragma unroll
        for (int e = 0; e < 8; ++e) w[i][e] = cw[i * 512 + c0 + e];
    for (int it = gw; it < M / 32; it += NGW) {
        const int r0 = it * 32, s0 = r0 & (SEQ - 1);
#pragma unroll 1
        for (int ch = 0; ch < 4; ++ch) {
            float x[10][8]; v4u g[8];
#pragma unroll
            for (int k = 0; k < 10; ++k) { const int ss = s0 + 8 * ch - 1 + k; v4u raw = {0u, 0u, 0u, 0u};
                if (ss >= 0 && ss < SEQ) raw = *(const GAS v4u*)(cv + (size_t)(r0 + 8 * ch - 1 + k) * 512 + c0);
                unpack8f(raw, x[k]); }
#pragma unroll
            for (int o = 0; o < 8; ++o) g[o] = *(const GAS v4u*)(cab + (size_t)(r0 + 8 * ch + o) * 512 + c0);
#pragma unroll
            for (int o = 0; o < 8; ++o) { float acc[8], gf[8]; unpack8f(g[o], gf);
#pragma unroll
                for (int e = 0; e < 8; ++e) acc[e] = (x[o][e] * w[0][e] + x[o + 1][e] * w[1][e] + x[o + 2][e] * w[2][e]) * gf[e];
                *(GAS v4u*)(ya + (size_t)(r0 + 8 * ch + o) * 512 + c0) = pack8f(acc); }
        }
    }
}
__device__ __forceinline__ void phase_ba(const bf16* xn, const bf16* wba, size_t wb_stride, const float* rstd, const float* bias, int bias_stride, float* ba, int lane, int wave) {
    typedef short bf16x8 __attribute__((ext_vector_type(8)));
    const int gw = vblk() * NWAVES + wave, NGW = gridDim.x * NWAVES, c16 = lane & 15, q4 = lane >> 4;
    for (int itl = gw; itl < M / 16; itl += NGW) {
        const int it = (gridDim.x == 256) ? ((((itl >> 3) & 7) << 8) | ((itl >> 6) << 3) | (itl & 7)) : itl;
        const bf16* ap = xn + (size_t)(16 * it + c16) * D + 8 * q4; const int bb = (16 * it) >> 13; const bf16* bp0 = wba + (size_t)bb * wb_stride + (size_t)c16 * D + 8 * q4; const bf16* bp1 = bp0 + (size_t)16 * D;
        f32x4 acc0 = {0.f, 0.f, 0.f, 0.f}, acc1 = {0.f, 0.f, 0.f, 0.f};
        bf16x8 af[D / 32];
#pragma unroll
        for (int ks = 0; ks < D / 32; ++ks) af[ks] = *(const bf16x8*)(ap + 32 * ks);
#pragma unroll
        for (int ks = 0; ks < D / 32; ++ks) { const bf16x8 b0 = *(const bf16x8*)(bp0 + 32 * ks), b1 = *(const bf16x8*)(bp1 + 32 * ks);
            acc0 = __builtin_amdgcn_mfma_f32_16x16x32_bf16(af[ks], b0, acc0, 0, 0, 0); acc1 = __builtin_amdgcn_mfma_f32_16x16x32_bf16(af[ks], b1, acc1, 0, 0, 0); }
        const float bi0 = bias[bb * bias_stride + c16], bi1 = bias[bb * bias_stride + 16 + c16];
#pragma unroll
        for (int r = 0; r < 4; ++r) { const int row = 16 * it + 4 * q4 + r; const float rr = rstd[row]; float* o = ba + (size_t)row * 32; o[c16] = acc0[r] * rr + bi0; o[16 + c16] = acc1[r] * rr + bi1; }
    }
}
__device__ __forceinline__ void phase_gb(const Args& a, const float* ba, float* gb, int tid) {
    for (int i = blockIdx.x * 512 + tid; i < M * 32; i += gridDim.x * 512) {
        const int row = i >> 5, j = i & 31, part = j >> 3, h = j & 7; const float x = ba[i]; float r;
        if (part < 2) r = sigmoidf_(x);
        else { const float al = a.in[part == 2 ? I_ALF : I_ALB][h], dt = a.in[part == 2 ? I_DTF : I_DTB][h]; const float y = x + dt;
            const float sp = y > 20.f ? y : log1pf(__expf(y)); r = -__expf(al) * sp; }
        gb[(size_t)part * M * 8 + (size_t)row * 8 + h] = r;
    }
}
namespace scan {
typedef short bf16x8 __attribute__((ext_vector_type(8)));
typedef short s16x4 __attribute__((ext_vector_type(4)));
typedef float f32x4 __attribute__((ext_vector_type(4)));
typedef unsigned u32x2 __attribute__((ext_vector_type(2)));
typedef unsigned long long u64;
typedef u64 u64x2 __attribute__((ext_vector_type(2)));
typedef __bf16 nbf16x8 __attribute__((ext_vector_type(8)));
typedef __bf16 nbf16x2 __attribute__((ext_vector_type(2)));
typedef float f32x8 __attribute__((ext_vector_type(8)));
typedef float f32x2 __attribute__((ext_vector_type(2)));
constexpr int RS = 288, TS = 144, VSS = 80;
constexpr int KNB = 0, QNB = 55296, VSB = 92160, SCB = 102400;
constexpr int KN_BYTES = 18432, VS_BYTES = 5120, SC_BYTES = 1280;
constexpr int ATTB = 106240, ANEGB = 124672, DMB = 143104, SCAN_LDS_END = 147200;
static_assert(SCAN_LDS_END <= LDSCTL_OFF, "scan LDS");
__device__ __forceinline__ bf16x8 frag2(u64 lo, u64 hi) { return __builtin_bit_cast(bf16x8, (u64x2){lo, hi}); }
__device__ __forceinline__ bf16x8 packB(f32x4 a, f32x4 b) { const f32x8 v = {a[0], a[1], a[2], a[3], b[0], b[1], b[2], b[3]}; return __builtin_bit_cast(bf16x8, __builtin_convertvector(v, nbf16x8)); }
__device__ __forceinline__ bf16x8 packB1(f32x4 a) { const f32x8 v = {a[0], a[1], a[2], a[3], 0.f, 0.f, 0.f, 0.f}; return __builtin_bit_cast(bf16x8, __builtin_convertvector(v, nbf16x8)); }
__device__ __forceinline__ unsigned cvt2(float lo, float hi) { const f32x2 v = {lo, hi}; return __builtin_bit_cast(unsigned, __builtin_convertvector(v, nbf16x2)); }
__device__ __forceinline__ unsigned short cvt1(float x) { return (unsigned short)(cvt2(x, 0.f) & 0xffffu); }
#define MFMA16(a, b, c) __builtin_amdgcn_mfma_f32_16x16x32_bf16((a), (b), (c), 0, 0, 0)
__device__ __forceinline__ bf16x8 ldA1(LAS unsigned char* base, int stride, int c16, int q4, int col0) {
    LAS unsigned char* p = base + c16 * stride + (col0 + 4 * q4) * 2; return frag2(*(LAS u64*)p, 0ull); }
__device__ __forceinline__ bf16x8 ldAtr(LAS unsigned char* tile, int c16, int q4, int row0, int dt) {
    LAS unsigned char* p = tile + (row0 + 4 * q4 + (c16 >> 2)) * RS + (32 * (dt >> 1) + 8 * (c16 & 3) + 4 * (dt & 1)) * 2;
    const s16x4 lo = __builtin_amdgcn_ds_read_tr16_b64_v4i16((LAS s16x4*)p), hi = __builtin_amdgcn_ds_read_tr16_b64_v4i16((LAS s16x4*)(p + 16 * RS));
    return (bf16x8){lo[0], lo[1], lo[2], lo[3], hi[0], hi[1], hi[2], hi[3]}; }
__device__ __forceinline__ bf16x8 ldA16(LAS unsigned char* base, int stride, int c16, int q4, int col0) { return *(LAS bf16x8*)(base + c16 * stride + (col0 + 8 * q4) * 2); }
__device__ __forceinline__ int tpos(int tj, int q4) { return 32 * (tj >> 1) + 8 * q4 + 4 * (tj & 1); }
__device__ __forceinline__ void d_invert(f32x4 at, LAS unsigned char* dmb, int c16, int q4) {
    LAS unsigned char* wp = dmb + c16 * 32 + 8 * q4;
    LAS unsigned char* rp = dmb + (4 * q4 + (c16 >> 2)) * 32 + 8 * (c16 & 3);
    const f32x4 z = {0.f, 0.f, 0.f, 0.f};
    f32x4 nt = -at, pt;
#pragma unroll
    for (int r = 0; r < 4; ++r) pt[r] = nt[r] + ((4 * q4 + r == c16) ? 1.f : 0.f);
#pragma unroll
    for (int k = 0; k < 4; ++k) {
        *(LAS u32x2*)wp = (u32x2){cvt2(nt[0], nt[1]), cvt2(nt[2], nt[3])};
        const s16x4 lo = __builtin_amdgcn_ds_read_tr16_b64_v4i16((LAS s16x4*)rp);
        const bf16x8 aop = (bf16x8){lo[0], lo[1], lo[2], lo[3], 0, 0, 0, 0};
        if (k > 0) pt = MFMA16(aop, packB1(pt), pt);
        if (k < 3) nt = MFMA16(aop, packB1(nt), z);
    }
    *(LAS u32x2*)wp = (u32x2){cvt2(pt[0], pt[1]), cvt2(pt[2], pt[3])};
}
template <int NT> __device__ __forceinline__ void c_tiles(LAS unsigned char* kn, LAS unsigned char* qn, LAS float* scf, LAS unsigned char* att, LAS unsigned char* aneg, f32x4& adiag, int ti, int tj0, int c16, int q4) {
    f32x4 acck[NT], accq[NT];
#pragma unroll
    for (int t = 0; t < NT; ++t) { acck[t] = (f32x4){0.f, 0.f, 0.f, 0.f}; accq[t] = (f32x4){0.f, 0.f, 0.f, 0.f}; }
    bf16x8 fa[2][NT], fk[2], fq[2];
#define C_LOAD(bf_, ks_) do { fk[bf_] = *(LAS bf16x8*)(kn + (16 * ti + c16) * RS + (ks_) * 64 + q4 * 16); fq[bf_] = *(LAS bf16x8*)(qn + (16 * ti + c16) * RS + (ks_) * 64 + q4 * 16); \
        _Pragma("unroll") for (int t = 0; t < NT; ++t) fa[bf_][t] = *(LAS bf16x8*)(kn + (16 * (tj0 + t) + c16) * RS + (ks_) * 64 + q4 * 16); } while (0)
    C_LOAD(0, 0);
#pragma unroll
    for (int ks = 0; ks < 4; ++ks) {
        if (ks == 0) C_LOAD(1, 1); else if (ks == 1) C_LOAD(0, 2); else if (ks == 2) C_LOAD(1, 3);
        __builtin_amdgcn_sched_barrier(0);
#pragma unroll
        for (int t = 0; t < NT; ++t) { acck[t] = MFMA16(fa[ks & 1][t], fk[ks & 1], acck[t]); accq[t] = MFMA16(fa[ks & 1][t], fq[ks & 1], accq[t]); }
        __builtin_amdgcn_sched_barrier(0);
    }
#undef C_LOAD
    const int I = 16 * ti + c16;
    const float gi = scf[I], bi = scf[128 + I];
#pragma unroll
    for (int t = 0; t < NT; ++t) {
        const int tj = tj0 + t, J0 = 16 * tj + 4 * q4;
        const f32x4 gj = *(LAS f32x4*)(scf + J0);
        f32x4 a, tt;
#pragma unroll
        for (int r = 0; r < 4; ++r) { const float dec = __expf(gi - gj[r]);
            a[r] = (I > J0 + r) ? bi * acck[t][r] * dec : 0.f; tt[r] = (I >= J0 + r) ? accq[t][r] * dec : 0.f; }
        *(LAS u32x2*)(att + I * TS + tpos(tj, q4) * 2) = (u32x2){cvt2(tt[0], tt[1]), cvt2(tt[2], tt[3])};
        if (tj == ti) adiag = a;
        else *(LAS u32x2*)(aneg + I * TS + tpos(tj, q4) * 2) = (u32x2){cvt2(-a[0], -a[1]), cvt2(-a[2], -a[3])};
    }
}
__device__ __forceinline__ void e_solve(const f32x4 (&rhs)[4], f32x4 (&X)[4], const bf16x8 (&Df)[4], bf16x8 A10, bf16x8 A2x, bf16x8 A3a, bf16x8 A3b) {
    const f32x4 z = {0.f, 0.f, 0.f, 0.f};
    X[0] = MFMA16(Df[0], packB1(rhs[0]), z);
    f32x4 y = MFMA16(A10, packB1(X[0]), rhs[1]);
    X[1] = MFMA16(Df[1], packB1(y), z);
    const bf16x8 x01 = packB(X[0], X[1]);
    y = MFMA16(A2x, x01, rhs[2]);
    f32x4 y3 = MFMA16(A3a, x01, rhs[3]);
    X[2] = MFMA16(Df[2], packB1(y), z);
    y3 = MFMA16(A3b, packB1(X[2]), y3);
    X[3] = MFMA16(Df[3], packB1(y3), z);
}
__device__ __forceinline__ void phase_scan(const bf16* Q, const bf16* K, const bf16* V, const float* gbuf, bf16* OF, bf16* OB, LAS unsigned char* lds, int tid, int lane, int wave) {
    constexpr int NC = SEQ / 64;
    for (int item = blockIdx.x; item < BATCH * NH * 2 * 4; item += gridDim.x) {
        const int xq = item & 7, yq = item >> 3, ci = xq * 8 + (yq >> 2), sl = yq & 3;
        const int b = ci >> 4, h = (ci >> 1) & 7, dir = ci & 1;
        const float* betap = gbuf + (size_t)dir * M * 8 + h; const float* glp = gbuf + (size_t)(2 + dir) * M * 8 + h; bf16* O = dir ? OB : OF;
        const size_t rowbase = (size_t)b * SEQ;
        __syncthreads();
        for (int i = tid; i < 2 * 9216 / 4; i += 512) ((LAS unsigned*)(lds + ATTB))[i] = 0u;
        v4u kreg[2], qreg[2], vreg = {0u, 0u, 0u, 0u}; float greg = 0.f, breg = 0.f;
#define SCAN_LOAD(n_) do { \
            _Pragma("unroll") for (int r = 0; r < 2; ++r) { const int pi = tid + 512 * r, row = pi >> 4, pc = pi & 15; const int p = 64 * (n_) + row; const int s = dir ? (SEQ - 1 - p) : p; \
                const size_t off = (rowbase + s) * D + h * 128 + pc * 8; kreg[r] = *(const GAS v4u*)(K + off); qreg[r] = *(const GAS v4u*)(Q + off); } \
            if (tid < 256) { const int row = tid >> 2, pc = tid & 3; const int p = 64 * (n_) + row; const int s = dir ? (SEQ - 1 - p) : p; vreg = *(const GAS v4u*)(V + (rowbase + s) * D + h * 128 + sl * 32 + pc * 8); } \
            if (wave == 6) { const int p = 64 * (n_) + lane; const int s = dir ? (SEQ - 1 - p) : p; greg = glp[(rowbase + s) * 8]; breg = betap[(rowbase + s) * 8]; } } while (0)
#define SCAN_STAGE(k3_, p2_) do { LAS unsigned char* knw_ = lds + KNB + (k3_) * KN_BYTES; LAS unsigned char* qnw_ = lds + QNB + (p2_) * KN_BYTES; LAS unsigned char* vsw_ = lds + VSB + (p2_) * VS_BYTES; \
            _Pragma("unroll") for (int r = 0; r < 2; ++r) { const int pi = tid + 512 * r, row = pi >> 4, pc = pi & 15; \
                *(LAS v4u*)(knw_ + row * RS + pc * 16) = kreg[r]; *(LAS v4u*)(qnw_ + row * RS + pc * 16) = qreg[r]; } \
            if (tid < 256) { const int row = tid >> 2, pc = tid & 3; *(LAS v4u*)(vsw_ + row * VSS + pc * 16) = vreg; } \
            if (wave == 6) { float g = greg; LAS float* scw = (LAS float*)(lds + SCB + (k3_) * SC_BYTES); \
                g = dpp_add<0x111>(g); g = dpp_add<0x112>(g); g = dpp_add<0x114>(g); g = dpp_add<0x118>(g);        \
                g = dpp_add<0x142, 0xa>(g); g = dpp_add<0x143, 0xc>(g);                                          \
                const float g63 = __shfl(g, 63), eg = __expf(g); \
                scw[lane] = g; scw[64 + lane] = breg * eg; scw[128 + lane] = breg; scw[192 + lane] = eg; scw[256 + lane] = __expf(g63 - g); } } while (0)
        SCAN_LOAD(0);
        SCAN_STAGE(0, 0);
        SCAN_LOAD(1);
        __syncthreads();
#define SCAN_ITER_PTRS \
            const bool have_prod = (n + 1 < NC), have_cons = (n >= 0), have_stage = (n + 2 < NC); (void)have_prod; (void)have_cons; \
            LAS unsigned char* knc = lds + KNB + k3c * KN_BYTES; LAS unsigned char* knp = lds + KNB + k3p * KN_BYTES;              \
            LAS unsigned char* qnc = lds + QNB + (n & 1) * KN_BYTES; LAS unsigned char* qnp = lds + QNB + ((n + 1) & 1) * KN_BYTES; \
            LAS unsigned char* vsc = lds + VSB + (n & 1) * VS_BYTES; \
            LAS float* scc = (LAS float*)(lds + SCB + k3c * SC_BYTES); LAS float* scp = (LAS float*)(lds + SCB + k3p * SC_BYTES); \
            LAS unsigned char* attc = lds + ATTB + (n & 1) * 9216; LAS unsigned char* attp = lds + ATTB + ((n + 1) & 1) * 9216; \
            LAS unsigned char* anegc = lds + ANEGB + (n & 1) * 9216; LAS unsigned char* anegp = lds + ANEGB + ((n + 1) & 1) * 9216; \
            LAS unsigned char* dmc = lds + DMB + (n & 1) * 2048; LAS unsigned char* dmp = lds + DMB + ((n + 1) & 1) * 2048; \
            (void)knc; (void)knp; (void)qnc; (void)qnp; (void)vsc; (void)scc; (void)scp; (void)attc; (void)attp; (void)anegc; (void)anegp; (void)dmc; (void)dmp; \
            int lane_o = lane; asm volatile("" : "+v"(lane_o)); const int c16 = lane_o & 15, q4 = lane_o >> 4;
#define SCAN_ITER_NEXT do { k3c = k3p; k3p = k3s; k3s = (k3s == 2) ? 0 : k3s + 1; } while (0)
        if (wave < 2) {
            f32x4 S[8];
#pragma unroll
            for (int t = 0; t < 8; ++t) S[t] = (f32x4){0.f, 0.f, 0.f, 0.f};
            int k3c = 2, k3p = 0, k3s = 1;
            for (int n = -1; n < NC; ++n) {
                SCAN_ITER_PTRS
                f32x4 R[4], ao[4], vn[4];
                if (have_cons) {
                    bf16x8 Sb[4];
#pragma unroll
                    for (int ks = 0; ks < 4; ++ks) Sb[ks] = packB(S[2 * ks], S[2 * ks + 1]);
                    bf16x8 kf[2][4], qf[2][4]; f32x4 kbv[2], bev[2]; float egv[2]; s16x4 vraw[2];
                    bf16x8 Df[4], A10, A2x, A3a, A3b;
#define F1_LOAD(bf_, it_) do { _Pragma("unroll") for (int ks = 0; ks < 4; ++ks) { kf[bf_][ks] = ldA16(knc + 16 * (it_) * RS, RS, c16, q4, 32 * ks); qf[bf_][ks] = ldA16(qnc + 16 * (it_) * RS, RS, c16, q4, 32 * ks); } \
                        kbv[bf_] = *(LAS f32x4*)(scc + 64 + 16 * (it_) + 4 * q4); bev[bf_] = *(LAS f32x4*)(scc + 128 + 16 * (it_) + 4 * q4); egv[bf_] = scc[192 + 16 * (it_) + c16]; \
                        vraw[bf_] = __builtin_amdgcn_ds_read_tr16_b64_v4i16((LAS s16x4*)(vsc + (16 * (it_) + 4 * q4 + (c16 >> 2)) * VSS + (16 * wave + 4 * (c16 & 3)) * 2)); } while (0)
                    F1_LOAD(0, 0);
#pragma unroll
                    for (int it = 0; it < 4; ++it) {
                        if (it == 0) F1_LOAD(1, 1); else if (it == 1) F1_LOAD(0, 2); else if (it == 2) F1_LOAD(1, 3);
                        else {
#pragma unroll
                            for (int r = 0; r < 4; ++r) Df[r] = ldA1(dmc + r * 512, 32, c16, q4, 0);
                            A10 = frag2(*(LAS u64*)(anegc + (16 + c16) * TS + tpos(0, q4) * 2), 0ull); A2x = ldA16(anegc + 32 * TS, TS, c16, q4, 0);
                            A3a = ldA16(anegc + 48 * TS, TS, c16, q4, 0); A3b = frag2(*(LAS u64*)(anegc + (48 + c16) * TS + tpos(2, q4) * 2), 0ull); }
                        __builtin_amdgcn_sched_barrier(0);
                        const int bf = it & 1;
                        f32x4 ak = {0.f, 0.f, 0.f, 0.f}, aq = {0.f, 0.f, 0.f, 0.f};
#pragma unroll
                        for (int ks = 0; ks < 4; ++ks) { ak = MFMA16(kf[bf][ks], Sb[ks], ak); aq = MFMA16(Sb[ks], qf[bf][ks], aq); }
                        f32x4 vb;
#pragma unroll
                        for (int rr = 0; rr < 4; ++rr) vb[rr] = bf2f((unsigned short)vraw[bf][rr]) * bev[bf][rr];
                        R[it] = vb - kbv[bf] * ak; ao[it] = aq * egv[bf];
                        __builtin_amdgcn_sched_barrier(0);
                    }
#undef F1_LOAD
                    e_solve(R, vn, Df, A10, A2x, A3a, A3b);
                }
                __syncthreads();
                if (have_stage) SCAN_STAGE(k3s, n & 1);
                if (n + 3 < NC) SCAN_LOAD(n + 3);
                if (have_cons) {
                    const float egl = scc[192 + 63];
                    bf16x8 tf[2][4][2];
#define F2_LOAD(bf_, dt0_) do { _Pragma("unroll") for (int d = 0; d < 4; ++d) _Pragma("unroll") for (int s2 = 0; s2 < 2; ++s2) tf[bf_][d][s2] = ldAtr(knc, c16, q4, 32 * s2, (dt0_) + d); } while (0)
                    F2_LOAD(0, 0);
                    F2_LOAD(1, 4);
                    bf16x8 Vb[2], Vd[2];
#pragma unroll
                    for (int s2 = 0; s2 < 2; ++s2) { const f32x4 e0 = *(LAS f32x4*)(scc + 256 + 32 * s2 + 4 * q4), e1 = *(LAS f32x4*)(scc + 256 + 32 * s2 + 16 + 4 * q4);
                        Vb[s2] = packB(vn[2 * s2], vn[2 * s2 + 1]); Vd[s2] = packB(vn[2 * s2] * e0, vn[2 * s2 + 1] * e1); }
                    __builtin_amdgcn_sched_barrier(0);
#pragma unroll
                    for (int d = 0; d < 4; ++d) { f32x4 a = S[d] * egl;
#pragma unroll
                        for (int s2 = 0; s2 < 2; ++s2) a = MFMA16(tf[0][d][s2], Vd[s2], a);
                        S[d] = a; }
#pragma unroll
                    for (int it = 0; it < 4; ++it)
#pragma unroll
                        for (int s2 = 0; s2 < 2; ++s2) tf[0][it][s2] = ldA16(attc + 16 * it * TS, TS, c16, q4, 32 * s2);
                    __builtin_amdgcn_sched_barrier(0);
#pragma unroll
                    for (int d = 0; d < 4; ++d) { f32x4 a = S[4 + d] * egl;
#pragma unroll
                        for (int s2 = 0; s2 < 2; ++s2) a = MFMA16(tf[1][d][s2], Vd[s2], a);
                        S[4 + d] = a; }
                    __builtin_amdgcn_sched_barrier(0);
#undef F2_LOAD
#pragma unroll
                    for (int it = 0; it < 4; ++it) {
#pragma unroll
                        for (int s2 = 0; s2 < 2; ++s2) ao[it] = MFMA16(Vb[s2], tf[0][it][s2], ao[it]);
                        const int p = 64 * n + 16 * it + c16; const int s = dir ? (SEQ - 1 - p) : p;
                        *(GAS u32x2*)(O + (rowbase + s) * D + h * 128 + sl * 32 + 16 * wave + 4 * q4) = (u32x2){cvt2(ao[it][0], ao[it][1]), cvt2(ao[it][2], ao[it][3])}; }
                }
                SCAN_ITER_NEXT;
                __syncthreads();
            }
        } else {
            int k3c = 2, k3p = 0, k3s = 1;
            for (int n = -1; n < NC; ++n) {
                SCAN_ITER_PTRS
                f32x4 adiag = {0.f, 0.f, 0.f, 0.f};
                const int ti = (wave < 4) ? 3 : (wave == 6 || wave == 5) ? 2 : (wave == 7) ? 1 : 0, tj0 = (wave == 3) ? 2 : (wave == 6) ? 1 : 0;
                if (have_prod) {
                    if (wave != 4 && wave != 5) c_tiles<2>(knp, qnp, scp, attp, anegp, adiag, ti, tj0, c16, q4);
                    else c_tiles<1>(knp, qnp, scp, attp, anegp, adiag, ti, tj0, c16, q4); }
                __syncthreads();
                if (have_stage) SCAN_STAGE(k3s, n & 1);
                if (n + 3 < NC) SCAN_LOAD(n + 3);
                if (have_prod && wave != 2 && wave != 5) d_invert(adiag, dmp + ti * 512, c16, q4);
                SCAN_ITER_NEXT;
                __syncthreads();
            }
        }
#undef SCAN_ITER_PTRS
#undef SCAN_ITER_NEXT
#undef SCAN_LOAD
#undef SCAN_STAGE
    }
}
#undef MFMA16
}

__device__ __forceinline__ void phase_onorm(bf16* of, const bf16* ob, const float* dnw, int lane, int wave) {
    const int gw = vblk() * NWAVES + wave, NGW = gridDim.x * NWAVES, hh = lane >> 4, cp = lane & 15;
    float w[8];
#pragma unroll
    for (int e = 0; e < 8; ++e) w[e] = dnw[8 * cp + e];
    for (int it0 = gw; it0 < M * 2; it0 += 4 * NGW) {
        v4u xa[4], ya[4];
#pragma unroll
        for (int q = 0; q < 4; ++q) { const int it = itemmap((it0 + q * NGW < M * 2) ? it0 + q * NGW : it0); const size_t off = (size_t)(it >> 1) * D + (4 * (it & 1) + hh) * 128 + 8 * cp; xa[q] = *(const GAS v4u*)(of + off); ya[q] = *(const GAS v4u*)(ob + off); }
#pragma unroll
        for (int q = 0; q < 4; ++q) { if (it0 + q * NGW >= M * 2) break; const int it = itemmap(it0 + q * NGW); const size_t off = (size_t)(it >> 1) * D + (4 * (it & 1) + hh) * 128 + 8 * cp;
            float x[8], y[8]; unpack8f(xa[q], x); unpack8f(ya[q], y);
            float ssq = 0.f;
#pragma unroll
            for (int e = 0; e < 8; ++e) { x[e] += y[e]; ssq += x[e] * x[e]; }
            const float r = __builtin_amdgcn_rsqf(sum16(ssq) * (1.f / 128.f) + EPS);
#pragma unroll
            for (int e = 0; e < 8; ++e) x[e] = x[e] * r * w[e];
            *(GAS v4u*)(of + off) = pack8f(x); }
    }
}

template <class Epi, int QMODE = 0> __device__ __forceinline__ void run_gemm(LAS unsigned char* lds, const bf16* A, const bf16* Bt, int N, int K, const Epi& E) {
    pg8::Gemm g{A, Bt, M, N, K}; pg8::StaticOrder S; S.init(M, N, (int)gridDim.x, vblk());
    pg8::gemm_phase<Epi, pg8::StaticOrder, true, true, QMODE>(lds, g, S, E);
}

__global__ void __launch_bounds__(NWAVES * 64, 2) mk_fwd(Args args) {
    extern __shared__ __attribute__((aligned(16))) unsigned char lds_raw[];
    LAS unsigned char* lds = (LAS unsigned char*)lds_raw;
    volatile LAS unsigned* MISC = (volatile LAS unsigned*)(lds + MISC_OFF);
    const int tid = threadIdx.x, lane = tid & 63, wave = __builtin_amdgcn_readfirstlane(tid >> 6);
    unsigned char* ws = args.ws;
    for (int u = tid; u < (LDS_BYTES - LDSCTL_OFF) / 4; u += NWAVES * 64) ((LAS unsigned*)(lds + LDSCTL_OFF))[u] = 0u;
    __syncthreads();
    XcdBarrier bar; bar.bar = (unsigned*)(ws + WS_CTL); bar.x = 0; bar.st = nullptr;
    const int lo = args.ph_lo, hi = args.ph_hi;
    if (hi - lo > 1) bar = xcd_barrier_post((unsigned*)(ws + WS_CTL), MISC + 8);
    float* mod = (float*)(ws + WS_MOD);
    bf16* XN = (bf16*)(ws + WS_XN); bf16* HID = (bf16*)(ws + WS_HID);


#define IN(k) (lo <= (k) && (k) < hi)
#define TIDS int tid = threadIdx.x; asm volatile("" : "+v"(tid)); const int lane = tid & 63; const int wave = __builtin_amdgcn_readfirstlane(tid >> 6); (void)lane; (void)wave;
#define SEAM(k) do { if (IN(k) && (k) + 1 < hi) xcd_barrier(bar); } while (0)
#define SEAMN(k) do { if (IN(k) && (k) + 1 < hi) { if (vword() >> 16) xcd_barrier<false>(bar); else xcd_barrier(bar); } } while (0)
#define SEAML(k) do { if (IN(k) && (k) + 1 < hi) { if (vword() >> 16) xcd_local_barrier(bar); else xcd_barrier(bar); } } while (0)
    const float* ssqv = (const float*)(ws + WS_SSQ); float* ssqw = (float*)(ws + WS_SSQ);
    bf16* HB1 = (bf16*)args.out; bf16* HB2 = (bf16*)(ws + WS_HB2); bf16* HB3 = (bf16*)(ws + WS_HB3);
    const float* cw2 = (const float*)(ws + WS_CW); const float* cw3 = cw2 + 4 * D;
    if (IN(0)) { TIDS phase_prologue(args, lds, tid, lane, wave); } SEAM(0);
    if (IN(1)) { TIDS phase_first(args, mod, XN, tid, lane, wave); } SEAM(1);
    if (IN(2)) { TIDS pg8::EpiGlu<false, true> E{HID, FF, ssqv, (const float*)(ws + WS_BW + BW_UP1), 2 * FF, (LAS float*)(lds + RING_BYTES), (const float*)(ws + WS_CF)};
        run_gemm<pg8::EpiGlu<false, true>, 2>(lds, XN, (const bf16*)(ws + WS_WUP1I8), 2 * FF, D / 2, E); } SEAML(2);
    if (IN(3)) { TIDS pg8::EpiRes<true> E{args.in[I_X], HB1, nullptr, mod + 2 * D, NMOD * D, 0.5f, nullptr, ssqw + (size_t)16 * M}; run_gemm(lds, HID, (const bf16*)(ws + WS_WDN1), D, FF, E); } SEAML(3);
    if (IN(4)) { TIDS phase_mix_norm(HB1, ssqv + (size_t)16 * M, cw2, mod + 3 * D, (float*)(ws + WS_RSTD2), (unsigned char*)(ws + WS_XN), (float*)(ws + WS_RSX), lane, wave); } SEAMN(4);
    if (IN(5)) { TIDS phase_ba(HB1, (const bf16*)(ws + WS_WIN1F) + (size_t)1536 * D, (size_t)1568 * D, (const float*)(ws + WS_RSTD2), (const float*)(ws + WS_BWF) + 1536, 1568, (float*)(ws + WS_BA), lane, wave);
        { pg8::EpiIn1Q E{(bf16*)(ws + WS_CV), (bf16*)(ws + WS_CAB), (bf16*)(ws + WS_QRAW), (size_t)M * D, (const float*)(ws + WS_RSX), (const float*)(ws + WS_CF2), (LAS float*)(lds + RING_BYTES), 0, 6};
          run_gemm<pg8::EpiIn1Q, 2>(lds, XN, (const bf16*)(ws + WS_WIN1I8), 3072, D / 2, E); }
        __syncthreads();
        { pg8::EpiIn1F E{(bf16*)(ws + WS_CV), (bf16*)(ws + WS_CAB), (const float*)(ws + WS_RSTD2), (const float*)(ws + WS_BWF), 1568, (LAS float*)(lds + RING_BYTES)};
          pg8::Gemm g{HB1, (const bf16*)(ws + WS_WIN1F), M, 1536, D, (size_t)1568 * D * 2}; pg8::StaticOrder S; S.init(M, 1536, (int)gridDim.x, vblk());
          pg8::gemm_phase<pg8::EpiIn1F, pg8::StaticOrder, true, true, 0>(lds, g, S, E); } } SEAM(5);
    if (IN(6)) { TIDS phase_conv_qkv(ws + WS_QRAW, (bf16*)(ws + WS_QF), args.in[I_CONVDN], true, 0.08838834764831845f, lane, wave);
        phase_ya((const bf16*)(ws + WS_CAB), (const bf16*)(ws + WS_CV), args.in[I_CONVA], (bf16*)(ws + WS_YA), lane, wave);
        phase_gb(args, (const float*)(ws + WS_BA), (float*)(ws + WS_GB), tid); } SEAMN(6);
    bf16* VFp = (bf16*)args.out + (size_t)M * D;
    if (IN(7)) { TIDS phase_conv_qkv(ws + WS_KRAW, (bf16*)(ws + WS_KF), args.in[I_CONVDN] + 1024, true, 1.0f, lane, wave);
        phase_conv_qkv(ws + WS_VRAW, VFp, args.in[I_CONVDN] + 2048, false, 1.0f, lane, wave); } SEAM(7);
    if (IN(9)) { TIDS scan::phase_scan((const bf16*)(ws + WS_QF), (const bf16*)(ws + WS_KF), (const bf16*)VFp, (const float*)(ws + WS_GB), (bf16*)(ws + WS_OF), (bf16*)(ws + WS_OB), lds, tid, lane, wave); } SEAM(9);
    if (IN(10)) { TIDS phase_onorm((bf16*)(ws + WS_OF), (const bf16*)(ws + WS_OB), args.in[I_DNNORM], lane, wave); } SEAML(10);
    if (IN(11)) { TIDS pg8::EpiIn2Q E{(bf16*)(ws + WS_OF), (bf16*)(ws + WS_SGA), (bf16*)(ws + WS_SGB), (const float*)(ws + WS_RSX), (const float*)(ws + WS_CF3), (LAS float*)(lds + RING_BYTES)};
        run_gemm<pg8::EpiIn2Q, 2>(lds, XN, (const bf16*)(ws + WS_WIN2I8), N_IN2, D / 2, E); } SEAML(11);
    if (IN(13)) { TIDS pg8::EpiPairMerge E{(const bf16*)(ws + WS_SGA), (bf16*)(ws + WS_SGB)};
        pg8::GemmPair g{(const bf16*)(ws + WS_YA), (const bf16*)(ws + WS_WA), 512, (const bf16*)(ws + WS_OF), (const bf16*)(ws + WS_WB), D};
        pg8::StaticOrder S; S.init(M, D, (int)gridDim.x, vblk()); pg8::gemm_phase_pair<pg8::EpiPairMerge, pg8::StaticOrder>(lds, g, S, E); } SEAML(13);
    if (IN(14)) { TIDS pg8::EpiRes<false> E{HB1, HB2, nullptr, mod + 5 * D, NMOD * D, 1.0f, nullptr, ssqw + (size_t)32 * M}; run_gemm(lds, (const bf16*)(ws + WS_SGB), (const bf16*)(ws + WS_WO), D, D, E); } SEAML(14);
    if (IN(15)) { TIDS phase_rstd_q(ssqv + (size_t)32 * M, ssqw + (size_t)M, HB2, cw3, ws + WS_YA, lane, wave); } SEAMN(15);
    if (IN(16)) { TIDS pg8::EpiGlu<false, true> E{HID, FF, ssqv + (size_t)M, (const float*)(ws + WS_BW + BW_UP2), 2 * FF, (LAS float*)(lds + RING_BYTES), (const float*)(ws + WS_CF) + 2 * FF};
        run_gemm<pg8::EpiGlu<false, true>, 2>(lds, (const bf16*)(ws + WS_YA), (const bf16*)(ws + WS_WUP2I8), 2 * FF, D / 2, E); } SEAML(16);
    if (IN(17)) { TIDS pg8::EpiRes<false> E{HB2, HB3, nullptr, mod + 8 * D, NMOD * D, 0.5f, nullptr, ssqw + (size_t)48 * M}; run_gemm(lds, HID, (const bf16*)(ws + WS_WDN2), D, FF, E); } SEAML(17);
    if (IN(18)) { TIDS phase_final_norm(HB3, ssqv + (size_t)48 * M, args.out, args.in[I_NFIN], lane, wave); }
#undef IN
#undef SEAM
}

extern "C" void kernel_launch(void* const* d_in, const int* in_sizes, int n_in, void* d_out, int out_size, void* d_ws, size_t ws_size, hipStream_t stream) {
    static int grid = 0;
    if (grid == 0) {
        if (n_in != 23 || in_sizes[0] != M * D || out_size != M * D || ws_size < WS_END) { fprintf(stderr, "kernel_launch: unexpected problem: n_in %d in0 %d out %d ws %zu (need %zu)\n", n_in, n_in > 0 ? in_sizes[0] : -1, out_size, ws_size, (size_t)WS_END); grid = -1; return; }
        int dev = 0, cus = 0, per_cu = 0;
        if (hipGetDevice(&dev) != hipSuccess || hipDeviceGetAttribute(&cus, hipDeviceAttributeMultiprocessorCount, dev) != hipSuccess) { grid = -1; return; }
        if (hipFuncSetAttribute((const void*)mk_fwd, hipFuncAttributeMaxDynamicSharedMemorySize, LDS_BYTES) != hipSuccess) { fprintf(stderr, "kernel_launch: hipFuncSetAttribute failed\n"); grid = -1; return; }
        if (hipOccupancyMaxActiveBlocksPerMultiprocessor(&per_cu, (const void*)mk_fwd, NWAVES * 64, LDS_BYTES) != hipSuccess || per_cu < 1)
            fprintf(stderr, "kernel_launch: note: occupancy query reports %d workgroups per CU\n", per_cu);
        (void)hipGetLastError();
        grid = cus;
    }
    if (grid < 0) return;
    (void)hipMemsetAsync((char*)d_ws + WS_CTL, 0, CTL_ZERO_BYTES, stream);
    Args a{};
    for (int i = 0; i < 23; ++i) a.in[i] = (const float*)d_in[i];
    a.out = (float*)d_out; a.ws = (unsigned char*)d_ws;
#if MK_SPLIT
    for (int ph = 0; ph < NPHASE; ++ph) { a.ph_lo = ph; a.ph_hi = ph + 1; hipLaunchKernelGGL(mk_fwd, dim3(grid), dim3(NWAVES * 64), LDS_BYTES, stream, a); }
#else
    a.ph_lo = 0; a.ph_hi = NPHASE; hipLaunchKernelGGL(mk_fwd, dim3(grid), dim3(NWAVES * 64), LDS_BYTES, stream, a);
#endif
    const hipError_t le = hipPeekAtLastError();
    if (le != hipSuccess) fprintf(stderr, "kernel_launch: launch failed: %s\n", hipGetErrorName(le));
}
```
